# Optimizing an MI355X kernel written in HIP

```python
import math, functools
import jax, jax.numpy as jnp
from jax import lax
import numpy as np

D_MODEL = 1024
BATCH = 2
SEQ = 16384
DEPTH = 1
DEC_BATCH = 16
DEC_SEQ = 16
PAST_LEN = 2048

CHUNK = 64
Q_BLOCK = 128
A_HEADS = 8
A_HEAD_DIM = 64
A_WIDTH = A_HEADS * A_HEAD_DIM
M_HEADS = 4
M_HEAD_DIM = 128
M_WIDTH = M_HEADS * M_HEAD_DIM
CONV_W = 4
D_FF = 2816
LN_EPS = 1e-5
ALPHA = (2.0 * DEPTH) ** 0.25
BETA = (8.0 * DEPTH) ** -0.25
IN_SIZES = (A_WIDTH, A_WIDTH, A_WIDTH, A_HEADS,
            M_WIDTH, M_WIDTH, M_WIDTH, M_HEADS, M_HEADS, M_WIDTH,
            D_MODEL, D_MODEL)
D_IN = sum(IN_SIZES)

kernel_name = "fox_mlstm_gated_macaron_deepnorm_adaln_step"


def _layer_norm(x, g, b):
    xf = x.astype(jnp.float32)
    mu = jnp.mean(xf, axis=-1, keepdims=True)
    var = jnp.mean(jnp.square(xf - mu), axis=-1, keepdims=True)
    return ((xf - mu) * lax.rsqrt(var + LN_EPS) * g + b).astype(x.dtype)


def _ffn(h, w_gu, w_down):
    g, u = jnp.split(h @ w_gu, 2, axis=-1)
    return (jax.nn.silu(g) * u) @ w_down


def _split_in(z):
    idx = [int(i) for i in np.cumsum(IN_SIZES)[:-1]]
    return jnp.split(z, idx, axis=-1)


def _causal_conv(u, buf, w, b):
    L = u.shape[1]
    full = jnp.concatenate([buf.astype(u.dtype), u], axis=1)
    out = b
    for j in range(CONV_W):
        out = out + full[:, j:j + L] * w[j]
    return out, full[:, -(CONV_W - 1):]


def _branch_inputs(h, w_in, b_in, conv_w, conv_b, conv_buf):
    B, L = h.shape[:2]
    z = h @ w_in + b_in
    aq, ak, av, af, mq, mk, mv, mi, mf, mo, ga, gb = _split_in(z)
    qk, new_buf = _causal_conv(jnp.concatenate([mq, mk], axis=-1), conv_buf, conv_w, conv_b)
    mq, mk = jnp.split(jax.nn.silu(qk), 2, axis=-1)
    fox = (aq.reshape(B, L, A_HEADS, A_HEAD_DIM),
           ak.reshape(B, L, A_HEADS, A_HEAD_DIM),
           av.reshape(B, L, A_HEADS, A_HEAD_DIM),
           jax.nn.log_sigmoid(af.astype(jnp.float32)))
    f32 = jnp.float32
    mls = (mq.reshape(B, L, M_HEADS, M_HEAD_DIM).astype(f32),
           mk.reshape(B, L, M_HEADS, M_HEAD_DIM).astype(f32) * (M_HEAD_DIM ** -0.5),
           mv.reshape(B, L, M_HEADS, M_HEAD_DIM).astype(f32),
           mi.astype(f32),
           jax.nn.log_sigmoid(mf.astype(f32)),
           mo)
    return fox, mls, ga, gb, new_buf


def _fox_prompt(q, k, v, logf):
    B, S = q.shape[:2]
    nb = S // Q_BLOCK
    Ft = jnp.cumsum(logf, axis=1).transpose(0, 2, 1)
    qb = q.reshape(B, nb, Q_BLOCK, A_HEADS, A_HEAD_DIM).transpose(1, 0, 2, 3, 4)
    Fb = Ft.reshape(B, A_HEADS, nb, Q_BLOCK).transpose(2, 0, 1, 3)
    pos_k = jnp.arange(S)
    scale = A_HEAD_DIM ** -0.5

    def block(args):
        i, qi, Fi = args
        s = jnp.einsum('bqhd,bkhd->bhqk', qi, k, preferred_element_type=jnp.float32) * scale
        s = s + Fi[..., :, None] - Ft[..., None, :]
        pos_q = i * Q_BLOCK + jnp.arange(Q_BLOCK)
        s = jnp.where(pos_k[None, :] <= pos_q[:, None], s, -jnp.inf)
        p = jax.nn.softmax(s, axis=-1)
        return jnp.einsum('bhqk,bkhd->bqhd', p.astype(v.dtype), v)

    out = lax.map(block, (jnp.arange(nb), qb, Fb))
    return out.transpose(1, 0, 2, 3, 4).reshape(B, S, A_WIDTH)


def _fox_sample(q, k_new, v_new, logf_new, k_cache, v_cache, logf_cache):
    B, L = q.shape[:2]
    P = k_cache.shape[1]
    k = jnp.concatenate([k_cache.astype(k_new.dtype), k_new], axis=1)
    v = jnp.concatenate([v_cache.astype(v_new.dtype), v_new], axis=1)
    logf = jnp.concatenate([logf_cache.astype(jnp.float32), logf_new], axis=1)
    Ft = jnp.cumsum(logf, axis=1).transpose(0, 2, 1)
    s = jnp.einsum('bqhd,bkhd->bhqk', q, k, preferred_element_type=jnp.float32) * (A_HEAD_DIM ** -0.5)
    s = s + Ft[..., P:, None] - Ft[..., None, :]
    pos_q = P + jnp.arange(L)
    pos_k = jnp.arange(P + L)
    s = jnp.where(pos_k[None, :] <= pos_q[:, None], s, -jnp.inf)
    p = jax.nn.softmax(s, axis=-1)
    return jnp.einsum('bhqk,bkhd->bqhd', p.astype(v.dtype), v).reshape(B, L, A_WIDTH)


def _mlstm_chunk(carry, inp):
    C, n, m = carry
    q, k, v, ig, lf = inp
    L = q.shape[1]
    b = jnp.cumsum(lf, axis=1).transpose(0, 2, 1)
    it = ig.transpose(0, 2, 1)
    causal = jnp.tril(jnp.ones((L, L), dtype=bool))
    d = jnp.where(causal, b[..., :, None] - b[..., None, :] + it[..., None, :], -jnp.inf)
    inter = b + m[..., None]
    m_t = jnp.maximum(inter, jnp.max(d, axis=-1))
    w_inter = jnp.exp(inter - m_t)
    a = jnp.exp(d - m_t[..., None]) * jnp.einsum('blhd,bshd->bhls', q, k)
    num = jnp.einsum('bhls,bshv->bhlv', a, v) + w_inter[..., None] * jnp.einsum('bhvd,blhd->bhlv', C, q)
    den = jnp.sum(a, axis=-1) + w_inter * jnp.einsum('bhd,blhd->bhl', n, q)
    h = num / jnp.maximum(jnp.abs(den), jnp.exp(-m_t))[..., None]
    m_new = m_t[..., -1]
    w_state = jnp.exp(b[..., -1] + m - m_new)
    w_s = jnp.exp(b[..., -1:] - b + it - m_new[..., None])
    C_new = w_state[..., None, None] * C + jnp.einsum('bhs,bshv,bshd->bhvd', w_s, v, k)
    n_new = w_state[..., None] * n + jnp.einsum('bhs,bshd->bhd', w_s, k)
    return (C_new, n_new, m_new), h.transpose(0, 2, 1, 3)


def _mlstm_prompt(q, k, v, ig, lf):
    B, S = q.shape[:2]
    nc = S // CHUNK

    def to_chunks(a):
        return a.reshape((B, nc, CHUNK) + a.shape[2:]).swapaxes(0, 1)

    init = (jnp.zeros((B, M_HEADS, M_HEAD_DIM, M_HEAD_DIM), jnp.float32),
            jnp.zeros((B, M_HEADS, M_HEAD_DIM), jnp.float32),
            jnp.zeros((B, M_HEADS), jnp.float32))
    carry, hs = lax.scan(_mlstm_chunk, init, tuple(to_chunks(a) for a in (q, k, v, ig, lf)))
    return hs.swapaxes(0, 1).reshape(B, S, M_HEADS, M_HEAD_DIM), carry


def _mlstm_out(h, o, g):
    B, L = h.shape[:2]
    mu = jnp.mean(h, axis=-1, keepdims=True)
    var = jnp.mean(jnp.square(h - mu), axis=-1, keepdims=True)
    hn = ((h - mu) * lax.rsqrt(var + LN_EPS)).reshape(B, L, M_WIDTH)
    return (hn * g * jax.nn.sigmoid(o.astype(jnp.float32))).astype(o.dtype)


def _merge(o_a, o_b, ga, gb, w_branch_a, w_branch_b, w_out):
    m = jax.nn.sigmoid(ga) * (o_a @ w_branch_a) + jax.nn.sigmoid(gb) * (o_b @ w_branch_b)
    return m @ w_out


def _mixer_prompt(h, w_in, b_in, conv_w, conv_b, norm_g, w_branch_a, w_branch_b, w_out):
    B = h.shape[0]
    buf0 = jnp.zeros((B, CONV_W - 1, 2 * M_WIDTH), h.dtype)
    fox, mls, ga, gb, new_buf = _branch_inputs(h, w_in, b_in, conv_w, conv_b, buf0)
    aq, ak, av, alf = fox
    o_a = _fox_prompt(aq, ak, av, alf)
    mq, mk, mv, mi, mf, mo = mls
    hm, (C, n, m) = _mlstm_prompt(mq, mk, mv, mi, mf)
    o_b = _mlstm_out(hm, mo, norm_g)
    y = _merge(o_a, o_b, ga, gb, w_branch_a, w_branch_b, w_out)
    return y, (ak, av, alf, C, n, m, new_buf)


def _mixer_sample(h, k_cache, v_cache, logf_cache, C0, n0, m0, conv_buf,
                  w_in, b_in, conv_w, conv_b, norm_g, w_branch_a, w_branch_b, w_out):
    fox, mls, ga, gb, new_buf = _branch_inputs(h, w_in, b_in, conv_w, conv_b, conv_buf)
    aq, ak, av, alf = fox
    o_a = _fox_sample(aq, ak, av, alf, k_cache, v_cache, logf_cache)
    mq, mk, mv, mi, mf, mo = mls
    carry0 = (C0.astype(jnp.float32), n0.astype(jnp.float32), m0.astype(jnp.float32))
    (C, n, m), hm = _mlstm_chunk(carry0, (mq, mk, mv, mi, mf))
    o_b = _mlstm_out(hm, mo, norm_g)
    y = _merge(o_a, o_b, ga, gb, w_branch_a, w_branch_b, w_out)
    return y, (ak, av, alf, C, n, m, new_buf)


def _trunk_layer(x, c, mixer_fn, w_ada, b_ada, ffn1_w_gu, ffn1_w_down, ffn2_w_gu, ffn2_w_down, ln_g, ln_b):
    mod = jax.nn.silu(c) @ w_ada + b_ada
    sh1, sc1, g1, sh2, sc2, g2, sh3, sc3, g3 = jnp.split(mod[:, None, :], 9, axis=-1)
    h = x * (1 + sc1) + sh1
    x = _layer_norm(ALPHA * x + 0.5 * g1 * _ffn(h, ffn1_w_gu, ffn1_w_down), ln_g[0], ln_b[0])
    h = x * (1 + sc2) + sh2
    mix, new_state = mixer_fn(h)
    x = _layer_norm(ALPHA * x + g2 * mix, ln_g[1], ln_b[1])
    h = x * (1 + sc3) + sh3
    x = _layer_norm(ALPHA * x + 0.5 * g3 * _ffn(h, ffn2_w_gu, ffn2_w_down), ln_g[2], ln_b[2])
    return x, new_state


def setup_inputs(seed: int = 0) -> dict:
    key = jax.random.key(seed)
    ks = jax.random.split(key, 32)
    nrm = jax.random.normal
    f32 = jnp.float32
    D = D_MODEL
    off = [int(o) for o in np.cumsum((0,) + IN_SIZES)]
    b_in = 0.02 * nrm(ks[0], (DEPTH, D_IN), f32)
    b_in = b_in.at[:, off[3]:off[4]].add(jnp.linspace(1.0, 4.0, A_HEADS))
    b_in = b_in.at[:, off[8]:off[9]].add(jnp.linspace(3.0, 6.0, M_HEADS))
    return {
        "x_prompt": nrm(ks[1], (BATCH, SEQ, D), f32),
        "x_sample": nrm(ks[2], (DEC_BATCH, DEC_SEQ, D), f32),
        "cache_fox_k": nrm(ks[3], (DEPTH, DEC_BATCH, PAST_LEN, A_HEADS, A_HEAD_DIM), f32),
        "cache_fox_v": nrm(ks[4], (DEPTH, DEC_BATCH, PAST_LEN, A_HEADS, A_HEAD_DIM), f32),
        "cache_fox_logf": jax.nn.log_sigmoid(3.0 + nrm(ks[5], (DEPTH, DEC_BATCH, PAST_LEN, A_HEADS), f32)),
        "state_mlstm_C": 0.1 * nrm(ks[6], (DEPTH, DEC_BATCH, M_HEADS, M_HEAD_DIM, M_HEAD_DIM), f32),
        "state_mlstm_n": 0.1 * nrm(ks[7], (DEPTH, DEC_BATCH, M_HEADS, M_HEAD_DIM), f32),
        "state_mlstm_m": nrm(ks[8], (DEPTH, DEC_BATCH, M_HEADS), f32),
        "state_conv": nrm(ks[9], (DEPTH, DEC_BATCH, CONV_W - 1, 2 * M_WIDTH), f32),
        "c_prompt": nrm(ks[10], (BATCH, D), f32),
        "c_sample": nrm(ks[11], (DEC_BATCH, D), f32),
        "w_ada": 0.5 * D ** -0.5 * nrm(ks[12], (DEPTH, D, 9 * D), f32),
        "b_ada": 0.02 * nrm(ks[13], (DEPTH, 9 * D), f32),
        "ffn1_w_gu": D ** -0.5 * nrm(ks[14], (DEPTH, D, 2 * D_FF), f32),
        "ffn1_w_down": BETA * D_FF ** -0.5 * nrm(ks[15], (DEPTH, D_FF, D), f32),
        "w_in": D ** -0.5 * nrm(ks[16], (DEPTH, D, D_IN), f32),
        "b_in": b_in,
        "conv_w": CONV_W ** -0.5 * nrm(ks[17], (DEPTH, CONV_W, 2 * M_WIDTH), f32),
        "conv_b": 0.02 * nrm(ks[18], (DEPTH, 2 * M_WIDTH), f32),
        "mlstm_norm_g": 1.0 + 0.02 * nrm(ks[19], (DEPTH, M_WIDTH), f32),
        "w_branch_a": A_WIDTH ** -0.5 * nrm(ks[20], (DEPTH, A_WIDTH, D), f32),
        "w_branch_b": M_WIDTH ** -0.5 * nrm(ks[21], (DEPTH, M_WIDTH, D), f32),
        "w_out": BETA * D ** -0.5 * nrm(ks[22], (DEPTH, D, D), f32),
        "ffn2_w_gu": D ** -0.5 * nrm(ks[23], (DEPTH, D, 2 * D_FF), f32),
        "ffn2_w_down": BETA * D_FF ** -0.5 * nrm(ks[24], (DEPTH, D_FF, D), f32),
        "ln_g": 1.0 + 0.02 * nrm(ks[25], (DEPTH, 3, D), f32),
        "ln_b": 0.02 * nrm(ks[26], (DEPTH, 3, D), f32),
    }


def reference(x_prompt, x_sample, cache_fox_k, cache_fox_v, cache_fox_logf, state_mlstm_C,
              state_mlstm_n, state_mlstm_m, state_conv, c_prompt, c_sample, w_ada, b_ada,
              ffn1_w_gu, ffn1_w_down, w_in, b_in, conv_w, conv_b, mlstm_norm_g, w_branch_a,
              w_branch_b, w_out, ffn2_w_gu, ffn2_w_down, ln_g, ln_b):
    xp, xs = x_prompt, x_sample
    sp = [[] for _ in range(7)]
    ss = [[] for _ in range(7)]
    for l in range(DEPTH):
        mix_w = (w_in[l], b_in[l], conv_w[l], conv_b[l], mlstm_norm_g[l], w_branch_a[l], w_branch_b[l], w_out[l])
        layer_w = (w_ada[l], b_ada[l], ffn1_w_gu[l], ffn1_w_down[l], ffn2_w_gu[l], ffn2_w_down[l], ln_g[l], ln_b[l])
        xp, st_p = _trunk_layer(xp, c_prompt, lambda h: _mixer_prompt(h, *mix_w), *layer_w)
        xs, st_s = _trunk_layer(
            xs, c_sample,
            lambda h: _mixer_sample(h, cache_fox_k[l], cache_fox_v[l], cache_fox_logf[l], state_mlstm_C[l],
                                    state_mlstm_n[l], state_mlstm_m[l], state_conv[l], *mix_w),
            *layer_w)
        for j in range(7):
            sp[j].append(st_p[j])
            ss[j].append(st_s[j])
    fox_k_p, fox_v_p, fox_logf_p, mlstm_C_p, mlstm_n_p, mlstm_m_p, conv_p = [jnp.stack(a, 0) for a in sp]
    fox_k_s, fox_v_s, fox_logf_s, mlstm_C_s, mlstm_n_s, mlstm_m_s, conv_s = [jnp.stack(a, 0) for a in ss]
    return (xp, xs, fox_k_p, fox_v_p, fox_logf_p, mlstm_C_p, mlstm_n_p, mlstm_m_p, conv_p,
            fox_k_s, fox_v_s, fox_logf_s, mlstm_C_s, mlstm_n_s, mlstm_m_s, conv_s)
```

```cpp
#include <hip/hip_runtime.h>
#include <hip/hip_cooperative_groups.h>
#include <cstdio>
#include <cstdint>
#include <type_traits>
namespace cg = cooperative_groups;
namespace pg8 {
#define PG8_LAS __attribute__((address_space(3)))
typedef unsigned short bf16_t;
typedef short bf16x8 __attribute__((ext_vector_type(8)));
typedef float f32x4 __attribute__((ext_vector_type(4)));
typedef unsigned u32x4 __attribute__((ext_vector_type(4)));
constexpr int BM = 256, BK = 64, HALF = 128, HTB = HALF * BK * 2  , STAGE_BYTES = 8 * HTB, NXCD = 8, WGM = 8;

__host__ __device__ __forceinline__ int lds_byte(int r, int c) { const int st = (r >> 4) * 2 + (c >> 5), rr = r & 15, cc = c & 31, ob = rr * 64 + cc * 2; return st * 1024 + (ob ^ (((ob >> 9) & 1) << 5)); }
__host__ __device__ __forceinline__ void stage_rc(int b, int& R, int& C) { const int st = b / 1024, sb = b % 1024, swz = sb ^ (((sb >> 9) & 1) << 5); R = (st >> 1) * 16 + swz / 64; C = (st & 1) * 32 + (swz % 64) / 2; }
__host__ __device__ __forceinline__ int perm32(int rho) { const int n = rho >> 4, i = rho & 15; return 8 * (i >> 2) + 4 * n + (i & 3); }

struct Unit { int pm, pn; };
struct Gemm { const bf16_t* A; const bf16_t* Bt; int M, N, K; };

struct StaticOrder {
    int nM, nN, nwg, G, c;
    __host__ __device__ void init(int M, int N, int G_, int c_) { nM = M / BM; nN = N / BM; nwg = nM * nN; G = G_; c = c_; }
    __host__ __device__ bool next(int i, Unit& u) const {
        const long L = (long)i * G + c; if (L >= nwg) return false;
        int wgid = (int)L; { const int q = nwg / NXCD, r = nwg % NXCD, xcd = wgid % NXCD, off = wgid / NXCD; wgid = (xcd < r ? xcd * (q + 1) : r * (q + 1) + (xcd - r) * q) + off; }
        const int nig = WGM * nN, gid = wgid / nig, fm = gid * WGM, gsz = (nM - fm) < WGM ? (nM - fm) : WGM;
        u.pm = fm + ((wgid % nig) % gsz); u.pn = (wgid % nig) / gsz; return true;
    }
    __device__ __forceinline__ void a_ready(const Unit&) const {}
    __device__ __forceinline__ void done(const Unit&) const {}
};
__device__ __forceinline__ unsigned cvt_pk_bf16(float lo, float hi) { unsigned r; asm volatile("v_cvt_pk_bf16_f32 %0, %1, %2" : "=v"(r) : "v"(lo), "v"(hi)); return r; }
template <class Epi, class Sched, bool STAMP = false>
__device__ __forceinline__ void gemm_phase(PG8_LAS unsigned char* lds, const Gemm g, const Sched& S, const Epi& E, unsigned long long* stamps) {
    int tid_ = threadIdx.x; asm volatile("" : "+v"(tid_));
    const int tid = tid_, wid = __builtin_amdgcn_readfirstlane(tid >> 6), lane = tid & 63, wr = wid >> 2, wc = wid & 3, fr = lane & 15, fq = lane >> 4;
    const int K = g.K, nt = K / BK;
    int ts_lo = 0, ts_hi = 0, nts = 0; const unsigned long long rt_entry = STAMP ? (unsigned long long)wall_clock64() : 0ull;
#define PG8_STAMP() do { if (STAMP && wid == 0 && nts < 64) { const unsigned long long _c = (unsigned long long)clock64(); \
        ts_lo = (lane == nts) ? (int)(unsigned)_c : ts_lo; ts_hi = (lane == nts) ? (int)(unsigned)(_c >> 32) : ts_hi; ++nts; } } while (0)
    PG8_STAMP();
    unsigned voffA[2], voffB[2];
#pragma unroll
    for (int i = 0; i < 2; ++i) { int R, C; stage_rc(tid * 16 + i * 8192, R, C); const int Rb = Epi::PERM ? ((R & ~31) + perm32(R & 31)) : R;
        voffA[i] = (unsigned)(R * K + C) * 2u; voffB[i] = (unsigned)(Rb * K + C) * 2u; }
    const size_t kstep = (size_t)(BK * 2);
    const size_t hstep = (size_t)HALF * K * 2;
    const size_t tstep = 2 * hstep;
    const unsigned ldsw = (unsigned)wid * 1024u;
    const int aoff = lds_byte(wr * 64 + fr, fq * 8), boff = lds_byte(wc * 32 + fr, fq * 8);
#define PG8_SA(b, h) (((b) * 2 + (h)) * HTB)
#define PG8_SB(b, h) ((4 + (b) * 2 + (h)) * HTB)
#define PG8_STAGE(bufoff, gbase, voff) do { _Pragma("unroll") for (int _i = 0; _i < 2; ++_i) \
        __builtin_amdgcn_global_load_lds((const unsigned*)((const char*)(gbase) + (voff)[_i]), (PG8_LAS unsigned*)(lds + (bufoff) + ldsw + _i * 8192), 16, 0, 0); } while (0)
#define PG8_LDA(dst, b, h) do { _Pragma("unroll") for (int m = 0; m < 4; ++m) _Pragma("unroll") for (int k = 0; k < 2; ++k) dst[m][k] = *(const PG8_LAS bf16x8*)(lds + PG8_SA(b, h) + aoff + m * 2048 + k * 1024); } while (0)
#define PG8_LDB(dst, b, h) do { _Pragma("unroll") for (int n = 0; n < 2; ++n) _Pragma("unroll") for (int k = 0; k < 2; ++k) dst[n][k] = *(const PG8_LAS bf16x8*)(lds + PG8_SB(b, h) + boff + n * 2048 + k * 1024); } while (0)
#define PG8_MMA(ai, bj, At, Bt) do { __builtin_amdgcn_s_setprio(1); _Pragma("unroll") for (int m = 0; m < 4; ++m) _Pragma("unroll") for (int n = 0; n < 2; ++n) _Pragma("unroll") for (int k = 0; k < 2; ++k) \
        acc[ai][bj][m][n] = __builtin_amdgcn_mfma_f32_16x16x32_bf16(Bt[n][k], At[m][k], acc[ai][bj][m][n], 0, 0, 0); __builtin_amdgcn_s_setprio(0); } while (0)
#define PG8_WAIT_V(n) asm volatile("s_waitcnt vmcnt(" #n ")" ::: "memory")
#define PG8_WAIT_L(n) asm volatile("s_waitcnt lgkmcnt(" #n ")" ::: "memory")
#define PG8_BAR __builtin_amdgcn_s_barrier()
#define PG8_SCHED __builtin_amdgcn_sched_barrier(0)
    Unit cur, nxt; int ui = 0;
    if (!S.next(0, cur)) return;
    f32x4 acc[2][2][4][2];
#pragma unroll
    for (int a = 0; a < 2; ++a)
#pragma unroll
        for (int b = 0; b < 2; ++b)
#pragma unroll
            for (int m = 0; m < 4; ++m)
#pragma unroll
                for (int n = 0; n < 2; ++n) acc[a][b][m][n] = (f32x4){0.f, 0.f, 0.f, 0.f};
    bf16x8 At[4][2], B0[2][2], B1[2][2];
    const char* cA = (const char*)g.A + (size_t)cur.pm * tstep; const char* cB = (const char*)g.Bt + (size_t)cur.pn * tstep;
    S.a_ready(cur);
    PG8_STAGE(PG8_SB(0, 0), cB, voffB); PG8_STAGE(PG8_SA(0, 0), cA, voffA); PG8_STAGE(PG8_SB(0, 1), cB + hstep, voffB); PG8_STAGE(PG8_SA(0, 1), cA + hstep, voffA);
    if (wr == 1) PG8_BAR;
    PG8_WAIT_V(4); PG8_BAR;
    PG8_STAGE(PG8_SB(1, 0), cB + kstep, voffB); PG8_STAGE(PG8_SA(1, 0), cA + kstep, voffA); PG8_STAGE(PG8_SB(1, 1), cB + hstep + kstep, voffB);
    PG8_WAIT_V(6); PG8_BAR;
    PG8_STAMP();
    for (;;) {
        const bool has_next = S.next(ui + 1, nxt);
        const char* nA = has_next ? (const char*)g.A + (size_t)nxt.pm * tstep : cA; const char* nB = has_next ? (const char*)g.Bt + (size_t)nxt.pn * tstep : cB;
        for (int t = 0; t < nt; t += 2) {
            const bool last = (t == nt - 2);
            const char* a1 = cA + (size_t)(t + 1) * kstep;
            const char* a2 = last ? nA : cA + (size_t)(t + 2) * kstep; const char* b2 = last ? nB : cB + (size_t)(t + 2) * kstep;
            const char* a3 = a2 + kstep; const char* b3 = b2 + kstep;
            if (last && has_next) S.a_ready(nxt);
            PG8_LDB(B0, 0, 0); PG8_SCHED; PG8_LDA(At, 0, 0); PG8_STAGE(PG8_SA(1, 1), a1 + hstep, voffA);
            PG8_WAIT_L(8); PG8_BAR; PG8_WAIT_L(0); PG8_MMA(0, 0, At, B0); PG8_BAR; PG8_SCHED;
            PG8_LDB(B1, 0, 1); PG8_STAGE(PG8_SB(0, 0), b2, voffB);
            PG8_BAR; PG8_WAIT_L(0); PG8_MMA(0, 1, At, B1); PG8_BAR;
            PG8_LDA(At, 0, 1); PG8_STAGE(PG8_SA(0, 0), a2, voffA);
            PG8_BAR; PG8_WAIT_L(0); PG8_MMA(1, 0, At, B0); PG8_BAR; PG8_SCHED;
            PG8_STAGE(PG8_SB(0, 1), b2 + hstep, voffB);
            PG8_WAIT_V(6); PG8_BAR; PG8_MMA(1, 1, At, B1); PG8_BAR;
            PG8_LDB(B0, 1, 0); PG8_SCHED; PG8_LDA(At, 1, 0); PG8_STAGE(PG8_SA(0, 1), a2 + hstep, voffA);
            PG8_WAIT_L(8); PG8_BAR; PG8_WAIT_L(0); PG8_MMA(0, 0, At, B0); PG8_BAR; PG8_SCHED;
            PG8_LDB(B1, 1, 1); PG8_STAGE(PG8_SB(1, 0), b3, voffB);
            PG8_BAR; PG8_WAIT_L(0); PG8_MMA(0, 1, At, B1); PG8_BAR;
            PG8_LDA(At, 1, 1); PG8_STAGE(PG8_SA(1, 0), a3, voffA);
            PG8_BAR; PG8_WAIT_L(0); PG8_MMA(1, 0, At, B0); PG8_BAR; PG8_SCHED;
            PG8_STAGE(PG8_SB(1, 1), b3 + hstep, voffB);
            PG8_WAIT_V(6); PG8_BAR; PG8_MMA(1, 1, At, B1); PG8_BAR;
        }
        PG8_STAMP();
        if constexpr (!Epi::AFTER_DRAIN) { E(acc, cur, wr, wc, fr, fq); S.done(cur); }
        PG8_STAMP();
        if (!has_next) break;
#pragma unroll
        for (int a = 0; a < 2; ++a)
#pragma unroll
            for (int b = 0; b < 2; ++b)
#pragma unroll
                for (int m = 0; m < 4; ++m)
#pragma unroll
                    for (int n = 0; n < 2; ++n) acc[a][b][m][n] = (f32x4){0.f, 0.f, 0.f, 0.f};
        cur = nxt; cA = nA; cB = nB; ++ui;
    }
    PG8_WAIT_V(0);
    if (wr == 0) PG8_BAR;
    PG8_BAR;
    if constexpr (Epi::AFTER_DRAIN) { E.fused(acc, cur, wr, wc, fr, fq, lds, wid, lane); S.done(cur); }
    PG8_STAMP();
    if (STAMP && wid == 0) { stamps[lane] = lane < nts ? (((unsigned long long)(unsigned)ts_hi << 32) | (unsigned)ts_lo) : 0ull;
        if (lane == 62) stamps[62] = rt_entry; if (lane == 63) stamps[63] = (unsigned long long)wall_clock64(); }
#undef PG8_STAMP
#undef PG8_SA
#undef PG8_SB
#undef PG8_STAGE
#undef PG8_LDA
#undef PG8_LDB
#undef PG8_MMA
#undef PG8_WAIT_V
#undef PG8_WAIT_L
#undef PG8_BAR
#undef PG8_SCHED
}
}
typedef unsigned short u16;
using pg8::f32x4; using pg8::u32x4; using pg8::bf16x8;
typedef float f32x16 __attribute__((ext_vector_type(16)));

constexpr int TP = 32768, TS = 256, T = TP + TS, D = 1024, FF = 2816, SEQ = 16384, PAST = 2048;
constexpr float ALPHA = 1.189207115002721f, LN_EPS = 1e-5f, LOG2E = 1.4426950408889634f, C2 = 0.125f * LOG2E;
constexpr int NTHR = 512, LDS_BYTES = 148480, MISC_OFF = 147712;
#ifndef PRUNE
#define PRUNE 1
#endif
constexpr float PRUNE_TH = 32.f;

constexpr size_t O_YP = 0, O_YS = 33554432, O_KP = 33816576, O_VP = 50593792, O_LFP = 67371008, O_CP = 67633152, O_NP = 67764224, O_MP = 67765248,
                 O_CONVP = 67765256, O_KS = 67771400, O_VS = 67902472, O_LFS = 68033544, O_CS = 68035592, O_NS = 69084168, O_MS = 69092360, O_CONVS = 69092424;
constexpr size_t MiB = 1u << 20;
constexpr size_t WS_CTL = 0, WS_MOD = 1 * MiB, WS_BIN = 2 * MiB;
constexpr size_t WS_F2 = 3 * MiB;
constexpr size_t WS_MI = 4 * MiB;
constexpr size_t WS_MLF = 5 * MiB;
constexpr size_t WS_MB = 6 * MiB;
constexpr size_t WS_MM = 7 * MiB;
constexpr size_t WS_UN = 8 * MiB;
constexpr size_t WS_MST = 9 * MiB;
constexpr size_t WS_WGU1 = 10 * MiB, WS_WD1 = 21 * MiB, WS_WIN = 27 * MiB, WS_WBA = 39 * MiB, WS_WBB = 40 * MiB, WS_WOUT = 41 * MiB, WS_WGU2 = 43 * MiB, WS_WD2 = 54 * MiB;
constexpr size_t WS_X = 60 * MiB, WS_H = 189 * MiB, WS_ACT = 254 * MiB;
constexpr size_t QSZ = (size_t)T * 512 * 2;
constexpr size_t WS_AQ = WS_ACT, WS_AK = WS_AQ + QSZ, WS_AV = WS_AK + QSZ, WS_PRE = WS_AV + QSZ;
constexpr size_t WS_U = WS_AK, WS_GA = WS_PRE, WS_GB = WS_AK;
constexpr size_t WS_MV = 432 * MiB, WS_SIGO = WS_MV + QSZ, WS_END = WS_SIGO + QSZ;
static_assert(WS_PRE + 2 * QSZ <= WS_ACT + (size_t)T * FF * 2 + 16 * MiB && WS_ACT + (size_t)T * FF * 2 <= WS_MV && WS_END <= 512 * MiB, "ws map");

struct Params { const float* in[27]; float* out; unsigned char* ws; };

__device__ __forceinline__ float bf2f(u16 b) { return __uint_as_float(((unsigned)b) << 16); }
__device__ __forceinline__ u16 f2bf(float f) { unsigned u = __float_as_uint(f); return (u16)((u + 0x7fffu + ((u >> 16) & 1u)) >> 16); }
__device__ __forceinline__ unsigned pk2(float lo, float hi) { return (unsigned)f2bf(lo) | ((unsigned)f2bf(hi) << 16); }
__device__ __forceinline__ float sigm(float x) { return 1.f / (1.f + __expf(-x)); }
__device__ __forceinline__ float siluf(float x) { return x / (1.f + __expf(-x)); }
__device__ __forceinline__ float logsig(float x) { return fminf(x, 0.f) - log1pf(__expf(-fabsf(x))); }
__device__ __forceinline__ int modrow(int t) { return t < TP ? (t >> 14) : 2 + ((t - TP) >> 4); }
__device__ __forceinline__ float wsum(float v) { for (int m = 32; m >= 1; m >>= 1) v += __shfl_xor(v, m); return v; }
__device__ __forceinline__ float wmax(float v) { for (int m = 32; m >= 1; m >>= 1) v = fmaxf(v, __shfl_xor(v, m)); return v; }
__device__ __forceinline__ int crow(int r, int hi) { return (r & 3) + 8 * (r >> 2) + 4 * hi; }

struct EpiGU { static constexpr bool PERM = true, AFTER_DRAIN = false; u16* ACT;
  __device__ __forceinline__ void operator()(const f32x4 (&acc)[2][2][4][2], const pg8::Unit& u, int wr, int wc, int fr, int fq) const {
    const int row0 = u.pm * 256 + wr * 64 + fr, col0 = u.pn * 128 + wc * 32 + 8 * fq;
#pragma unroll
    for (int ai = 0; ai < 2; ++ai)
#pragma unroll
      for (int m = 0; m < 4; ++m) { const size_t row = row0 + ai * 128 + m * 16;
        const f32x4 g0 = acc[ai][0][m][0], g1 = acc[ai][0][m][1], u0 = acc[ai][1][m][0], u1 = acc[ai][1][m][1];
        u32x4 o; o[0] = pk2(siluf(g0[0]) * u0[0], siluf(g0[1]) * u0[1]); o[1] = pk2(siluf(g0[2]) * u0[2], siluf(g0[3]) * u0[3]);
        o[2] = pk2(siluf(g1[0]) * u1[0], siluf(g1[1]) * u1[1]); o[3] = pk2(siluf(g1[2]) * u1[2], siluf(g1[3]) * u1[3]);
        *(u32x4*)(ACT + row * FF + col0) = o; }
  } };

struct EpiRes { static constexpr bool PERM = false, AFTER_DRAIN = false; const float* xp; const float* xs; float* X; const float* gate; float gs;
  __device__ __forceinline__ void operator()(const f32x4 (&acc)[2][2][4][2], const pg8::Unit& u, int wr, int wc, int fr, int fq) const {
    const int row0 = u.pm * 256 + wr * 64 + fr, col0 = u.pn * 256 + wc * 32 + 4 * fq;
#pragma unroll
    for (int ai = 0; ai < 2; ++ai)
#pragma unroll
      for (int m = 0; m < 4; ++m) { const int row = row0 + ai * 128 + m * 16;
        const float* xr = row < TP ? xp + (size_t)row * D : xs + (size_t)(row - TP) * D; const float* gr = gate + modrow(row) * 9216; float* o = X + (size_t)row * D;
#pragma unroll
        for (int bj = 0; bj < 2; ++bj)
#pragma unroll
          for (int n = 0; n < 2; ++n) { const int c = col0 + bj * 128 + n * 16; const f32x4 xv = *(const f32x4*)(xr + c), gv = *(const f32x4*)(gr + c);
            *(f32x4*)(o + c) = xv * ALPHA + gv * acc[ai][bj][m][n] * gs; } }
  } };

struct EpiIn { static constexpr bool PERM = true, AFTER_DRAIN = false; u16 *AQ, *AK, *AV, *PRE, *MV, *SIGO; float *MI, *MLF; const float* bias; float* out;
  __device__ __forceinline__ void operator()(const f32x4 (&acc)[2][2][4][2], const pg8::Unit& u, int wr, int wc, int fr, int fq) const {
    const int row0 = u.pm * 256 + wr * 64 + fr, pn = u.pn;
#pragma unroll
    for (int ai = 0; ai < 2; ++ai)
#pragma unroll
      for (int m = 0; m < 4; ++m) { const int row = row0 + ai * 128 + m * 16;
#pragma unroll
        for (int bj = 0; bj < 2; ++bj) { const int cl = 128 * bj + 32 * wc + 8 * fq, pc = 256 * pn + cl;
          f32x4 v0 = acc[ai][bj][m][0] + *(const f32x4*)(bias + pc), v1 = acc[ai][bj][m][1] + *(const f32x4*)(bias + pc + 4);
          if (pn < 2) { u32x4 o = {pk2(v0[0] * C2, v0[1] * C2), pk2(v0[2] * C2, v0[3] * C2), pk2(v1[0] * C2, v1[1] * C2), pk2(v1[2] * C2, v1[3] * C2)};
            *(u32x4*)(AQ + (size_t)row * 512 + pc) = o; }
          else if (pn < 6) { const int col = (pn < 4) ? pc - 512 : pc - 1024; u16* B = (pn < 4) ? AK : AV;
            u32x4 o = {pk2(v0[0], v0[1]), pk2(v0[2], v0[3]), pk2(v1[0], v1[1]), pk2(v1[2], v1[3])}; *(u32x4*)(B + (size_t)row * 512 + col) = o;
            float* op = (row < TP) ? out + ((pn < 4) ? O_KP : O_VP) + (size_t)row * 512 + col : out + ((pn < 4) ? O_KS : O_VS) + (size_t)(row - TP) * 512 + col;
            *(f32x4*)op = v0; *(f32x4*)(op + 4) = v1; }
          else if (pn < 10) { const int col = pc - 1536;
            u32x4 o = {pk2(v0[0], v0[1]), pk2(v0[2], v0[3]), pk2(v1[0], v1[1]), pk2(v1[2], v1[3])}; *(u32x4*)(PRE + (size_t)row * 1024 + col) = o;
            if (row < TP) { const int s = row & (SEQ - 1); if (s >= SEQ - 3) { float* op = out + O_CONVP + ((size_t)(row >> 14) * 3 + (s - (SEQ - 3))) * 1024 + col; *(f32x4*)op = v0; *(f32x4*)(op + 4) = v1; } }
            else { const int l = (row - TP) & 15; if (l >= 13) { float* op = out + O_CONVS + ((size_t)((row - TP) >> 4) * 3 + (l - 13)) * 1024 + col; *(f32x4*)op = v0; *(f32x4*)(op + 4) = v1; } } }
          else if (pn < 12) { u32x4 o = {pk2(v0[0], v0[1]), pk2(v0[2], v0[3]), pk2(v1[0], v1[1]), pk2(v1[2], v1[3])}; *(u32x4*)(MV + (size_t)row * 512 + (pc - 2560)) = o; }
          else if (pn < 14) { u32x4 o = {pk2(sigm(v0[0]), sigm(v0[1])), pk2(sigm(v0[2]), sigm(v0[3])), pk2(sigm(v1[0]), sigm(v1[1])), pk2(sigm(v1[2]), sigm(v1[3]))};
            *(u32x4*)(SIGO + (size_t)row * 512 + (pc - 3072)) = o; }
          else { if (bj == 0 && wc == 0) {
              if (fq == 0) { float* op = (row < TP) ? out + O_LFP + (size_t)row * 8 : out + O_LFS + (size_t)(row - TP) * 8;
                f32x4 a = {logsig(v0[0]), logsig(v0[1]), logsig(v0[2]), logsig(v0[3])}, b = {logsig(v1[0]), logsig(v1[1]), logsig(v1[2]), logsig(v1[3])};
                *(f32x4*)op = a; *(f32x4*)(op + 4) = b; }
              else if (fq == 1) { *(f32x4*)(MI + (size_t)row * 4) = v0; f32x4 b = {logsig(v1[0]), logsig(v1[1]), logsig(v1[2]), logsig(v1[3])}; *(f32x4*)(MLF + (size_t)row * 4) = b; } } }
        } }
  } };

template <int MODE> struct EpiMerge { static constexpr bool PERM = true, AFTER_DRAIN = false; u16* O; const u16* Aa; const float* bias;
  __device__ __forceinline__ void operator()(const f32x4 (&acc)[2][2][4][2], const pg8::Unit& u, int wr, int wc, int fr, int fq) const {
    const int row0 = u.pm * 256 + wr * 64 + fr, col0 = u.pn * 256 + wc * 32 + 8 * fq;
#pragma unroll
    for (int ai = 0; ai < 2; ++ai)
#pragma unroll
      for (int m = 0; m < 4; ++m) { const size_t row = row0 + ai * 128 + m * 16;
#pragma unroll
        for (int bj = 0; bj < 2; ++bj) { const int c = col0 + bj * 128; u16* op = O + row * D + c; float r[8];
          const f32x4 a0 = acc[ai][bj][m][0], a1 = acc[ai][bj][m][1];
          if (MODE == 0) { const f32x4 b0 = *(const f32x4*)(bias + c), b1 = *(const f32x4*)(bias + c + 4);
#pragma unroll
            for (int j = 0; j < 4; ++j) { r[j] = sigm(a0[j] + b0[j]); r[4 + j] = sigm(a1[j] + b1[j]); } }
          else { const u32x4 ov = *(const u32x4*)op; float o[8];
#pragma unroll
            for (int j = 0; j < 4; ++j) { o[2 * j] = __uint_as_float(ov[j] << 16); o[2 * j + 1] = __uint_as_float(ov[j] & 0xffff0000u); }
            if (MODE == 1) {
#pragma unroll
              for (int j = 0; j < 4; ++j) { r[j] = o[j] * a0[j]; r[4 + j] = o[4 + j] * a1[j]; } }
            else { const u32x4 av = *(const u32x4*)(Aa + row * D + c); const float accv[8] = {a0[0], a0[1], a0[2], a0[3], a1[0], a1[1], a1[2], a1[3]};
#pragma unroll
              for (int j = 0; j < 4; ++j) { const float x0 = __uint_as_float(av[j] << 16), x1 = __uint_as_float(av[j] & 0xffff0000u);
                r[2 * j] = x0 + o[2 * j] * accv[2 * j]; r[2 * j + 1] = x1 + o[2 * j + 1] * accv[2 * j + 1]; } } }
          u32x4 w = {pk2(r[0], r[1]), pk2(r[2], r[3]), pk2(r[4], r[5]), pk2(r[6], r[7])}; *(u32x4*)op = w; } }
  } };

template <class Epi> __device__ __forceinline__ void run_gemm(unsigned char* lds, const u16* A, const u16* Bt, int N, int K, const Epi& E) {
  pg8::Gemm g; g.A = A; g.Bt = Bt; g.M = T; g.N = N; g.K = K;
  pg8::StaticOrder S; S.init(T, N, (int)gridDim.x, (int)blockIdx.x);
  pg8::gemm_phase<Epi, pg8::StaticOrder, false>((PG8_LAS unsigned char*)lds, g, S, E, nullptr);
  __syncthreads();
}

__device__ __forceinline__ int gu_map(int p) { const int t = p >> 8, r = p & 255; return r < 128 ? t * 128 + r : FF + t * 128 + (r - 128); }
__device__ __forceinline__ int in_map(int p) {
  if (p < 1536) return p; if (p < 2560) return 1544 + (p - 1536); if (p < 3072) return 2568 + (p - 2560); if (p < 3584) return 3088 + (p - 3072);
  if (p < 3592) return 1536 + (p - 3584); if (p < 3596) return 3080 + (p - 3592); if (p < 3600) return 3084 + (p - 3596); if (p < 3840) return -1;
  if (p < 4864) return 3600 + (p - 3840); return 4624 + (p - 4864); }

__device__ __forceinline__ void adaln_unit(const Params& p, float* mod, int unit, unsigned char* lds, int tid) {
  float* sc = (float*)lds; float* red = (float*)(lds + 73728);
  for (int i = tid; i < 18 * 1024; i += NTHR) { const int r = i >> 10, k = i & 1023; const float c = r < 2 ? p.in[9][r * 1024 + k] : p.in[10][(r - 2) * 1024 + k]; sc[i] = siluf(c); }
  __syncthreads();
  const int col = tid & 63, kg = tid >> 6; const float* W = p.in[11] + unit * 64 + col;
  float acc[18];
#pragma unroll
  for (int r = 0; r < 18; ++r) acc[r] = 0.f;
  for (int k = kg * 128; k < kg * 128 + 128; ++k) { const float w = W[(size_t)k * 9216];
#pragma unroll
    for (int r = 0; r < 18; ++r) acc[r] += sc[r * 1024 + k] * w; }
#pragma unroll
  for (int r = 0; r < 18; ++r) red[(kg * 18 + r) * 64 + col] = acc[r];
  __syncthreads();
  for (int i = tid; i < 18 * 64; i += NTHR) { const int r = i >> 6, c = i & 63; float s = 0.f; for (int g = 0; g < 8; ++g) s += red[(g * 18 + r) * 64 + c]; mod[r * 9216 + unit * 64 + c] = s + p.in[12][unit * 64 + c]; }
  __syncthreads();
}
template <int MAP> __device__ __forceinline__ void transpose_tile(const float* src, int ld, int K, u16* dst, int p0, int k0, unsigned char* lds, int tid) {
  u16* tl = (u16*)lds;
  { const int pp = tid & 63, kk = tid >> 6; const int sc = MAP == 0 ? p0 + pp : (MAP == 1 ? gu_map(p0 + pp) : in_map(p0 + pp));
#pragma unroll
    for (int i = 0; i < 8; ++i) { const int k = kk + 8 * i; const float v = sc >= 0 ? src[(size_t)(k0 + k) * ld + sc] : 0.f; tl[pp * 66 + k] = f2bf(v); } }
  __syncthreads();
  { const int row = tid >> 3, ch = tid & 7; const unsigned* s = (const unsigned*)(tl + row * 66 + ch * 8); u32x4 v = {s[0], s[1], s[2], s[3]};
    *(u32x4*)(dst + (size_t)(p0 + row) * K + k0 + ch * 8) = v; }
  __syncthreads();
}
__device__ __forceinline__ void prep_phase(const Params& p, unsigned char* lds, int tid) {
  unsigned char* ws = p.ws;
  if (blockIdx.x == 0) { int* ctl = (int*)(ws + WS_CTL); if (tid < 64) ctl[tid] = 0;
    float* bp = (float*)(ws + WS_BIN); for (int i = tid; i < 5888; i += NTHR) { const int s = in_map(i); bp[i] = s >= 0 ? p.in[16][s] : 0.f; } }
  constexpr int N0 = 88 * 16, N1 = 16 * 44, N2 = 92 * 16, N3 = 16 * 8, N4 = 16 * 8, N5 = 16 * 16, N6 = 88 * 16, N7 = 16 * 44;
  constexpr int total = 144 + N0 + N1 + N2 + N3 + N4 + N5 + N6 + N7;
  for (int w = blockIdx.x; w < total; w += gridDim.x) {
    if (w < 144) { adaln_unit(p, (float*)(ws + WS_MOD), w, lds, tid); continue; }
    int q = w - 144, j = 0;
    if (q >= N0) { q -= N0; j = 1; if (q >= N1) { q -= N1; j = 2; if (q >= N2) { q -= N2; j = 3; if (q >= N3) { q -= N3; j = 4; if (q >= N4) { q -= N4; j = 5; if (q >= N5) { q -= N5; j = 6; if (q >= N6) { q -= N6; j = 7; } } } } } } }
    switch (j) {
      case 0: transpose_tile<1>(p.in[13], 2 * FF, 1024, (u16*)(ws + WS_WGU1), (q >> 4) * 64, (q & 15) * 64, lds, tid); break;
      case 1: transpose_tile<0>(p.in[14], D, FF, (u16*)(ws + WS_WD1), (q / 44) * 64, (q % 44) * 64, lds, tid); break;
      case 2: transpose_tile<2>(p.in[15], 5648, 1024, (u16*)(ws + WS_WIN), (q >> 4) * 64, (q & 15) * 64, lds, tid); break;
      case 3: transpose_tile<0>(p.in[20], D, 512, (u16*)(ws + WS_WBA), (q >> 3) * 64, (q & 7) * 64, lds, tid); break;
      case 4: transpose_tile<0>(p.in[21], D, 512, (u16*)(ws + WS_WBB), (q >> 3) * 64, (q & 7) * 64, lds, tid); break;
      case 5: transpose_tile<0>(p.in[22], D, 1024, (u16*)(ws + WS_WOUT), (q >> 4) * 64, (q & 15) * 64, lds, tid); break;
      case 6: transpose_tile<1>(p.in[23], 2 * FF, 1024, (u16*)(ws + WS_WGU2), (q >> 4) * 64, (q & 15) * 64, lds, tid); break;
      default: transpose_tile<0>(p.in[24], D, FF, (u16*)(ws + WS_WD2), (q / 44) * 64, (q % 44) * 64, lds, tid); break;
    }
  }
}

template <int MODE> __device__ __forceinline__ void row_phase(const Params& p, int lnidx, int sh_off, int sc_off) {
  int t_ = threadIdx.x; asm volatile("" : "+v"(t_)); const int lane = t_ & 63, wave = t_ >> 6;
  float* X = (float*)(p.ws + WS_X); u16* H = (u16*)(p.ws + WS_H); const float* mod = (const float*)(p.ws + WS_MOD);
  for (int row = blockIdx.x * 8 + wave; row < T; row += gridDim.x * 8) {
    const float* src = MODE == 0 ? (row < TP ? p.in[0] + (size_t)row * D : p.in[1] + (size_t)(row - TP) * D) : X + (size_t)row * D;
    f32x4 v[4];
#pragma unroll
    for (int i = 0; i < 4; ++i) v[i] = *(const f32x4*)(src + lane * 4 + 256 * i);
    if (MODE != 0) {
      float s = 0.f;
#pragma unroll
      for (int i = 0; i < 4; ++i) s += v[i][0] + v[i][1] + v[i][2] + v[i][3];
      const float mu = wsum(s) * (1.f / D); float q = 0.f;
#pragma unroll
      for (int i = 0; i < 4; ++i) { v[i] = v[i] - mu; q += v[i][0] * v[i][0] + v[i][1] * v[i][1] + v[i][2] * v[i][2] + v[i][3] * v[i][3]; }
      const float rstd = rsqrtf(wsum(q) * (1.f / D) + LN_EPS);
#pragma unroll
      for (int i = 0; i < 4; ++i) { const int c = lane * 4 + 256 * i; const f32x4 g = *(const f32x4*)(p.in[25] + lnidx * D + c), b = *(const f32x4*)(p.in[26] + lnidx * D + c); v[i] = v[i] * rstd * g + b; }
    }
    if (MODE == 2) { float* dst = row < TP ? p.out + O_YP + (size_t)row * D : p.out + O_YS + (size_t)(row - TP) * D;
#pragma unroll
      for (int i = 0; i < 4; ++i) *(f32x4*)(dst + lane * 4 + 256 * i) = v[i]; }
    else { const float* mr = mod + modrow(row) * 9216;
#pragma unroll
      for (int i = 0; i < 4; ++i) { const int c = lane * 4 + 256 * i; if (MODE == 1) *(f32x4*)(X + (size_t)row * D + c) = v[i];
        const f32x4 sh = *(const f32x4*)(mr + sh_off + c), sc = *(const f32x4*)(mr + sc_off + c); const f32x4 h = v[i] * (sc + 1.f) + sh;
        uint2 w; w.x = pk2(h[0], h[1]); w.y = pk2(h[2], h[3]); *(uint2*)(H + (size_t)row * D + c) = w; } }
  }
}

__device__ __forceinline__ void scan_phase(const Params& p, unsigned char* lds, int tid) {
  unsigned char* ws = p.ws; float* sm = (float*)lds;
  const float* MI = (const float*)(ws + WS_MI); const float* MLF = (const float*)(ws + WS_MLF);
  for (int u = blockIdx.x; u < 24 + 512; u += gridDim.x) {
    if (u < 16) {
      const int b = u >> 3, h = u & 7; const float* lf = p.out + O_LFP + ((size_t)b * SEQ) * 8 + h; float* F2 = (float*)(ws + WS_F2) + ((size_t)b * SEQ) * 8 + h;
      float loc[32]; float tot = 0.f;
#pragma unroll
      for (int i = 0; i < 32; ++i) { tot += lf[(size_t)(tid * 32 + i) * 8]; loc[i] = tot; }
      sm[tid] = tot; __syncthreads();
      for (int off = 1; off < NTHR; off <<= 1) { const float v = tid >= off ? sm[tid - off] : 0.f; __syncthreads(); sm[tid] += v; __syncthreads(); }
      const float pre = sm[tid] - tot;
#pragma unroll
      for (int i = 0; i < 32; ++i) F2[(size_t)(tid * 32 + i) * 8] = (pre + loc[i]) * LOG2E;
      __syncthreads();
    } else if (u < 24) {
      const int sq = u - 16, b = sq >> 2, h = sq & 3; const size_t r0 = (size_t)b * SEQ;
      float* MB = (float*)(ws + WS_MB); float* MM = (float*)(ws + WS_MM); float* MST = (float*)(ws + WS_MST);
      float* sA = sm, *sC = sm + 256, *sS = sm + 512;
      if (tid < 256) { float bsum = 0.f, ml = -INFINITY; for (int i = 0; i < 64; ++i) { const size_t r = r0 + tid * 64 + i; const float lf = MLF[r * 4 + h], ig = MI[r * 4 + h]; bsum += lf; ml = fmaxf(lf + ml, ig); } sA[tid] = bsum; sC[tid] = ml; }
      __syncthreads();
      if (tid == 0) { float m = 0.f; for (int c = 0; c < 256; ++c) { sS[c] = m; m = fmaxf(sA[c] + m, sC[c]); } p.out[O_MP + sq] = m; }
      __syncthreads();
      if (tid < 256) { const float ms = sS[tid]; float bsum = 0.f, m = ms; for (int i = 0; i < 64; ++i) { const size_t r = r0 + tid * 64 + i; const float lf = MLF[r * 4 + h], ig = MI[r * 4 + h]; bsum += lf; m = fmaxf(lf + m, ig); MB[r * 4 + h] = bsum; MM[r * 4 + h] = m; }
        MST[sq * 256 + tid] = ms; MST[2048 + sq * 256 + tid] = __expf(bsum + ms - m); }
      __syncthreads();
    } else {
      const int v = u - 24, b = v >> 8, tile = v & 255; unsigned* mx = (unsigned*)lds;
      if (tid < 16) mx[tid] = 0u; __syncthreads();
      const int row = tid >> 3, h = tid & 7; const size_t r = (size_t)b * SEQ + tile * 64 + row;
      const u16* kp = (const u16*)(ws + WS_AK) + r * 512 + h * 64; const u16* qp = (const u16*)(ws + WS_AQ) + r * 512 + h * 64;
      float nk = 0.f, nq = 0.f;
#pragma unroll
      for (int i = 0; i < 8; ++i) { const u32x4 a = *(const u32x4*)(kp + i * 8), c = *(const u32x4*)(qp + i * 8);
#pragma unroll
        for (int j = 0; j < 4; ++j) { float x = __uint_as_float(a[j] << 16), y = __uint_as_float(a[j] & 0xffff0000u); nk += x * x + y * y; x = __uint_as_float(c[j] << 16); y = __uint_as_float(c[j] & 0xffff0000u); nq += x * x + y * y; } }
      atomicMax(&mx[h], __float_as_uint(nk)); atomicMax(&mx[8 + h], __float_as_uint(nq)); __syncthreads();
      if (tid < 16) { float* MST = (float*)(ws + WS_MST); const int hh = tid & 7; MST[(tid < 8 ? 4096 : 8192) + (b * 8 + hh) * 256 + tile] = sqrtf(__uint_as_float(mx[tid])) * 1.0001f; }
      __syncthreads();
    }
  }
}

__device__ __forceinline__ void attn_prompt_unit(const Params& p, int b, int h, int qb, unsigned char* lds, int tid) {
  unsigned char* ws = p.ws;
  const u16* AQ = (const u16*)(ws + WS_AQ); const u16* AK = (const u16*)(ws + WS_AK); const u16* AV = (const u16*)(ws + WS_AV); u16* OA = (u16*)(ws + WS_AQ);
  const float* F2 = (const float*)(ws + WS_F2); const float* MST = (const float*)(ws + WS_MST);
  u16* Ks = (u16*)lds;
  u16* Vt = (u16*)(lds + 18432);
  float* Fk = (float*)(lds + 36864);
  int* si = (int*)(lds + 37376);
  const int lane = tid & 63, wave = tid >> 6, r32 = lane & 31, hi = lane >> 5;
  const size_t rb = (size_t)b * SEQ; const int q0 = qb * 256; const int qrow = q0 + wave * 32 + r32;
  const int tend = 4 * qb + 3;
  int tstart = 0;
#if PRUNE
  { if (tid == 0) si[0] = 4 * qb; __syncthreads();
    const float* KM = MST + 4096 + (b * 8 + h) * 256; const float* QM = MST + 8192 + (b * 8 + h) * 256;
    const float q2 = fmaxf(fmaxf(QM[4 * qb], QM[4 * qb + 1]), fmaxf(QM[4 * qb + 2], QM[4 * qb + 3]));
    const float kd = fmaxf(fmaxf(KM[4 * qb], KM[4 * qb + 1]), fmaxf(KM[4 * qb + 2], KM[4 * qb + 3]));
    const float lower = -q2 * kd; const float fq0 = F2[(rb + q0) * 8 + h];
    if (tid < 4 * qb) { const float upper = q2 * KM[tid] + fq0 - F2[(rb + tid * 64 + 63) * 8 + h]; if (!(upper - lower < -PRUNE_TH)) atomicMin(&si[0], tid); }
    __syncthreads(); tstart = si[0]; __syncthreads(); }
#endif
  bf16x8 qr[4];
#pragma unroll
  for (int d0 = 0; d0 < 4; ++d0) qr[d0] = *(const bf16x8*)(AQ + (rb + qrow) * 512 + h * 64 + d0 * 16 + hi * 8);
  const float fq = F2[(rb + qrow) * 8 + h];
  f32x16 o0, o1;
#pragma unroll
  for (int r = 0; r < 16; ++r) { o0[r] = 0.f; o1[r] = 0.f; }
  float mrun = -INFINITY, lrun = 0.f;
  const int srow = tid >> 3, sch = tid & 7;
  u32x4 kreg, vreg; float freg = 0.f;
  { const size_t r = rb + (size_t)tstart * 64 + srow; kreg = *(const u32x4*)(AK + r * 512 + h * 64 + sch * 8); vreg = *(const u32x4*)(AV + r * 512 + h * 64 + sch * 8);
    if (tid < 64) freg = F2[(rb + (size_t)tstart * 64 + tid) * 8 + h]; }
  int buf = 0;
  for (int t = tstart; t <= tend; ++t) {
    u16* Kb = Ks + buf * 4608; u16* Vb = Vt + buf * 4608; float* Fb = Fk + buf * 64;
    *(u32x4*)(Kb + srow * 72 + sch * 8) = kreg;
#pragma unroll
    for (int j = 0; j < 4; ++j) { Vb[(sch * 8 + 2 * j) * 72 + srow] = (u16)(vreg[j] & 0xffffu); Vb[(sch * 8 + 2 * j + 1) * 72 + srow] = (u16)(vreg[j] >> 16); }
    if (tid < 64) Fb[tid] = freg;
    __syncthreads();
    if (t < tend) { const size_t r = rb + (size_t)(t + 1) * 64 + srow; kreg = *(const u32x4*)(AK + r * 512 + h * 64 + sch * 8); vreg = *(const u32x4*)(AV + r * 512 + h * 64 + sch * 8);
      if (tid < 64) freg = F2[(rb + (size_t)(t + 1) * 64 + tid) * 8 + h]; }
    f32x16 pb[2];
#pragma unroll
    for (int blk = 0; blk < 2; ++blk) {
      f32x16 c;
#pragma unroll
      for (int g = 0; g < 4; ++g) { const f32x4 fk = *(const f32x4*)(Fb + 32 * blk + 8 * g + 4 * hi); c[4 * g] = fq - fk[0]; c[4 * g + 1] = fq - fk[1]; c[4 * g + 2] = fq - fk[2]; c[4 * g + 3] = fq - fk[3]; }
#pragma unroll
      for (int d0 = 0; d0 < 4; ++d0) { const bf16x8 a = *(const bf16x8*)(Kb + (32 * blk + r32) * 72 + d0 * 16 + hi * 8); c = __builtin_amdgcn_mfma_f32_32x32x16_bf16(a, qr[d0], c, 0, 0, 0); }
      pb[blk] = c;
    }
    if (t >= 4 * qb) { const int kb0 = t * 64;
#pragma unroll
      for (int blk = 0; blk < 2; ++blk)
#pragma unroll
        for (int r = 0; r < 16; ++r) { const int kv = kb0 + 32 * blk + crow(r, hi); if (kv > qrow) pb[blk][r] = -INFINITY; } }
    float rm = -INFINITY;
#pragma unroll
    for (int r = 0; r < 16; ++r) rm = fmaxf(rm, fmaxf(pb[0][r], pb[1][r]));
    rm = fmaxf(rm, __shfl_xor(rm, 32));
    const float mnew = fmaxf(mrun, rm);
    const float al = __builtin_amdgcn_exp2f(mrun - mnew);
    float rs = 0.f;
#pragma unroll
    for (int blk = 0; blk < 2; ++blk)
#pragma unroll
      for (int r = 0; r < 16; ++r) { const float e = __builtin_amdgcn_exp2f(pb[blk][r] - mnew); pb[blk][r] = e; rs += e; }
    lrun = lrun * al + rs; mrun = mnew;
#pragma unroll
    for (int r = 0; r < 16; ++r) { o0[r] *= al; o1[r] *= al; }
#pragma unroll
    for (int blk = 0; blk < 2; ++blk)
#pragma unroll
      for (int s = 0; s < 2; ++s) {
        u32x4 pw = {pk2(pb[blk][8 * s], pb[blk][8 * s + 1]), pk2(pb[blk][8 * s + 2], pb[blk][8 * s + 3]), pk2(pb[blk][8 * s + 4], pb[blk][8 * s + 5]), pk2(pb[blk][8 * s + 6], pb[blk][8 * s + 7])};
        const bf16x8 pf = __builtin_bit_cast(bf16x8, pw);
        const int kvo = 32 * blk + 16 * s + 4 * hi;
        { const uint2 x = *(const uint2*)(Vb + r32 * 72 + kvo), y = *(const uint2*)(Vb + r32 * 72 + kvo + 8); u32x4 a = {x.x, x.y, y.x, y.y};
          o0 = __builtin_amdgcn_mfma_f32_32x32x16_bf16(__builtin_bit_cast(bf16x8, a), pf, o0, 0, 0, 0); }
        { const uint2 x = *(const uint2*)(Vb + (32 + r32) * 72 + kvo), y = *(const uint2*)(Vb + (32 + r32) * 72 + kvo + 8); u32x4 a = {x.x, x.y, y.x, y.y};
          o1 = __builtin_amdgcn_mfma_f32_32x32x16_bf16(__builtin_bit_cast(bf16x8, a), pf, o1, 0, 0, 0); }
      }
    buf ^= 1;
  }
  lrun += __shfl_xor(lrun, 32);
  const float inv = 1.f / lrun;
  u16* orow = OA + (rb + qrow) * 512 + h * 64;
#pragma unroll
  for (int g = 0; g < 4; ++g) { uint2 w; w.x = pk2(o0[4 * g] * inv, o0[4 * g + 1] * inv); w.y = pk2(o0[4 * g + 2] * inv, o0[4 * g + 3] * inv); *(uint2*)(orow + 8 * g + 4 * hi) = w;
    w.x = pk2(o1[4 * g] * inv, o1[4 * g + 1] * inv); w.y = pk2(o1[4 * g + 2] * inv, o1[4 * g + 3] * inv); *(uint2*)(orow + 32 + 8 * g + 4 * hi) = w; }
  __syncthreads();
}

__device__ __forceinline__ void attn_sample_unit(const Params& p, int b, int h, unsigned char* lds, int tid) {
  constexpr int NK = PAST + 16, SP = 2080;
  float* S = (float*)lds;
  float* Ft = (float*)(lds + 133120);
  float* qs = (float*)(lds + 141440);
  float* red = (float*)(lds + 145536);
  const u16* AQ = (const u16*)(p.ws + WS_AQ); u16* OA = (u16*)(p.ws + WS_AQ);
  const float* ck = p.in[2]; const float* cv = p.in[3]; const float* clf = p.in[4];
  for (int i = tid; i < 1024; i += NTHR) { const int qi = i >> 6, d = i & 63; qs[i] = bf2f(AQ[(size_t)(TP + b * 16 + qi) * 512 + h * 64 + d]); }
  { float loc[5]; float tot = 0.f;
#pragma unroll
    for (int i = 0; i < 5; ++i) { const int j = tid * 5 + i; float v = 0.f; if (j < PAST) v = clf[((size_t)b * PAST + j) * 8 + h]; else if (j < NK) v = p.out[O_LFS + (size_t)(b * 16 + j - PAST) * 8 + h]; tot += v; loc[i] = tot; }
    red[tid] = tot; __syncthreads();
    for (int off = 1; off < NTHR; off <<= 1) { const float v = tid >= off ? red[tid - off] : 0.f; __syncthreads(); red[tid] += v; __syncthreads(); }
    const float pre = red[tid] - tot;
#pragma unroll
    for (int i = 0; i < 5; ++i) { const int j = tid * 5 + i; if (j < NK) Ft[j] = (pre + loc[i]) * LOG2E; }
    __syncthreads(); }
  for (int j = tid; j < NK; j += NTHR) {
    const float* kp = j < PAST ? ck + (((size_t)b * PAST + j) * 8 + h) * 64 : p.out + O_KS + (size_t)(b * 16 + j - PAST) * 512 + h * 64;
    float acc[16];
#pragma unroll
    for (int qi = 0; qi < 16; ++qi) acc[qi] = 0.f;
#pragma unroll 4
    for (int d4 = 0; d4 < 16; ++d4) { const f32x4 kv = *(const f32x4*)(kp + d4 * 4);
#pragma unroll
      for (int qi = 0; qi < 16; ++qi) { const f32x4 qv = *(const f32x4*)(qs + qi * 64 + d4 * 4); acc[qi] += kv[0] * qv[0] + kv[1] * qv[1] + kv[2] * qv[2] + kv[3] * qv[3]; } }
    const float fj = Ft[j];
#pragma unroll
    for (int qi = 0; qi < 16; ++qi) S[qi * SP + j] = (j <= PAST + qi) ? acc[qi] + Ft[PAST + qi] - fj : -INFINITY;
  }
  __syncthreads();
  { const int lane = tid & 63, wave = tid >> 6;
    for (int qi = wave * 2; qi < wave * 2 + 2; ++qi) { float m = -INFINITY; for (int j = lane; j < NK; j += 64) m = fmaxf(m, S[qi * SP + j]); m = wmax(m);
      float s = 0.f; for (int j = lane; j < NK; j += 64) { const float e = __builtin_amdgcn_exp2f(S[qi * SP + j] - m); S[qi * SP + j] = e; s += e; } s = wsum(s); if (lane == 0) red[512 + qi] = 1.f / s; } }
  __syncthreads();
  const int slice = tid >> 4, d4 = tid & 15;
  f32x4 acc[16];
#pragma unroll
  for (int qi = 0; qi < 16; ++qi) acc[qi] = (f32x4){0.f, 0.f, 0.f, 0.f};
  for (int j = slice; j < NK; j += 32) {
    const float* vp = j < PAST ? cv + (((size_t)b * PAST + j) * 8 + h) * 64 : p.out + O_VS + (size_t)(b * 16 + j - PAST) * 512 + h * 64;
    const f32x4 vv = *(const f32x4*)(vp + d4 * 4);
#pragma unroll
    for (int qi = 0; qi < 16; ++qi) acc[qi] += vv * S[qi * SP + j];
  }
  __syncthreads();
  float* R = (float*)lds;
#pragma unroll
  for (int qi = 0; qi < 16; ++qi) *(f32x4*)(R + (slice * 16 + qi) * 64 + d4 * 4) = acc[qi];
  __syncthreads();
  for (int i = tid; i < 1024; i += NTHR) { const int qi = i >> 6, d = i & 63; float s = 0.f; for (int sl = 0; sl < 32; ++sl) s += R[(sl * 16 + qi) * 64 + d];
    OA[(size_t)(TP + b * 16 + qi) * 512 + h * 64 + d] = f2bf(s * red[512 + qi]); }
  __syncthreads();
}

template <class CT> __device__ __forceinline__ float ldc(const CT* p);
template <> __device__ __forceinline__ float ldc<u16>(const u16* p) { return bf2f(*p); }
template <> __device__ __forceinline__ float ldc<float>(const float* p) { return *p; }

template <int L, int MODE> __device__ __forceinline__ void mlstm_unit(const Params& p, int b, int h, int c, unsigned char* lds, int tid) {
  typedef typename std::conditional<MODE == 2, float, u16>::type CT;
  constexpr int CP = (MODE == 2) ? 129 : 130;
  constexpr int OFF_Q = 0, OFF_K = L * 260, OFF_V = 2 * L * 260, OFF_C = 3 * L * 260, OFF_A = OFF_C + 128 * CP * (int)sizeof(CT), OFF_H = OFF_A + L * (L + 1) * 4, OFF_S = OFF_H + L * 128 * 4;
  static_assert(OFF_S + 1024 * 4 <= MISC_OFF && (OFF_C % 4) == 0 && (OFF_A % 4) == 0, "mlstm lds");
  unsigned char* ws = p.ws;
  u16* qs = (u16*)(lds + OFF_Q); u16* ks = (u16*)(lds + OFF_K); u16* vs = (u16*)(lds + OFF_V); CT* Cs = (CT*)(lds + OFF_C); float* A = (float*)(lds + OFF_A); float* Hs = (float*)(lds + OFF_H);
  float* sc = (float*)(lds + OFF_S); float *bt = sc, *ig = sc + 64, *mt = sc + 128, *wint = sc + 192, *den = sc + 256, *nq = sc + 320, *wsv = sc + 384, *ns = sc + 448, *misc = sc + 576;
  const u16* PRE = (const u16*)(ws + WS_PRE); u16* MV = (u16*)(ws + WS_MV); const u16* SIGO = (const u16*)(ws + WS_SIGO);
  const float* MI = (const float*)(ws + WS_MI); const float* MLF = (const float*)(ws + WS_MLF);
  const int sq = b * 4 + h; const int item = sq * 256 + c;
  const size_t r0 = (MODE == 2) ? (size_t)TP + b * 16 : (size_t)b * SEQ + (size_t)c * 64;
  const float* cw = p.in[17]; const float* cb = p.in[18];
  for (int idx = tid; idx < L * 256; idx += NTHR) { const int l = idx >> 8, ch = idx & 255; if (MODE == 0 && ch < 128) continue;
    const int col = ch < 128 ? h * 128 + ch : 512 + h * 128 + (ch - 128);
    float val = cb[col];
#pragma unroll
    for (int j = 0; j < 4; ++j) { const int rr = l - 3 + j; float x;
      if (rr >= 0 || (MODE != 2 && c > 0)) x = bf2f(PRE[(r0 + rr) * 1024 + col]); else x = (MODE == 2) ? p.in[8][((size_t)b * 3 + (3 + rr)) * 1024 + col] : 0.f;
      val += x * cw[j * 1024 + col]; }
    val = siluf(val);
    if (ch < 128) qs[l * 130 + ch] = f2bf(val); else ks[l * 130 + (ch - 128)] = f2bf(val * 0.08838834764831845f); }
  for (int idx = tid; idx < L * 128; idx += NTHR) { const int l = idx >> 7, v = idx & 127; vs[l * 130 + v] = MV[(r0 + l) * 512 + h * 128 + v]; }
  float m0;
  if (MODE == 2) { m0 = p.in[7][sq];
    if (tid == 0) { float bs = 0.f, m = m0; for (int l = 0; l < L; ++l) { const float lf = MLF[(r0 + l) * 4 + h], g = MI[(r0 + l) * 4 + h]; bs += lf; m = fmaxf(lf + m, g); bt[l] = bs; ig[l] = g; mt[l] = m; } }
    for (int i = tid; i < 128; i += NTHR) ns[i] = p.in[6][sq * 128 + i];
  } else { m0 = ((const float*)(ws + WS_MST))[item];
    if (tid < L) { bt[tid] = ((const float*)(ws + WS_MB))[(r0 + tid) * 4 + h]; ig[tid] = MI[(r0 + tid) * 4 + h]; mt[tid] = ((const float*)(ws + WS_MM))[(r0 + tid) * 4 + h]; }
    if (MODE == 1) for (int i = tid; i < 128; i += NTHR) ns[i] = ((const float*)(ws + WS_UN))[(size_t)item * 128 + i]; }
  if (MODE == 1) { const u16* Cg = (const u16*)(ws + WS_U) + (size_t)item * 16384; for (int i = tid; i < 16384; i += NTHR) Cs[(i >> 7) * CP + (i & 127)] = Cg[i]; }
  if (MODE == 2) { const float* Cg = p.in[5] + (size_t)sq * 16384; for (int i = tid; i < 16384; i += NTHR) ((float*)Cs)[(i >> 7) * CP + (i & 127)] = Cg[i]; }
  __syncthreads();
  if (tid < L) { wint[tid] = __expf(bt[tid] + m0 - mt[tid]); wsv[tid] = __expf(bt[L - 1] - bt[tid] + ig[tid] - mt[L - 1]); }
  const float mnew = mt[L - 1]; const float wstate = __expf(bt[L - 1] + m0 - mnew);
  if (MODE != 0) {
    for (int idx = tid; idx < L * L; idx += NTHR) { const int t = idx / L, s = idx % L; float a = 0.f;
      if (s <= t) { float dot = 0.f;
#pragma unroll 8
        for (int d = 0; d < 128; ++d) dot += bf2f(qs[t * 130 + d]) * bf2f(ks[s * 130 + d]);
        a = __expf(bt[t] - bt[s] + ig[s] - mt[t]) * dot; }
      A[t * (L + 1) + s] = a; }
    __syncthreads();
    if (tid < L) { float s = 0.f; for (int j = 0; j <= tid; ++j) s += A[tid * (L + 1) + j]; den[tid] = s; }
    else if (tid >= 64 && tid < 64 + L) { const int t = tid - 64; float s = 0.f; for (int d = 0; d < 128; ++d) s += ns[d] * bf2f(qs[t * 130 + d]); nq[t] = s; }
    __syncthreads();
    for (int idx = tid; idx < L * 128; idx += NTHR) { const int t = idx >> 7, v = idx & 127; float n1 = 0.f, n2 = 0.f;
      for (int s = 0; s <= t; ++s) n1 += A[t * (L + 1) + s] * bf2f(vs[s * 130 + v]);
#pragma unroll 8
      for (int d = 0; d < 128; ++d) n2 += ldc<CT>(Cs + v * CP + d) * bf2f(qs[t * 130 + d]);
      const float wi = wint[t]; const float dn = den[t] + wi * nq[t];
      Hs[t * 128 + v] = (n1 + wi * n2) / fmaxf(fabsf(dn), __expf(-mt[t])); }
    __syncthreads();
    { const int lane = tid & 63, wave = tid >> 6;
      for (int t = wave; t < L; t += 8) { const float x0 = Hs[t * 128 + lane], x1 = Hs[t * 128 + 64 + lane]; const float mu = wsum(x0 + x1) * (1.f / 128.f);
        const float y0 = x0 - mu, y1 = x1 - mu; const float rstd = rsqrtf(wsum(y0 * y0 + y1 * y1) * (1.f / 128.f) + LN_EPS);
        const size_t ro = (r0 + t) * 512 + h * 128; const float* ng = p.in[19] + h * 128;
        MV[ro + lane] = f2bf(y0 * rstd * ng[lane] * bf2f(SIGO[ro + lane])); MV[ro + 64 + lane] = f2bf(y1 * rstd * ng[64 + lane] * bf2f(SIGO[ro + 64 + lane])); } }
  }
  if (MODE != 1) {
    __syncthreads();
    const int v = tid >> 2, dg = tid & 3; float acc[32];
#pragma unroll
    for (int i = 0; i < 32; ++i) acc[i] = 0.f;
    for (int s = 0; s < L; ++s) { const float wv = wsv[s] * bf2f(vs[s * 130 + v]);
#pragma unroll
      for (int i = 0; i < 32; ++i) acc[i] += wv * bf2f(ks[s * 130 + dg * 32 + i]); }
    if (MODE == 0) { u16* Ug = (u16*)(ws + WS_U) + (size_t)item * 16384 + v * 128 + dg * 32;
#pragma unroll
      for (int i = 0; i < 4; ++i) { u32x4 w = {pk2(acc[8 * i], acc[8 * i + 1]), pk2(acc[8 * i + 2], acc[8 * i + 3]), pk2(acc[8 * i + 4], acc[8 * i + 5]), pk2(acc[8 * i + 6], acc[8 * i + 7])}; *(u32x4*)(Ug + 8 * i) = w; }
      if (tid < 128) { float s = 0.f; for (int j = 0; j < L; ++j) s += wsv[j] * bf2f(ks[j * 130 + tid]); ((float*)(ws + WS_UN))[(size_t)item * 128 + tid] = s; } }
    else { float* Cg = p.out + O_CS + (size_t)sq * 16384 + v * 128 + dg * 32;
#pragma unroll
      for (int i = 0; i < 32; ++i) Cg[i] = wstate * ldc<CT>(Cs + v * CP + dg * 32 + i) + acc[i];
      if (tid < 128) { float s = 0.f; for (int j = 0; j < L; ++j) s += wsv[j] * bf2f(ks[j * 130 + tid]); p.out[O_NS + sq * 128 + tid] = wstate * ns[tid] + s; }
      if (tid == 0) p.out[O_MS + sq] = mnew; }
  }
  __syncthreads();
}

__device__ __forceinline__ void state_scan_phase(const Params& p, int tid) {
  unsigned char* ws = p.ws; const float* WST = (const float*)(ws + WS_MST) + 2048;
  for (int u = blockIdx.x; u < 258; u += gridDim.x) {
    const int gi = u * NTHR + tid;
    if (gi < 131072) { const int sq = gi >> 14, e = gi & 16383; u16* U = (u16*)(ws + WS_U) + (size_t)sq * 256 * 16384 + e; const float* w = WST + sq * 256; float C = 0.f;
      for (int c0 = 0; c0 < 256; c0 += 16) { u16 tmp[16];
#pragma unroll
        for (int i = 0; i < 16; ++i) tmp[i] = U[(size_t)(c0 + i) * 16384];
#pragma unroll
        for (int i = 0; i < 16; ++i) { U[(size_t)(c0 + i) * 16384] = f2bf(C); C = w[c0 + i] * C + bf2f(tmp[i]); } }
      p.out[O_CP + gi] = C; }
    else if (gi < 131072 + 1024) { const int g2 = gi - 131072, sq = g2 >> 7, e = g2 & 127; float* U = (float*)(ws + WS_UN) + (size_t)sq * 256 * 128 + e; const float* w = WST + sq * 256; float C = 0.f;
      for (int c0 = 0; c0 < 256; c0 += 16) { float tmp[16];
#pragma unroll
        for (int i = 0; i < 16; ++i) tmp[i] = U[(size_t)(c0 + i) * 128];
#pragma unroll
        for (int i = 0; i < 16; ++i) { U[(size_t)(c0 + i) * 128] = C; C = w[c0 + i] * C + tmp[i]; } }
      p.out[O_NP + g2] = C; }
  }
}

__global__ void __launch_bounds__(NTHR, 2) fwd_kernel(Params p) {
  extern __shared__ __attribute__((aligned(16))) unsigned char lds[];
  cg::grid_group grid = cg::this_grid();
#define OTID() ({ int t_ = threadIdx.x; asm volatile("" : "+v"(t_)); t_; })
  int tid = OTID(); unsigned char* ws = p.ws;
  int* ctl = (int*)(ws + WS_CTL); int* s_u = (int*)(lds + MISC_OFF);
  float* X = (float*)(ws + WS_X); u16* H = (u16*)(ws + WS_H); u16* ACT = (u16*)(ws + WS_ACT); const float* mod = (const float*)(ws + WS_MOD);
  prep_phase(p, lds, tid);
  grid.sync(); tid = OTID();
  row_phase<0>(p, 0, 0, 1024);
  grid.sync(); tid = OTID();
  { EpiGU E; E.ACT = ACT; run_gemm(lds, H, (const u16*)(ws + WS_WGU1), 2 * FF, D, E); }
  grid.sync(); tid = OTID();
  { EpiRes E; E.xp = p.in[0]; E.xs = p.in[1]; E.X = X; E.gate = mod + 2048; E.gs = 0.5f; run_gemm(lds, ACT, (const u16*)(ws + WS_WD1), D, FF, E); }
  grid.sync(); tid = OTID();
  row_phase<1>(p, 0, 3072, 4096);
  grid.sync(); tid = OTID();
  { EpiIn E; E.AQ = (u16*)(ws + WS_AQ); E.AK = (u16*)(ws + WS_AK); E.AV = (u16*)(ws + WS_AV); E.PRE = (u16*)(ws + WS_PRE); E.MV = (u16*)(ws + WS_MV); E.SIGO = (u16*)(ws + WS_SIGO);
    E.MI = (float*)(ws + WS_MI); E.MLF = (float*)(ws + WS_MLF); E.bias = (const float*)(ws + WS_BIN); E.out = p.out; run_gemm(lds, H, (const u16*)(ws + WS_WIN), 3840, D, E); }
  grid.sync(); tid = OTID();
  scan_phase(p, lds, tid);
  grid.sync(); tid = OTID();
  for (;;) { __syncthreads(); if (tid == 0) *s_u = atomicAdd(&ctl[0], 1); __syncthreads(); const int u = *s_u; if (u >= 128 + 1024) break;
    if (u < 128) attn_sample_unit(p, u >> 3, u & 7, lds, tid);
    else { const int v = u - 128; attn_prompt_unit(p, (v & 15) >> 3, v & 7, 63 - (v >> 4), lds, tid); } }
  grid.sync(); tid = OTID();
  for (;;) { __syncthreads(); if (tid == 0) *s_u = atomicAdd(&ctl[1], 1); __syncthreads(); const int u = *s_u; if (u >= 64 + 2048) break;
    if (u < 64) mlstm_unit<16, 2>(p, u >> 2, u & 3, 0, lds, tid);
    else { const int v = u - 64; mlstm_unit<64, 0>(p, v >> 10, (v >> 8) & 3, v & 255, lds, tid); } }
  grid.sync(); tid = OTID();
  state_scan_phase(p, tid);
  grid.sync(); tid = OTID();
  for (;;) { __syncthreads(); if (tid == 0) *s_u = atomicAdd(&ctl[2], 1); __syncthreads(); const int u = *s_u; if (u >= 2048) break;
    mlstm_unit<64, 1>(p, u >> 10, (u >> 8) & 3, u & 255, lds, tid); }
  grid.sync(); tid = OTID();
  { const float* bias = (const float*)(ws + WS_BIN); u16* GA = (u16*)(ws + WS_GA); u16* GB = (u16*)(ws + WS_GB); const u16* WIN = (const u16*)(ws + WS_WIN);
    { EpiMerge<0> E; E.O = GA; E.Aa = nullptr; E.bias = bias + 3840; run_gemm(lds, H, WIN + (size_t)3840 * D, D, D, E); }
    { EpiMerge<1> E; E.O = GA; E.Aa = nullptr; E.bias = nullptr; run_gemm(lds, (const u16*)(ws + WS_AQ), (const u16*)(ws + WS_WBA), D, 512, E); }
    { EpiMerge<0> E; E.O = GB; E.Aa = nullptr; E.bias = bias + 4864; run_gemm(lds, H, WIN + (size_t)4864 * D, D, D, E); }
    { EpiMerge<2> E; E.O = GB; E.Aa = GA; E.bias = nullptr; run_gemm(lds, (const u16*)(ws + WS_MV), (const u16*)(ws + WS_WBB), D, 512, E); } }
  grid.sync(); tid = OTID();
  { EpiRes E; E.xp = X; E.xs = X + (size_t)TP * D; E.X = X; E.gate = mod + 5120; E.gs = 1.0f; run_gemm(lds, (const u16*)(ws + WS_GB), (const u16*)(ws + WS_WOUT), D, D, E); }
  grid.sync(); tid = OTID();
  row_phase<1>(p, 1, 6144, 7168);
  grid.sync(); tid = OTID();
  { EpiGU E; E.ACT = ACT; run_gemm(lds, H, (const u16*)(ws + WS_WGU2), 2 * FF, D, E); }
  grid.sync(); tid = OTID();
  { EpiRes E; E.xp = X; E.xs = X + (size_t)TP * D; E.X = X; E.gate = mod + 8192; E.gs = 0.5f; run_gemm(lds, ACT, (const u16*)(ws + WS_WD2), D, FF, E); }
  grid.sync(); tid = OTID();
  row_phase<2>(p, 2, 0, 0);
}

extern "C" void kernel_launch(void* const* d_in, const int* in_sizes, int n_in, void* d_out, int out_size, void* d_ws, size_t ws_size, hipStream_t stream) {
  static int grid = 0;
  if (grid == 0) {
    if (n_in != 27 || ws_size < WS_END) { fprintf(stderr, "kernel_launch: unexpected n_in %d / ws_size %zu (need %zu)\n", n_in, ws_size, (size_t)WS_END); grid = -1; return; }
    int dev = 0, cus = 0, per_cu = 0;
    hipGetDevice(&dev); hipDeviceGetAttribute(&cus, hipDeviceAttributeMultiprocessorCount, dev);
    if (hipFuncSetAttribute((const void*)fwd_kernel, hipFuncAttributeMaxDynamicSharedMemorySize, LDS_BYTES) != hipSuccess) { fprintf(stderr, "kernel_launch: hipFuncSetAttribute failed\n"); grid = -1; return; }
    if (hipOccupancyMaxActiveBlocksPerMultiprocessor(&per_cu, (const void*)fwd_kernel, NTHR, LDS_BYTES) != hipSuccess || per_cu < 1) { fprintf(stderr, "kernel_launch: occupancy query says %d\n", per_cu); per_cu = 1; }
    (void)hipGetLastError();
    grid = cus * 1;
  }
  if (grid < 0) return;
  Params p{};
  for (int i = 0; i < 27; ++i) p.in[i] = (const float*)d_in[i];
  p.out = (float*)d_out; p.ws = (unsigned char*)d_ws;
  void* args[] = {&p};
  hipError_t e = hipLaunchCooperativeKernel((const void*)fwd_kernel, dim3(grid), dim3(NTHR), args, LDS_BYTES, stream);
  if (e != hipSuccess) fprintf(stderr, "cooperative launch failed: %s (grid %d)\n", hipGetErrorString(e), grid);
}
```

```cpp
#include <hip/hip_runtime.h>
#include <hip/hip_cooperative_groups.h>
#include <cstdio>
#include <cstdint>
#include <type_traits>
namespace cg = cooperative_groups;
namespace pg8 {
#define PG8_LAS __attribute__((address_space(3)))
typedef unsigned short bf16_t;
typedef short bf16x8 __attribute__((ext_vector_type(8)));
typedef float f32x4 __attribute__((ext_vector_type(4)));
typedef unsigned u32x4 __attribute__((ext_vector_type(4)));
constexpr int BM = 256, BK = 64, HALF = 128, HTB = HALF * BK * 2  , STAGE_BYTES = 8 * HTB, NXCD = 8, WGM = 8;

__host__ __device__ __forceinline__ int lds_byte(int r, int c) { const int st = (r >> 4) * 2 + (c >> 5), rr = r & 15, cc = c & 31, ob = rr * 64 + cc * 2; return st * 1024 + (ob ^ (((ob >> 9) & 1) << 5)); }
__host__ __device__ __forceinline__ void stage_rc(int b, int& R, int& C) { const int st = b / 1024, sb = b % 1024, swz = sb ^ (((sb >> 9) & 1) << 5); R = (st >> 1) * 16 + swz / 64; C = (st & 1) * 32 + (swz % 64) / 2; }
__host__ __device__ __forceinline__ int perm32(int rho) { const int n = rho >> 4, i = rho & 15; return 8 * (i >> 2) + 4 * n + (i & 3); }

struct Unit { int pm, pn; };
struct Gemm { const bf16_t* A; const bf16_t* Bt; int M, N, K, ld; };

struct StaticOrder {
    int nM, nN, nwg, G, c;
    __host__ __device__ void init(int M, int N, int G_, int c_) { nM = M / BM; nN = N / BM; nwg = nM * nN; G = G_; c = c_; }
    __host__ __device__ bool next(int i, Unit& u) const {
        const long L = (long)i * G + c; if (L >= nwg) return false;
        int wgid = (int)L; { const int q = nwg / NXCD, r = nwg % NXCD, xcd = wgid % NXCD, off = wgid / NXCD; wgid = (xcd < r ? xcd * (q + 1) : r * (q + 1) + (xcd - r) * q) + off; }
        const int nig = WGM * nN, gid = wgid / nig, fm = gid * WGM, gsz = (nM - fm) < WGM ? (nM - fm) : WGM;
        u.pm = fm + ((wgid % nig) % gsz); u.pn = (wgid % nig) / gsz; return true;
    }
    __device__ __forceinline__ void a_ready(const Unit&) const {}
    __device__ __forceinline__ void done(const Unit&) const {}
};

__device__ __forceinline__ unsigned cvt_pk_bf16(float lo, float hi) { unsigned r; asm volatile("v_cvt_pk_bf16_f32 %0, %1, %2" : "=v"(r) : "v"(lo), "v"(hi)); return r; }
template <class Epi, class Sched, bool ALIGN_EPI = false, bool SP2 = false>
__device__ __forceinline__ void gemm_phase(PG8_LAS unsigned char* lds, const Gemm g, const Sched& S, const Epi& E) {
    int tid_ = threadIdx.x; asm volatile("" : "+v"(tid_));
    const int tid = tid_, wid = __builtin_amdgcn_readfirstlane(tid >> 6), lane = tid & 63, wr = wid >> 2, wc = wid & 3, fr = lane & 15, fq = lane >> 4;
    const int K = g.K, nt = K / BK;
    unsigned voffA[2], voffB[2];
#pragma unroll
    for (int i = 0; i < 2; ++i) { int R, C; stage_rc(tid * 16 + i * 8192, R, C); const int Rb = Epi::PERM ? ((R & ~31) + perm32(R & 31)) : R;
        voffA[i] = (unsigned)(R * g.ld + C) * 2u; voffB[i] = (unsigned)(Rb * g.ld + C) * 2u; }
    const size_t kstep = (size_t)(BK * 2);
    const size_t hstep = (size_t)HALF * g.ld * 2;
    const size_t tstep = 2 * hstep;
    const unsigned ldsw = (unsigned)wid * 1024u;
    const int aoff = lds_byte(wr * 64 + fr, fq * 8), boff = lds_byte(wc * 32 + fr, fq * 8);
#define PG8_SA(b, h) (((b) * 2 + (h)) * HTB)
#define PG8_SB(b, h) ((4 + (b) * 2 + (h)) * HTB)
#define PG8_STAGE(bufoff, gbase, voff) do { _Pragma("unroll") for (int _i = 0; _i < 2; ++_i) \
        __builtin_amdgcn_global_load_lds((const unsigned*)((const char*)(gbase) + (voff)[_i]), (PG8_LAS unsigned*)(lds + (bufoff) + ldsw + _i * 8192), 16, 0, 0); } while (0)
#define PG8_LDA(dst, b, h) do { _Pragma("unroll") for (int m = 0; m < 4; ++m) _Pragma("unroll") for (int k = 0; k < 2; ++k) dst[m][k] = *(const PG8_LAS bf16x8*)(lds + PG8_SA(b, h) + aoff + m * 2048 + k * 1024); } while (0)
#define PG8_LDB(dst, b, h) do { _Pragma("unroll") for (int n = 0; n < 2; ++n) _Pragma("unroll") for (int k = 0; k < 2; ++k) dst[n][k] = *(const PG8_LAS bf16x8*)(lds + PG8_SB(b, h) + boff + n * 2048 + k * 1024); } while (0)
#define PG8_MMA(ai, bj, At, Bt) do { __builtin_amdgcn_s_setprio(1); _Pragma("unroll") for (int m = 0; m < 4; ++m) _Pragma("unroll") for (int n = 0; n < 2; ++n) _Pragma("unroll") for (int k = 0; k < 2; ++k) \
        acc[ai][bj][m][n] = __builtin_amdgcn_mfma_f32_16x16x32_bf16(Bt[n][k], At[m][k], acc[ai][bj][m][n], 0, 0, 0); __builtin_amdgcn_s_setprio(0); } while (0)
#define PG8_WAIT_V(n) asm volatile("s_waitcnt vmcnt(" #n ")" ::: "memory")
#define PG8_WAIT_L(n) asm volatile("s_waitcnt lgkmcnt(" #n ")" ::: "memory")
#define PG8_BAR __builtin_amdgcn_s_barrier()
#define PG8_SCHED __builtin_amdgcn_sched_barrier(0)
    Unit cur, nxt; int ui = 0;
    if (!S.next(0, cur)) return;
    f32x4 acc[2][2][4][2];
#pragma unroll
    for (int a = 0; a < 2; ++a)
#pragma unroll
        for (int b = 0; b < 2; ++b)
#pragma unroll
            for (int m = 0; m < 4; ++m)
#pragma unroll
                for (int n = 0; n < 2; ++n) acc[a][b][m][n] = (f32x4){0.f, 0.f, 0.f, 0.f};
    bf16x8 At[4][2], B0[2][2], B1[2][2];
    const char* cA = (const char*)g.A + (size_t)cur.pm * tstep; const char* cB = (const char*)g.Bt + (size_t)cur.pn * tstep;
    S.a_ready(cur);
    if constexpr (SP2) {
        PG8_STAGE(PG8_SB(0, 0), cB, voffB); PG8_STAGE(PG8_SB(0, 1), cB + hstep, voffB); PG8_STAGE(PG8_SA(0, 0), cA, voffA); PG8_STAGE(PG8_SA(0, 1), cA + hstep, voffA);
        if (wr == 1) PG8_BAR;
        PG8_WAIT_V(2); PG8_BAR;
        PG8_STAGE(PG8_SB(1, 0), cB + kstep, voffB); PG8_STAGE(PG8_SA(1, 0), cA + kstep, voffA); PG8_STAGE(PG8_SB(1, 1), cB + hstep + kstep, voffB);
        PG8_WAIT_V(6); PG8_BAR;
    } else {
        PG8_STAGE(PG8_SB(0, 0), cB, voffB); PG8_STAGE(PG8_SA(0, 0), cA, voffA); PG8_STAGE(PG8_SB(0, 1), cB + hstep, voffB); PG8_STAGE(PG8_SA(0, 1), cA + hstep, voffA);
        if (wr == 1) PG8_BAR;
        PG8_WAIT_V(4); PG8_BAR;
        PG8_STAGE(PG8_SB(1, 0), cB + kstep, voffB); PG8_STAGE(PG8_SA(1, 0), cA + kstep, voffA); PG8_STAGE(PG8_SB(1, 1), cB + hstep + kstep, voffB);
        PG8_WAIT_V(6); PG8_BAR;
    }
    for (;;) {
        const bool has_next = S.next(ui + 1, nxt);
        const char* nA = has_next ? (const char*)g.A + (size_t)nxt.pm * tstep : cA; const char* nB = has_next ? (const char*)g.Bt + (size_t)nxt.pn * tstep : cB;
        for (int t = 0; t < nt; t += 2) {
            const bool last = (t == nt - 2);
            const char* a1 = cA + (size_t)(t + 1) * kstep;
            const char* a2 = last ? nA : cA + (size_t)(t + 2) * kstep; const char* b2 = last ? nB : cB + (size_t)(t + 2) * kstep;
            const char* a3 = a2 + kstep; const char* b3 = b2 + kstep;
            if (last && has_next) S.a_ready(nxt);
            if constexpr (SP2) {
            PG8_LDB(B0, 0, 0); PG8_LDB(B1, 0, 1); PG8_SCHED; PG8_LDA(At, 0, 0); PG8_STAGE(PG8_SA(1, 1), a1 + hstep, voffA);
            PG8_WAIT_V(8); PG8_WAIT_L(0); PG8_BAR; PG8_MMA(0, 0, At, B0); PG8_MMA(0, 1, At, B1); PG8_BAR; PG8_SCHED;
            PG8_LDA(At, 0, 1); PG8_STAGE(PG8_SB(0, 0), b2, voffB); PG8_STAGE(PG8_SB(0, 1), b2 + hstep, voffB); PG8_STAGE(PG8_SA(0, 0), a2, voffA);
            PG8_WAIT_V(8); PG8_WAIT_L(0); PG8_BAR; PG8_MMA(1, 0, At, B0); PG8_MMA(1, 1, At, B1); PG8_BAR; PG8_SCHED;
            PG8_LDB(B0, 1, 0); PG8_LDB(B1, 1, 1); PG8_SCHED; PG8_LDA(At, 1, 0); PG8_STAGE(PG8_SA(0, 1), a2 + hstep, voffA);
            PG8_WAIT_V(8); PG8_WAIT_L(0); PG8_BAR; PG8_MMA(0, 0, At, B0); PG8_MMA(0, 1, At, B1); PG8_BAR; PG8_SCHED;
            PG8_LDA(At, 1, 1); PG8_STAGE(PG8_SB(1, 0), b3, voffB); PG8_STAGE(PG8_SB(1, 1), b3 + hstep, voffB); PG8_STAGE(PG8_SA(1, 0), a3, voffA);
            PG8_WAIT_V(8); PG8_WAIT_L(0); PG8_BAR; PG8_MMA(1, 0, At, B0); PG8_MMA(1, 1, At, B1); PG8_BAR; PG8_SCHED;
            } else {
            PG8_LDB(B0, 0, 0); PG8_SCHED; PG8_LDA(At, 0, 0); PG8_STAGE(PG8_SA(1, 1), a1 + hstep, voffA);
            PG8_WAIT_L(8); PG8_BAR; PG8_WAIT_L(0); PG8_MMA(0, 0, At, B0); PG8_BAR; PG8_SCHED;
            PG8_LDB(B1, 0, 1); PG8_STAGE(PG8_SB(0, 0), b2, voffB);
            PG8_BAR; PG8_WAIT_L(0); PG8_MMA(0, 1, At, B1); PG8_BAR;
            PG8_LDA(At, 0, 1); PG8_STAGE(PG8_SA(0, 0), a2, voffA);
            PG8_BAR; PG8_WAIT_L(0); PG8_MMA(1, 0, At, B0); PG8_BAR; PG8_SCHED;
            PG8_STAGE(PG8_SB(0, 1), b2 + hstep, voffB);
            PG8_WAIT_V(6); PG8_BAR; PG8_MMA(1, 1, At, B1); PG8_BAR;
            PG8_LDB(B0, 1, 0); PG8_SCHED; PG8_LDA(At, 1, 0); PG8_STAGE(PG8_SA(0, 1), a2 + hstep, voffA);
            PG8_WAIT_L(8); PG8_BAR; PG8_WAIT_L(0); PG8_MMA(0, 0, At, B0); PG8_BAR; PG8_SCHED;
            PG8_LDB(B1, 1, 1); PG8_STAGE(PG8_SB(1, 0), b3, voffB);
            PG8_BAR; PG8_WAIT_L(0); PG8_MMA(0, 1, At, B1); PG8_BAR;
            PG8_LDA(At, 1, 1); PG8_STAGE(PG8_SA(1, 0), a3, voffA);
            PG8_BAR; PG8_WAIT_L(0); PG8_MMA(1, 0, At, B0); PG8_BAR; PG8_SCHED;
            PG8_STAGE(PG8_SB(1, 1), b3 + hstep, voffB);
            PG8_WAIT_V(6); PG8_BAR; PG8_MMA(1, 1, At, B1); PG8_BAR;
            }
        }
        if constexpr (ALIGN_EPI) { if (wr == 0) PG8_BAR; }
        if constexpr (!Epi::AFTER_DRAIN) { E(acc, cur, wr, wc, fr, fq); S.done(cur); }
        if (!has_next) break;
#pragma unroll
        for (int a = 0; a < 2; ++a)
#pragma unroll
            for (int b = 0; b < 2; ++b)
#pragma unroll
                for (int m = 0; m < 4; ++m)
#pragma unroll
                    for (int n = 0; n < 2; ++n) acc[a][b][m][n] = (f32x4){0.f, 0.f, 0.f, 0.f};
        cur = nxt; cA = nA; cB = nB; ++ui;
        if constexpr (ALIGN_EPI) { if (wr == 1) PG8_BAR; }
    }
    PG8_WAIT_V(0);
    if constexpr (!ALIGN_EPI) { if (wr == 0) PG8_BAR; }
    PG8_BAR;
    if constexpr (Epi::AFTER_DRAIN) { E.fused(acc, cur, wr, wc, fr, fq, lds, wid, lane); S.done(cur); }
#undef PG8_SA
#undef PG8_SB
#undef PG8_STAGE
#undef PG8_LDA
#undef PG8_LDB
#undef PG8_MMA
#undef PG8_WAIT_V
#undef PG8_WAIT_L
#undef PG8_BAR
#undef PG8_SCHED
}
}
typedef unsigned short u16;
using pg8::f32x4; using pg8::u32x4; using pg8::bf16x8;
typedef float f32x16 __attribute__((ext_vector_type(16)));

constexpr int TP = 32768, TS = 256, T = TP + TS, D = 1024, FF = 2816, SEQ = 16384, PAST = 2048;
constexpr float ALPHA = 1.189207115002721f, LN_EPS = 1e-5f, LOG2E = 1.4426950408889634f, C2 = 0.125f * LOG2E;
constexpr int NTHR = 512, LDS_BYTES = 148480, MISC_OFF = 147712;
#ifndef PROBE
#define PROBE 0
#endif
#ifndef GEMM_SP2
#define GEMM_SP2 true
#endif
#ifndef GEMM_ALIGN
#define GEMM_ALIGN true
#endif
#ifndef PRUNE
#define PRUNE 1
#endif
constexpr float PRUNE_TH = 32.f;

constexpr size_t O_YP = 0, O_YS = 33554432, O_KP = 33816576, O_VP = 50593792, O_LFP = 67371008, O_CP = 67633152, O_NP = 67764224, O_MP = 67765248,
                 O_CONVP = 67765256, O_KS = 67771400, O_VS = 67902472, O_LFS = 68033544, O_CS = 68035592, O_NS = 69084168, O_MS = 69092360, O_CONVS = 69092424;
constexpr size_t MiB = 1u << 20;
constexpr size_t WS_CTL = 0, WS_MOD = 1 * MiB, WS_BIN = 2 * MiB;
constexpr size_t WS_F2 = 3 * MiB;
constexpr size_t WS_MI = 4 * MiB;
constexpr size_t WS_MLF = 5 * MiB;
constexpr size_t WS_MB = 6 * MiB;
constexpr size_t WS_MM = 7 * MiB;
constexpr size_t WS_UN = 8 * MiB;
constexpr size_t WS_MST = 9 * MiB;
constexpr size_t WS_WGU1 = 10 * MiB, WS_WD1 = 21 * MiB, WS_WIN = 27 * MiB, WS_WBA = 39 * MiB, WS_WBB = 40 * MiB, WS_WOUT = 41 * MiB, WS_WGU2 = 43 * MiB, WS_WD2 = 54 * MiB;
constexpr size_t WS_X = 60 * MiB, WS_H = 189 * MiB, WS_ACT = 254 * MiB;
constexpr size_t QSZ = (size_t)T * 512 * 2;
constexpr size_t WS_AQ = WS_ACT, WS_AK = WS_AQ + QSZ, WS_AV = WS_AK + QSZ, WS_PRE = WS_AV + QSZ;
constexpr size_t WS_U = WS_AK, WS_GA = WS_PRE, WS_GB = WS_AK;
constexpr size_t WS_MV = 432 * MiB, WS_SIGO = WS_MV + QSZ, WS_END = WS_SIGO + QSZ;
static_assert(WS_PRE + 2 * QSZ <= WS_ACT + (size_t)T * FF * 2 + 16 * MiB && WS_ACT + (size_t)T * FF * 2 <= WS_MV && WS_END <= 512 * MiB, "ws map");

struct Params { const float* in[27]; float* out; unsigned char* ws; };

__device__ __forceinline__ float bf2f(u16 b) { return __uint_as_float(((unsigned)b) << 16); }
__device__ __forceinline__ u16 f2bf(float f) { unsigned u = __float_as_uint(f); return (u16)((u + 0x7fffu + ((u >> 16) & 1u)) >> 16); }
typedef float f32x2_t __attribute__((ext_vector_type(2))); typedef __bf16 bf16x2_t __attribute__((ext_vector_type(2)));
__device__ __forceinline__ unsigned pk2(float lo, float hi) { f32x2_t v = {lo, hi}; bf16x2_t b = __builtin_convertvector(v, bf16x2_t); return __builtin_bit_cast(unsigned, b); }
__device__ __forceinline__ float sigm(float x) { return 1.f / (1.f + __expf(-x)); }
__device__ __forceinline__ float siluf(float x) { return x / (1.f + __expf(-x)); }
__device__ __forceinline__ float logsig(float x) { return fminf(x, 0.f) - log1pf(__expf(-fabsf(x))); }
__device__ __forceinline__ int modrow(int t) { return t < TP ? (t >> 14) : 2 + ((t - TP) >> 4); }
__device__ __forceinline__ float wsum(float v) { for (int m = 32; m >= 1; m >>= 1) v += __shfl_xor(v, m); return v; }
__device__ __forceinline__ float wmax(float v) { for (int m = 32; m >= 1; m >>= 1) v = fmaxf(v, __shfl_xor(v, m)); return v; }
__device__ __forceinline__ int crow(int r, int hi) { return (r & 3) + 8 * (r >> 2) + 4 * hi; }

#define LAS __attribute__((address_space(3)))
#define XB_TMO      128
#define XB_XCNT(j)  (256  + 64 * (j))
#define XB_XSUB(j)  (1280 + 64 * (j))
#define XB_XGEN(j)  (2304 + 64 * (j))
#define XB_TOP      3328
#define XB_TOPGEN   3392
#define XCD_BAR_WORDS 3456
#define XB_SPIN_CAP (1u << 18)
__device__ __forceinline__ unsigned xb_ld(unsigned* p)              { return __hip_atomic_load(p, __ATOMIC_RELAXED, __HIP_MEMORY_SCOPE_AGENT); }
__device__ __forceinline__ unsigned xb_add(unsigned* p, unsigned v) { return __hip_atomic_fetch_add(p, v, __ATOMIC_RELAXED, __HIP_MEMORY_SCOPE_AGENT); }
__device__ __forceinline__ unsigned xb_xcc_id() { return (unsigned)__builtin_amdgcn_s_getreg((3 << 11) | 20) & 0xFu; }
#define XB_SPIN(cond, bar) do { unsigned _sp = 0; while (cond) { __builtin_amdgcn_s_sleep(1); \
    if ((++_sp & 255u) == 0u) { if (xb_ld(&(bar)[XB_TMO])) break; if (_sp > XB_SPIN_CAP) { atomicAdd(&(bar)[XB_TMO], 1u); break; } } } } while (0)
struct XcdBarrier { unsigned* bar; unsigned x; volatile LAS unsigned* st; };
__device__ __forceinline__ XcdBarrier xcd_barrier_post(unsigned* bar, volatile LAS unsigned* st) {
    XcdBarrier b; b.bar = bar; b.x = xb_xcc_id(); b.st = st;
    if (threadIdx.x == 0) (void)xb_add(&bar[XB_XCNT(b.x)], 1u);
    return b;
}
__device__ __forceinline__ void xcd_barrier_complete(unsigned* bar, unsigned x, unsigned& nloc, unsigned& nx) {
    const unsigned G = gridDim.x * gridDim.y * gridDim.z;
    unsigned sum, cnt, mine, sp = 0u;
    for (;;) {
        sum = 0u; cnt = 0u; mine = 0u;
#pragma unroll
        for (unsigned j = 0; j < 16; ++j) { const unsigned c = xb_ld(&bar[XB_XCNT(j)]); sum += c; cnt += (c > 0u) ? 1u : 0u; mine = (j == x) ? c : mine; }
        if (sum == G) break;
        __builtin_amdgcn_s_sleep(1);
        if ((++sp & 255u) == 0u) { if (xb_ld(&bar[XB_TMO])) break; if (sp > XB_SPIN_CAP) { atomicAdd(&bar[XB_TMO], 1u); break; } }
    }
    nloc = mine > 0u ? mine : 1u; nx = cnt > 0u ? cnt : 1u;
}
__device__ __forceinline__ void xcd_barrier(const XcdBarrier& b) {
    asm volatile("s_waitcnt vmcnt(0)" ::: "memory");
    __syncthreads();
    if (threadIdx.x == 0) {
        unsigned* bar = b.bar;
        __builtin_amdgcn_s_waitcnt(0);
        unsigned nloc = b.st[0], nx = b.st[1];
        if (nloc == 0u) { xcd_barrier_complete(bar, b.x, nloc, nx); b.st[0] = nloc; b.st[1] = nx; }
        const unsigned old = xb_add(&bar[XB_XSUB(b.x)], 1u);
        const unsigned gen = old / nloc;
        if (old + 1u == (gen + 1u) * nloc) {
            __builtin_amdgcn_fence(__ATOMIC_RELEASE, "agent");
            asm volatile("s_waitcnt vmcnt(0)" ::: "memory");
            const unsigned og = xb_add(&bar[XB_TOP], 1u);
            const unsigned tg = og / nx;
            if (og + 1u == (tg + 1u) * nx) xb_add(&bar[XB_TOPGEN], 1u);
            else XB_SPIN(xb_ld(&bar[XB_TOPGEN]) == tg, bar);
            __builtin_amdgcn_fence(__ATOMIC_ACQUIRE, "agent");
            xb_add(&bar[XB_XGEN(b.x)], 1u);
            asm volatile("s_waitcnt vmcnt(0)" ::: "memory");
        } else {
            XB_SPIN(xb_ld(&bar[XB_XGEN(b.x)]) == gen, bar);
            __builtin_amdgcn_fence(__ATOMIC_ACQUIRE, "agent");
            asm volatile("s_waitcnt vmcnt(0)" ::: "memory");
        }
    }
    __syncthreads();
}

struct EpiGU { static constexpr bool PERM = true, AFTER_DRAIN = false; u16* ACT;
  __device__ __forceinline__ void operator()(const f32x4 (&acc)[2][2][4][2], const pg8::Unit& u, int wr, int wc, int fr, int fq) const {
    const int row0 = u.pm * 256 + wr * 64 + fr, col0 = u.pn * 128 + wc * 32 + 8 * fq;
#pragma unroll
    for (int ai = 0; ai < 2; ++ai)
#pragma unroll
      for (int m = 0; m < 4; ++m) { const size_t row = row0 + ai * 128 + m * 16;
        const f32x4 g0 = acc[ai][0][m][0], g1 = acc[ai][0][m][1], u0 = acc[ai][1][m][0], u1 = acc[ai][1][m][1];
        u32x4 o; o[0] = pk2(siluf(g0[0]) * u0[0], siluf(g0[1]) * u0[1]); o[1] = pk2(siluf(g0[2]) * u0[2], siluf(g0[3]) * u0[3]);
        o[2] = pk2(siluf(g1[0]) * u1[0], siluf(g1[1]) * u1[1]); o[3] = pk2(siluf(g1[2]) * u1[2], siluf(g1[3]) * u1[3]);
        *(u32x4*)(ACT + row * FF + col0) = o; }
  } };

struct EpiRes { static constexpr bool PERM = false, AFTER_DRAIN = false; const float* xp; const float* xs; float* X; const float* gate; float gs;
  __device__ __forceinline__ void operator()(const f32x4 (&acc)[2][2][4][2], const pg8::Unit& u, int wr, int wc, int fr, int fq) const {
    const int row0 = u.pm * 256 + wr * 64 + fr, col0 = u.pn * 256 + wc * 32 + 4 * fq;
#pragma unroll
    for (int ai = 0; ai < 2; ++ai)
#pragma unroll
      for (int m = 0; m < 4; ++m) { const int row = row0 + ai * 128 + m * 16;
        const float* xr = row < TP ? xp + (size_t)row * D : xs + (size_t)(row - TP) * D; const float* gr = gate + modrow(row) * 9216; float* o = X + (size_t)row * D;
#pragma unroll
        for (int bj = 0; bj < 2; ++bj)
#pragma unroll
          for (int n = 0; n < 2; ++n) { const int c = col0 + bj * 128 + n * 16; const f32x4 xv = *(const f32x4*)(xr + c), gv = *(const f32x4*)(gr + c);
            *(f32x4*)(o + c) = xv * ALPHA + gv * acc[ai][bj][m][n] * gs; } }
  } };

struct EpiIn { static constexpr bool PERM = true, AFTER_DRAIN = false; u16 *AQ, *AK, *AV, *PRE, *MV, *SIGO; float *MI, *MLF; const float* bias; float* out;
  __device__ __forceinline__ void operator()(const f32x4 (&acc)[2][2][4][2], const pg8::Unit& u, int wr, int wc, int fr, int fq) const {
    const int row0 = u.pm * 256 + wr * 64 + fr, pn = u.pn;
#pragma unroll
    for (int ai = 0; ai < 2; ++ai)
#pragma unroll
      for (int m = 0; m < 4; ++m) { const int row = row0 + ai * 128 + m * 16;
#pragma unroll
        for (int bj = 0; bj < 2; ++bj) { const int cl = 128 * bj + 32 * wc + 8 * fq, pc = 256 * pn + cl;
          f32x4 v0 = acc[ai][bj][m][0] + *(const f32x4*)(bias + pc), v1 = acc[ai][bj][m][1] + *(const f32x4*)(bias + pc + 4);
          if (pn < 2) { u32x4 o = {pk2(v0[0] * C2, v0[1] * C2), pk2(v0[2] * C2, v0[3] * C2), pk2(v1[0] * C2, v1[1] * C2), pk2(v1[2] * C2, v1[3] * C2)};
            *(u32x4*)(AQ + (size_t)row * 512 + pc) = o; }
          else if (pn < 6) { const int col = (pn < 4) ? pc - 512 : pc - 1024; u16* B = (pn < 4) ? AK : AV;
            u32x4 o = {pk2(v0[0], v0[1]), pk2(v0[2], v0[3]), pk2(v1[0], v1[1]), pk2(v1[2], v1[3])}; *(u32x4*)(B + (size_t)row * 512 + col) = o;
            float* op = (row < TP) ? out + ((pn < 4) ? O_KP : O_VP) + (size_t)row * 512 + col : out + ((pn < 4) ? O_KS : O_VS) + (size_t)(row - TP) * 512 + col;
            *(f32x4*)op = v0; *(f32x4*)(op + 4) = v1; }
          else if (pn < 10) { const int col = pc - 1536;
            u32x4 o = {pk2(v0[0], v0[1]), pk2(v0[2], v0[3]), pk2(v1[0], v1[1]), pk2(v1[2], v1[3])}; *(u32x4*)(PRE + (size_t)row * 1024 + col) = o;
            if (row < TP) { const int s = row & (SEQ - 1); if (s >= SEQ - 3) { float* op = out + O_CONVP + ((size_t)(row >> 14) * 3 + (s - (SEQ - 3))) * 1024 + col; *(f32x4*)op = v0; *(f32x4*)(op + 4) = v1; } }
            else { const int l = (row - TP) & 15; if (l >= 13) { float* op = out + O_CONVS + ((size_t)((row - TP) >> 4) * 3 + (l - 13)) * 1024 + col; *(f32x4*)op = v0; *(f32x4*)(op + 4) = v1; } } }
          else if (pn < 12) { u32x4 o = {pk2(v0[0], v0[1]), pk2(v0[2], v0[3]), pk2(v1[0], v1[1]), pk2(v1[2], v1[3])}; *(u32x4*)(MV + (size_t)row * 512 + (pc - 2560)) = o; }
          else if (pn < 14) { u32x4 o = {pk2(sigm(v0[0]), sigm(v0[1])), pk2(sigm(v0[2]), sigm(v0[3])), pk2(sigm(v1[0]), sigm(v1[1])), pk2(sigm(v1[2]), sigm(v1[3]))};
            *(u32x4*)(SIGO + (size_t)row * 512 + (pc - 3072)) = o; }
          else { if (bj == 0 && wc == 0) {
              if (fq == 0) { float* op = (row < TP) ? out + O_LFP + (size_t)row * 8 : out + O_LFS + (size_t)(row - TP) * 8;
                f32x4 a = {logsig(v0[0]), logsig(v0[1]), logsig(v0[2]), logsig(v0[3])}, b = {logsig(v1[0]), logsig(v1[1]), logsig(v1[2]), logsig(v1[3])};
                *(f32x4*)op = a; *(f32x4*)(op + 4) = b; }
              else if (fq == 1) { *(f32x4*)(MI + (size_t)row * 4) = v0; f32x4 b = {logsig(v1[0]), logsig(v1[1]), logsig(v1[2]), logsig(v1[3])}; *(f32x4*)(MLF + (size_t)row * 4) = b; } } }
        } }
  } };

template <int MODE> struct EpiMerge { static constexpr bool PERM = true, AFTER_DRAIN = false; u16* O; const u16* Aa; const float* bias;
  __device__ __forceinline__ void operator()(const f32x4 (&acc)[2][2][4][2], const pg8::Unit& u, int wr, int wc, int fr, int fq) const {
    const int row0 = u.pm * 256 + wr * 64 + fr, col0 = u.pn * 256 + wc * 32 + 8 * fq;
#pragma unroll
    for (int ai = 0; ai < 2; ++ai)
#pragma unroll
      for (int m = 0; m < 4; ++m) { const size_t row = row0 + ai * 128 + m * 16;
#pragma unroll
        for (int bj = 0; bj < 2; ++bj) { const int c = col0 + bj * 128; u16* op = O + row * D + c; float r[8];
          const f32x4 a0 = acc[ai][bj][m][0], a1 = acc[ai][bj][m][1];
          if (MODE == 0) { const f32x4 b0 = *(const f32x4*)(bias + c), b1 = *(const f32x4*)(bias + c + 4);
#pragma unroll
            for (int j = 0; j < 4; ++j) { r[j] = sigm(a0[j] + b0[j]); r[4 + j] = sigm(a1[j] + b1[j]); } }
          else { const u32x4 ov = *(const u32x4*)op; float o[8];
#pragma unroll
            for (int j = 0; j < 4; ++j) { o[2 * j] = __uint_as_float(ov[j] << 16); o[2 * j + 1] = __uint_as_float(ov[j] & 0xffff0000u); }
            if (MODE == 1) {
#pragma unroll
              for (int j = 0; j < 4; ++j) { r[j] = o[j] * a0[j]; r[4 + j] = o[4 + j] * a1[j]; } }
            else { const u32x4 av = *(const u32x4*)(Aa + row * D + c); const float accv[8] = {a0[0], a0[1], a0[2], a0[3], a1[0], a1[1], a1[2], a1[3]};
#pragma unroll
              for (int j = 0; j < 4; ++j) { const float x0 = __uint_as_float(av[j] << 16), x1 = __uint_as_float(av[j] & 0xffff0000u);
                r[2 * j] = x0 + o[2 * j] * accv[2 * j]; r[2 * j + 1] = x1 + o[2 * j + 1] * accv[2 * j + 1]; } } }
          u32x4 w = {pk2(r[0], r[1]), pk2(r[2], r[3]), pk2(r[4], r[5]), pk2(r[6], r[7])}; *(u32x4*)op = w; } }
  } };

struct EpiResAtomic { static constexpr bool PERM = false, AFTER_DRAIN = false; float* X; const float* gate; float gs;
  __device__ __forceinline__ void operator()(const f32x4 (&acc)[2][2][4][2], const pg8::Unit& u, int wr, int wc, int fr, int fq) const {
    int fr2 = fr, fq2 = fq; asm volatile("" : "+v"(fr2), "+v"(fq2));
    const int row0 = TP + wr * 64 + fr2, col0 = u.pn * 256 + wc * 32 + 4 * fq2;
#pragma unroll
    for (int ai = 0; ai < 2; ++ai)
#pragma unroll
      for (int m = 0; m < 4; ++m) { const int row = row0 + ai * 128 + m * 16; const float* gr = gate + modrow(row) * 9216; float* o = X + (size_t)row * D;
#pragma unroll
        for (int bj = 0; bj < 2; ++bj)
#pragma unroll
          for (int n = 0; n < 2; ++n) { const int c = col0 + bj * 128 + n * 16; const f32x4 gv = *(const f32x4*)(gr + c);
#pragma unroll
            for (int j = 0; j < 4; ++j) (void)__hip_atomic_fetch_add(o + c + j, gs * gv[j] * acc[ai][bj][m][n][j], __ATOMIC_RELAXED, __HIP_MEMORY_SCOPE_AGENT); }
        asm volatile("" ::: "memory"); }
  } };
struct SplitOrder { int c, n;
  __device__ __forceinline__ bool next(int i, pg8::Unit& u) const { if (i != 0 || c >= n) return false; u.pm = 0; u.pn = c & 3; return true; }
  __device__ __forceinline__ void a_ready(const pg8::Unit&) const {}
  __device__ __forceinline__ void done(const pg8::Unit&) const {} };

template <class Epi> __device__ __forceinline__ void run_gemm(unsigned char* lds, const u16* A, const u16* Bt, int M, int N, int K, const Epi& E) {
  pg8::Gemm g; g.A = A; g.Bt = Bt; g.M = M; g.N = N; g.K = K; g.ld = K;
  pg8::StaticOrder S; S.init(M, N, (int)gridDim.x, (int)blockIdx.x);
  pg8::gemm_phase<Epi, pg8::StaticOrder, GEMM_ALIGN, GEMM_SP2>((PG8_LAS unsigned char*)lds, g, S, E);
  __syncthreads();
}
template <class Epi> __device__ __forceinline__ void run_gemm_split(unsigned char* lds, const u16* A, const u16* Bt, int K, const Epi& E) {
  const int c = (int)blockIdx.x, ks = c >> 2;
  pg8::Gemm g; g.A = A + (size_t)TP * K + ks * 256; g.Bt = Bt + ks * 256; g.M = 256; g.N = 1024; g.K = 256; g.ld = K;
  SplitOrder S; S.c = c; S.n = 4 * (K / 256);
  pg8::gemm_phase<Epi, SplitOrder, GEMM_ALIGN, GEMM_SP2>((PG8_LAS unsigned char*)lds, g, S, E);
  __syncthreads();
}

__device__ __forceinline__ int gu_map(int p) { const int t = p >> 8, r = p & 255; return r < 128 ? t * 128 + r : FF + t * 128 + (r - 128); }
__device__ __forceinline__ int in_map(int p) {
  if (p < 1536) return p; if (p < 2560) return 1544 + (p - 1536); if (p < 3072) return 2568 + (p - 2560); if (p < 3584) return 3088 + (p - 3072);
  if (p < 3592) return 1536 + (p - 3584); if (p < 3596) return 3080 + (p - 3592); if (p < 3600) return 3084 + (p - 3596); if (p < 3840) return -1;
  if (p < 4864) return 3600 + (p - 3840); return 4624 + (p - 4864); }

__device__ __forceinline__ void adaln_unit(const Params& p, float* mod, int unit, unsigned char* lds, int tid) {
  float* sc = (float*)lds; float* red = (float*)(lds + 73728);
  for (int i = tid; i < 18 * 1024; i += NTHR) { const int r = i >> 10, k = i & 1023; const float c = r < 2 ? p.in[9][r * 1024 + k] : p.in[10][(r - 2) * 1024 + k]; sc[i] = siluf(c); }
  __syncthreads();
  const int col = tid & 63, kg = tid >> 6; const float* W = p.in[11] + unit * 64 + col;
  float acc[18];
#pragma unroll
  for (int r = 0; r < 18; ++r) acc[r] = 0.f;
  for (int k0 = kg * 128; k0 < kg * 128 + 128; k0 += 16) { float w[16];
#pragma unroll
    for (int i = 0; i < 16; ++i) w[i] = W[(size_t)(k0 + i) * 9216];
#pragma unroll
    for (int i = 0; i < 16; ++i)
#pragma unroll
      for (int r = 0; r < 18; ++r) acc[r] += sc[r * 1024 + k0 + i] * w[i]; }
#pragma unroll
  for (int r = 0; r < 18; ++r) red[(kg * 18 + r) * 64 + col] = acc[r];
  __syncthreads();
  for (int i = tid; i < 18 * 64; i += NTHR) { const int r = i >> 6, c = i & 63; float s = 0.f; for (int g = 0; g < 8; ++g) s += red[(g * 18 + r) * 64 + c]; mod[r * 9216 + unit * 64 + c] = s + p.in[12][unit * 64 + c]; }
  __syncthreads();
}
template <int MAP> __device__ __forceinline__ void transpose_tile(const float* src, int ld, int K, u16* dst, int p0, int k0, unsigned char* lds, int tid) {
  u16* tl = (u16*)lds;
  { const int pp = tid & 63, kk = tid >> 6; const int sc = MAP == 0 ? p0 + pp : (MAP == 1 ? gu_map(p0 + pp) : in_map(p0 + pp));
#pragma unroll
    for (int i = 0; i < 8; ++i) { const int k = kk + 8 * i; const float v = sc >= 0 ? src[(size_t)(k0 + k) * ld + sc] : 0.f; tl[pp * 66 + k] = f2bf(v); } }
  __syncthreads();
  { const int row = tid >> 3, ch = tid & 7; const unsigned* s = (const unsigned*)(tl + row * 66 + ch * 8); u32x4 v = {s[0], s[1], s[2], s[3]};
    *(u32x4*)(dst + (size_t)(p0 + row) * K + k0 + ch * 8) = v; }
  __syncthreads();
}
__device__ __forceinline__ void prep_phase(const Params& p, unsigned char* lds, int tid_in) { int tid = tid_in;
  unsigned char* ws = p.ws;
  if (blockIdx.x == 0) { int* ctl = (int*)(ws + WS_CTL); if (tid < 64) ctl[tid] = 0; for (int i = tid; i < XCD_BAR_WORDS; i += NTHR) ctl[4096 + i] = 0;
    float* bp = (float*)(ws + WS_BIN); for (int i = tid; i < 5888; i += NTHR) { const int s = in_map(i); bp[i] = s >= 0 ? p.in[16][s] : 0.f; } }
  constexpr int N0 = 88 * 16, N1 = 16 * 44, N2 = 92 * 16, N3 = 16 * 8, N4 = 16 * 8, N5 = 16 * 16, N6 = 88 * 16, N7 = 16 * 44;
  constexpr int total = 144 + N0 + N1 + N2 + N3 + N4 + N5 + N6 + N7;
  for (int w = blockIdx.x; w < total; w += gridDim.x) { asm volatile("" : "+v"(tid));
    if (w < 144) { adaln_unit(p, (float*)(ws + WS_MOD), w, lds, tid); continue; }
    int q = w - 144, j = 0;
    if (q >= N0) { q -= N0; j = 1; if (q >= N1) { q -= N1; j = 2; if (q >= N2) { q -= N2; j = 3; if (q >= N3) { q -= N3; j = 4; if (q >= N4) { q -= N4; j = 5; if (q >= N5) { q -= N5; j = 6; if (q >= N6) { q -= N6; j = 7; } } } } } } }
    switch (j) {
      case 0: transpose_tile<1>(p.in[13], 2 * FF, 1024, (u16*)(ws + WS_WGU1), (q >> 4) * 64, (q & 15) * 64, lds, tid); break;
      case 1: transpose_tile<0>(p.in[14], D, FF, (u16*)(ws + WS_WD1), (q / 44) * 64, (q % 44) * 64, lds, tid); break;
      case 2: transpose_tile<2>(p.in[15], 5648, 1024, (u16*)(ws + WS_WIN), (q >> 4) * 64, (q & 15) * 64, lds, tid); break;
      case 3: transpose_tile<0>(p.in[20], D, 512, (u16*)(ws + WS_WBA), (q >> 3) * 64, (q & 7) * 64, lds, tid); break;
      case 4: transpose_tile<0>(p.in[21], D, 512, (u16*)(ws + WS_WBB), (q >> 3) * 64, (q & 7) * 64, lds, tid); break;
      case 5: transpose_tile<0>(p.in[22], D, 1024, (u16*)(ws + WS_WOUT), (q >> 4) * 64, (q & 15) * 64, lds, tid); break;
      case 6: transpose_tile<1>(p.in[23], 2 * FF, 1024, (u16*)(ws + WS_WGU2), (q >> 4) * 64, (q & 15) * 64, lds, tid); break;
      default: transpose_tile<0>(p.in[24], D, FF, (u16*)(ws + WS_WD2), (q / 44) * 64, (q % 44) * 64, lds, tid); break;
    }
  }
}

template <int MODE> __device__ __forceinline__ void row_phase(const Params& p, int lnidx, int sh_off, int sc_off) {
  int t_ = threadIdx.x; asm volatile("" : "+v"(t_)); const int lane = t_ & 63, wave = t_ >> 6;
  float* X = (float*)(p.ws + WS_X); u16* H = (u16*)(p.ws + WS_H); const float* mod = (const float*)(p.ws + WS_MOD);
  for (int row = blockIdx.x * 8 + wave; row < T; row += gridDim.x * 8) {
    const float* src = MODE == 0 ? (row < TP ? p.in[0] + (size_t)row * D : p.in[1] + (size_t)(row - TP) * D) : X + (size_t)row * D;
    f32x4 v[4];
#pragma unroll
    for (int i = 0; i < 4; ++i) v[i] = *(const f32x4*)(src + lane * 4 + 256 * i);
    if (MODE != 0) {
      float s = 0.f;
#pragma unroll
      for (int i = 0; i < 4; ++i) s += v[i][0] + v[i][1] + v[i][2] + v[i][3];
      const float mu = wsum(s) * (1.f / D); float q = 0.f;
#pragma unroll
      for (int i = 0; i < 4; ++i) { v[i] = v[i] - mu; q += v[i][0] * v[i][0] + v[i][1] * v[i][1] + v[i][2] * v[i][2] + v[i][3] * v[i][3]; }
      const float rstd = rsqrtf(wsum(q) * (1.f / D) + LN_EPS);
#pragma unroll
      for (int i = 0; i < 4; ++i) { const int c = lane * 4 + 256 * i; const f32x4 g = *(const f32x4*)(p.in[25] + lnidx * D + c), b = *(const f32x4*)(p.in[26] + lnidx * D + c); v[i] = v[i] * rstd * g + b; }
    }
    if (MODE == 2) { float* dst = row < TP ? p.out + O_YP + (size_t)row * D : p.out + O_YS + (size_t)(row - TP) * D;
#pragma unroll
      for (int i = 0; i < 4; ++i) *(f32x4*)(dst + lane * 4 + 256 * i) = v[i]; }
    else { const float* mr = mod + modrow(row) * 9216;
#pragma unroll
      for (int i = 0; i < 4; ++i) { const int c = lane * 4 + 256 * i; if (row >= TP) *(f32x4*)(X + (size_t)row * D + c) = v[i] * ALPHA; else if (MODE == 1) *(f32x4*)(X + (size_t)row * D + c) = v[i];
        const f32x4 sh = *(const f32x4*)(mr + sh_off + c), sc = *(const f32x4*)(mr + sc_off + c); const f32x4 h = v[i] * (sc + 1.f) + sh;
        uint2 w; w.x = pk2(h[0], h[1]); w.y = pk2(h[2], h[3]); *(uint2*)(H + (size_t)row * D + c) = w; } }
  }
}

__device__ __forceinline__ void scan_phase(const Params& p, unsigned char* lds, int tid_in) {
  unsigned char* ws = p.ws; float* sm = (float*)lds;
  const float* MI = (const float*)(ws + WS_MI); const float* MLF = (const float*)(ws + WS_MLF);
  for (int u = blockIdx.x; u < 24 + 512; u += gridDim.x) { int tid = tid_in; asm volatile("" : "+v"(tid));
    if (u < 16) {
      const int b = u >> 3, h = u & 7; const float* lf = p.out + O_LFP + ((size_t)b * SEQ) * 8 + h; float* F2 = (float*)(ws + WS_F2) + ((size_t)b * SEQ) * 8 + h;
      float loc[32]; float tot = 0.f;
#pragma unroll
      for (int i = 0; i < 32; ++i) { tot += lf[(size_t)(tid * 32 + i) * 8]; loc[i] = tot; }
      sm[tid] = tot; __syncthreads();
      for (int off = 1; off < NTHR; off <<= 1) { const float v = tid >= off ? sm[tid - off] : 0.f; __syncthreads(); sm[tid] += v; __syncthreads(); }
      const float pre = sm[tid] - tot;
#pragma unroll
      for (int i = 0; i < 32; ++i) F2[(size_t)(tid * 32 + i) * 8] = (pre + loc[i]) * LOG2E;
      __syncthreads();
    } else if (u < 24) {
      const int sq = u - 16, b = sq >> 2, h = sq & 3; const size_t r0 = (size_t)b * SEQ;
      float* MB = (float*)(ws + WS_MB); float* MM = (float*)(ws + WS_MM); float* MST = (float*)(ws + WS_MST);
      float* lfs = sm; float* igs = sm + 16640; float* sA = sm + 33280, *sC = sA + 256, *sE = sA + 512;
#pragma unroll 8
      for (int i = 0; i < 32; ++i) { const int tok = tid + NTHR * i; lfs[tok + (tok >> 6)] = MLF[(r0 + tok) * 4 + h]; igs[tok + (tok >> 6)] = MI[(r0 + tok) * 4 + h]; }
      __syncthreads();
      if (tid < 256) { float bsum = 0.f, ml = -INFINITY; for (int i = 0; i < 64; ++i) { const float lf = lfs[tid * 65 + i], ig = igs[tid * 65 + i]; bsum += lf; ml = fmaxf(lf + ml, ig); } sA[tid] = bsum; sC[tid] = ml; }
      __syncthreads();
      for (int off = 1; off < 256; off <<= 1) { float ap = 0.f, cp = -INFINITY; const bool act = tid < 256 && tid >= off; if (act) { ap = sA[tid - off]; cp = sC[tid - off]; } __syncthreads();
        if (act) { sC[tid] = fmaxf(sA[tid] + cp, sC[tid]); sA[tid] += ap; } __syncthreads(); }
      if (tid < 256) sE[tid] = fmaxf(sA[tid], sC[tid]);
      __syncthreads();
      if (tid < 256) { const float ms = tid > 0 ? sE[tid - 1] : 0.f; float bsum = 0.f, m = ms; for (int i = 0; i < 64; ++i) { const float lf = lfs[tid * 65 + i], ig = igs[tid * 65 + i]; bsum += lf; m = fmaxf(lf + m, ig); lfs[tid * 65 + i] = bsum; igs[tid * 65 + i] = m; }
        MST[sq * 256 + tid] = ms; MST[2048 + sq * 256 + tid] = __expf(bsum + ms - m); if (tid == 255) p.out[O_MP + sq] = m; }
      __syncthreads();
#pragma unroll 8
      for (int i = 0; i < 32; ++i) { const int tok = tid + NTHR * i; MB[(r0 + tok) * 4 + h] = lfs[tok + (tok >> 6)]; MM[(r0 + tok) * 4 + h] = igs[tok + (tok >> 6)]; }
      __syncthreads();
    } else {
      const int v = u - 24, b = v >> 8, tile = v & 255; unsigned* mx = (unsigned*)lds;
      if (tid < 16) mx[tid] = 0u; __syncthreads();
      const int row = tid >> 3, h = tid & 7; const size_t r = (size_t)b * SEQ + tile * 64 + row;
      const u16* kp = (const u16*)(ws + WS_AK) + r * 512 + h * 64; const u16* qp = (const u16*)(ws + WS_AQ) + r * 512 + h * 64;
      float nk = 0.f, nq = 0.f;
#pragma unroll
      for (int i = 0; i < 8; ++i) { const u32x4 a = *(const u32x4*)(kp + i * 8), c = *(const u32x4*)(qp + i * 8);
#pragma unroll
        for (int j = 0; j < 4; ++j) { float x = __uint_as_float(a[j] << 16), y = __uint_as_float(a[j] & 0xffff0000u); nk += x * x + y * y; x = __uint_as_float(c[j] << 16); y = __uint_as_float(c[j] & 0xffff0000u); nq += x * x + y * y; } }
      atomicMax(&mx[h], __float_as_uint(nk)); atomicMax(&mx[8 + h], __float_as_uint(nq)); __syncthreads();
      if (tid < 16) { float* MST = (float*)(ws + WS_MST); const int hh = tid & 7; MST[(tid < 8 ? 4096 : 8192) + (b * 8 + hh) * 256 + tile] = sqrtf(__uint_as_float(mx[tid])) * 1.0001f; }
      __syncthreads();
    }
  }
}

__device__ __forceinline__ void attn_prompt_unit(const Params& p, int b, int h, int qb, unsigned char* lds, int tid, int dry = 0) {
  unsigned char* ws = p.ws;
  const u16* AQ = (const u16*)(ws + WS_AQ); const u16* AK = (const u16*)(ws + WS_AK); const u16* AV = (const u16*)(ws + WS_AV); u16* OA = (u16*)(ws + WS_AQ);
  const float* F2 = (const float*)(ws + WS_F2); const float* MST = (const float*)(ws + WS_MST);
  u16* Ks = (u16*)lds;
  u16* Vt = (u16*)(lds + 18432);
  float* Fk = (float*)(lds + 36864);
  int* si = (int*)(lds + 37376);
  const int lane = tid & 63, wave = tid >> 6, r32 = lane & 31, hi = lane >> 5;
  const size_t rb = (size_t)b * SEQ; const int q0 = qb * 256; const int qrow = q0 + wave * 32 + r32;
  const int tend = 4 * qb + 3;
  int tstart = 0;
#if PRUNE
  { if (tid == 0) si[0] = 4 * qb; __syncthreads();
    const float* KM = MST + 4096 + (b * 8 + h) * 256; const float* QM = MST + 8192 + (b * 8 + h) * 256;
    const float q2 = fmaxf(fmaxf(QM[4 * qb], QM[4 * qb + 1]), fmaxf(QM[4 * qb + 2], QM[4 * qb + 3]));
    const float kd = fmaxf(fmaxf(KM[4 * qb], KM[4 * qb + 1]), fmaxf(KM[4 * qb + 2], KM[4 * qb + 3]));
    const float lower = -q2 * kd; const float fq0 = F2[(rb + q0) * 8 + h];
    if (tid < 4 * qb) { const float upper = q2 * KM[tid] + fq0 - F2[(rb + tid * 64 + 63) * 8 + h]; if (!(upper - lower < -PRUNE_TH)) atomicMin(&si[0], tid); }
    __syncthreads(); tstart = si[0]; __syncthreads(); }
#endif
  bf16x8 qr[4];
#pragma unroll
  for (int d0 = 0; d0 < 4; ++d0) qr[d0] = *(const bf16x8*)(AQ + (rb + qrow) * 512 + h * 64 + d0 * 16 + hi * 8);
  const float fq = F2[(rb + qrow) * 8 + h];
  f32x16 o0, o1;
#pragma unroll
  for (int r = 0; r < 16; ++r) { o0[r] = 0.f; o1[r] = 0.f; }
  float mrun = -INFINITY, lrun = 0.f;
  const int srow = tid >> 3, sch = tid & 7;
  u32x4 kreg, vreg; float freg = 0.f;
  { const size_t r = rb + (size_t)tstart * 64 + srow; kreg = *(const u32x4*)(AK + r * 512 + h * 64 + sch * 8); vreg = *(const u32x4*)(AV + r * 512 + h * 64 + sch * 8);
    if (tid < 64) freg = F2[(rb + (size_t)tstart * 64 + tid) * 8 + h]; }
  int buf = 0;
  for (int t = tstart; t <= tend; ++t) {
    u16* Kb = Ks + buf * 4608; u16* Vb = Vt + buf * 4608; float* Fb = Fk + buf * 64;
    *(u32x4*)(Kb + srow * 72 + sch * 8) = kreg;
#pragma unroll
    for (int j = 0; j < 4; ++j) { Vb[(sch * 8 + 2 * j) * 72 + srow] = (u16)(vreg[j] & 0xffffu); Vb[(sch * 8 + 2 * j + 1) * 72 + srow] = (u16)(vreg[j] >> 16); }
    if (tid < 64) Fb[tid] = freg;
    __syncthreads();
    if (t < tend) { const size_t r = rb + (size_t)(t + 1) * 64 + srow; kreg = *(const u32x4*)(AK + r * 512 + h * 64 + sch * 8); vreg = *(const u32x4*)(AV + r * 512 + h * 64 + sch * 8);
      if (tid < 64) freg = F2[(rb + (size_t)(t + 1) * 64 + tid) * 8 + h]; }
    f32x16 pb[2];
#pragma unroll
    for (int blk = 0; blk < 2; ++blk) {
      f32x16 c;
#pragma unroll
      for (int g = 0; g < 4; ++g) { const f32x4 fk = *(const f32x4*)(Fb + 32 * blk + 8 * g + 4 * hi); c[4 * g] = fq - fk[0]; c[4 * g + 1] = fq - fk[1]; c[4 * g + 2] = fq - fk[2]; c[4 * g + 3] = fq - fk[3]; }
#pragma unroll
      for (int d0 = 0; d0 < 4; ++d0) { const bf16x8 a = *(const bf16x8*)(Kb + (32 * blk + r32) * 72 + d0 * 16 + hi * 8); c = __builtin_amdgcn_mfma_f32_32x32x16_bf16(a, qr[d0], c, 0, 0, 0); }
      pb[blk] = c;
    }
    if (t >= 4 * qb) { const int kb0 = t * 64;
#pragma unroll
      for (int blk = 0; blk < 2; ++blk)
#pragma unroll
        for (int r = 0; r < 16; ++r) { const int kv = kb0 + 32 * blk + crow(r, hi); if (kv > qrow) pb[blk][r] = -INFINITY; } }
    float rm = -INFINITY;
#pragma unroll
    for (int r = 0; r < 16; ++r) rm = fmaxf(rm, fmaxf(pb[0][r], pb[1][r]));
    rm = fmaxf(rm, __shfl_xor(rm, 32));
    const float mnew = fmaxf(mrun, rm);
    const float al = __builtin_amdgcn_exp2f(mrun - mnew);
    float rs = 0.f;
#pragma unroll
    for (int blk = 0; blk < 2; ++blk)
#pragma unroll
      for (int r = 0; r < 16; ++r) { const float e = __builtin_amdgcn_exp2f(pb[blk][r] - mnew); pb[blk][r] = e; rs += e; }
    lrun = lrun * al + rs; mrun = mnew;
#pragma unroll
    for (int r = 0; r < 16; ++r) { o0[r] *= al; o1[r] *= al; }
#pragma unroll
    for (int blk = 0; blk < 2; ++blk)
#pragma unroll
      for (int s = 0; s < 2; ++s) {
        u32x4 pw = {pk2(pb[blk][8 * s], pb[blk][8 * s + 1]), pk2(pb[blk][8 * s + 2], pb[blk][8 * s + 3]), pk2(pb[blk][8 * s + 4], pb[blk][8 * s + 5]), pk2(pb[blk][8 * s + 6], pb[blk][8 * s + 7])};
        const bf16x8 pf = __builtin_bit_cast(bf16x8, pw);
        const int kvo = 32 * blk + 16 * s + 4 * hi;
        { const uint2 x = *(const uint2*)(Vb + r32 * 72 + kvo), y = *(const uint2*)(Vb + r32 * 72 + kvo + 8); u32x4 a = {x.x, x.y, y.x, y.y};
          o0 = __builtin_amdgcn_mfma_f32_32x32x16_bf16(__builtin_bit_cast(bf16x8, a), pf, o0, 0, 0, 0); }
        { const uint2 x = *(const uint2*)(Vb + (32 + r32) * 72 + kvo), y = *(const uint2*)(Vb + (32 + r32) * 72 + kvo + 8); u32x4 a = {x.x, x.y, y.x, y.y};
          o1 = __builtin_amdgcn_mfma_f32_32x32x16_bf16(__builtin_bit_cast(bf16x8, a), pf, o1, 0, 0, 0); }
      }
    buf ^= 1;
  }
  lrun += __shfl_xor(lrun, 32);
  const float inv = 1.f / lrun;
  u16* orow = dry ? (u16*)(ws + WS_END) + (((rb + qrow) * 512 + h * 64) & 0x3fffff) : OA + (rb + qrow) * 512 + h * 64;
#pragma unroll
  for (int g = 0; g < 4; ++g) { uint2 w; w.x = pk2(o0[4 * g] * inv, o0[4 * g + 1] * inv); w.y = pk2(o0[4 * g + 2] * inv, o0[4 * g + 3] * inv); *(uint2*)(orow + 8 * g + 4 * hi) = w;
    w.x = pk2(o1[4 * g] * inv, o1[4 * g + 1] * inv); w.y = pk2(o1[4 * g + 2] * inv, o1[4 * g + 3] * inv); *(uint2*)(orow + 32 + 8 * g + 4 * hi) = w; }
  __syncthreads();
}

__device__ __forceinline__ void attn_sample_unit(const Params& p, int b, int h, unsigned char* lds, int tid, int dry = 0) {
  constexpr int NK = PAST + 16, NTILE = (NK + 31) / 32;
  float* Ft = (float*)lds;
  float* red = (float*)(lds + 8320);
  const int lane = tid & 63, wave = tid >> 6, r32 = lane & 31, hi = lane >> 5, q = r32 & 15;
  unsigned char* wreg = lds + 10752 + wave * 12288;
  u16* Kw = (u16*)wreg; u16* Vw = (u16*)(wreg + 4608); float* Ow = (float*)wreg; float* MLw = (float*)(wreg + 8192);
  const u16* AQ = (const u16*)(p.ws + WS_AQ); u16* OA = (u16*)(p.ws + WS_AQ);
  const float* ck = p.in[2]; const float* cv = p.in[3]; const float* clf = p.in[4];
  { float loc[5]; float tot = 0.f;
#pragma unroll
    for (int i = 0; i < 5; ++i) { const int j = tid * 5 + i; float v = 0.f; if (j < PAST) v = clf[((size_t)b * PAST + j) * 8 + h]; else if (j < NK) v = p.out[O_LFS + (size_t)(b * 16 + j - PAST) * 8 + h]; tot += v; loc[i] = tot; }
    red[tid] = tot; __syncthreads();
    for (int off = 1; off < NTHR; off <<= 1) { const float v = tid >= off ? red[tid - off] : 0.f; __syncthreads(); red[tid] += v; __syncthreads(); }
    const float pre = red[tid] - tot;
#pragma unroll
    for (int i = 0; i < 5; ++i) { const int j = tid * 5 + i; if (j < 2080) Ft[j] = (pre + loc[i]) * LOG2E; }
    __syncthreads(); }
  bf16x8 qr[4];
#pragma unroll
  for (int d0 = 0; d0 < 4; ++d0) qr[d0] = *(const bf16x8*)(AQ + (size_t)(TP + b * 16 + q) * 512 + h * 64 + d0 * 16 + hi * 8);
  const float fq = Ft[PAST + q];
  f32x16 o0, o1;
#pragma unroll
  for (int r = 0; r < 16; ++r) { o0[r] = 0.f; o1[r] = 0.f; }
  float mrun = -INFINITY, lrun = 0.f;
  const int kk = lane >> 1, hh = lane & 1;
  f32x4 kreg[8], vreg[8];
#define SAMPLE_LOAD(t_) do { const int j_ = 32 * (t_) + kk; \
    if (j_ < NK) { const float* kp_ = j_ < PAST ? ck + (((size_t)b * PAST + j_) * 8 + h) * 64 : p.out + O_KS + (size_t)(b * 16 + j_ - PAST) * 512 + h * 64; \
      const float* vp_ = j_ < PAST ? cv + (((size_t)b * PAST + j_) * 8 + h) * 64 : p.out + O_VS + (size_t)(b * 16 + j_ - PAST) * 512 + h * 64; \
      _Pragma("unroll") for (int i_ = 0; i_ < 8; ++i_) { kreg[i_] = *(const f32x4*)(kp_ + hh * 32 + i_ * 4); vreg[i_] = *(const f32x4*)(vp_ + hh * 32 + i_ * 4); } } \
    else { _Pragma("unroll") for (int i_ = 0; i_ < 8; ++i_) { kreg[i_] = (f32x4){0.f, 0.f, 0.f, 0.f}; vreg[i_] = (f32x4){0.f, 0.f, 0.f, 0.f}; } } } while (0)
  SAMPLE_LOAD(wave);
  for (int t = wave; t < NTILE; t += 8) {
#pragma unroll
    for (int i = 0; i < 2; ++i) { u32x4 w0 = {pk2(kreg[4 * i][0], kreg[4 * i][1]), pk2(kreg[4 * i][2], kreg[4 * i][3]), pk2(kreg[4 * i + 1][0], kreg[4 * i + 1][1]), pk2(kreg[4 * i + 1][2], kreg[4 * i + 1][3])};
      u32x4 w1 = {pk2(kreg[4 * i + 2][0], kreg[4 * i + 2][1]), pk2(kreg[4 * i + 2][2], kreg[4 * i + 2][3]), pk2(kreg[4 * i + 3][0], kreg[4 * i + 3][1]), pk2(kreg[4 * i + 3][2], kreg[4 * i + 3][3])};
      *(u32x4*)(Kw + kk * 72 + hh * 32 + i * 16) = w0; *(u32x4*)(Kw + kk * 72 + hh * 32 + i * 16 + 8) = w1; }
#pragma unroll
    for (int i = 0; i < 8; ++i)
#pragma unroll
      for (int e = 0; e < 4; ++e) Vw[(hh * 32 + i * 4 + e) * 40 + kk] = f2bf(vreg[i][e]);
    if (t + 8 < NTILE) SAMPLE_LOAD(t + 8);
    f32x16 c;
#pragma unroll
    for (int g = 0; g < 4; ++g) { const f32x4 fk = *(const f32x4*)(Ft + 32 * t + 8 * g + 4 * hi); c[4 * g] = fq - fk[0]; c[4 * g + 1] = fq - fk[1]; c[4 * g + 2] = fq - fk[2]; c[4 * g + 3] = fq - fk[3]; }
#pragma unroll
    for (int d0 = 0; d0 < 4; ++d0) { const bf16x8 a = *(const bf16x8*)(Kw + r32 * 72 + d0 * 16 + hi * 8); c = __builtin_amdgcn_mfma_f32_32x32x16_bf16(a, qr[d0], c, 0, 0, 0); }
    if (32 * t + 31 > PAST) {
#pragma unroll
      for (int r = 0; r < 16; ++r) { const int kv = 32 * t + crow(r, hi); if (kv > PAST + q) c[r] = -INFINITY; } }
    float rm = -INFINITY;
#pragma unroll
    for (int r = 0; r < 16; ++r) rm = fmaxf(rm, c[r]);
    rm = fmaxf(rm, __shfl_xor(rm, 32));
    const float mnew = fmaxf(mrun, rm); const float al = __builtin_amdgcn_exp2f(mrun - mnew); float rs = 0.f;
#pragma unroll
    for (int r = 0; r < 16; ++r) { const float e = __builtin_amdgcn_exp2f(c[r] - mnew); c[r] = e; rs += e; }
    lrun = lrun * al + rs; mrun = mnew;
#pragma unroll
    for (int r = 0; r < 16; ++r) { o0[r] *= al; o1[r] *= al; }
#pragma unroll
    for (int s2 = 0; s2 < 2; ++s2) {
      u32x4 pw = {pk2(c[8 * s2], c[8 * s2 + 1]), pk2(c[8 * s2 + 2], c[8 * s2 + 3]), pk2(c[8 * s2 + 4], c[8 * s2 + 5]), pk2(c[8 * s2 + 6], c[8 * s2 + 7])};
      const bf16x8 pf = __builtin_bit_cast(bf16x8, pw); const int kvo = 16 * s2 + 4 * hi;
      { const uint2 x = *(const uint2*)(Vw + r32 * 40 + kvo), y = *(const uint2*)(Vw + r32 * 40 + kvo + 8); u32x4 a = {x.x, x.y, y.x, y.y};
        o0 = __builtin_amdgcn_mfma_f32_32x32x16_bf16(__builtin_bit_cast(bf16x8, a), pf, o0, 0, 0, 0); }
      { const uint2 x = *(const uint2*)(Vw + (32 + r32) * 40 + kvo), y = *(const uint2*)(Vw + (32 + r32) * 40 + kvo + 8); u32x4 a = {x.x, x.y, y.x, y.y};
        o1 = __builtin_amdgcn_mfma_f32_32x32x16_bf16(__builtin_bit_cast(bf16x8, a), pf, o1, 0, 0, 0); } }
  }
#undef SAMPLE_LOAD
  lrun += __shfl_xor(lrun, 32);
#pragma unroll
  for (int r = 0; r < 16; ++r) { Ow[crow(r, hi) * 32 + r32] = o0[r]; Ow[(32 + crow(r, hi)) * 32 + r32] = o1[r]; }
  if (hi == 0) { MLw[r32] = mrun; MLw[32 + r32] = lrun; }
  __syncthreads();
  { const int qq = tid & 15, dp = tid >> 4; float M = -INFINITY;
#pragma unroll
    for (int w = 0; w < 8; ++w) M = fmaxf(M, ((const float*)(lds + 10752 + w * 12288 + 8192))[qq]);
    float L = 0.f, a0 = 0.f, a1 = 0.f;
#pragma unroll
    for (int w = 0; w < 8; ++w) { const float* ml = (const float*)(lds + 10752 + w * 12288 + 8192); const float* ow = (const float*)(lds + 10752 + w * 12288); const float sc = __builtin_amdgcn_exp2f(ml[qq] - M);
      L += ml[32 + qq] * sc; a0 += ow[(2 * dp) * 32 + qq] * sc; a1 += ow[(2 * dp + 1) * 32 + qq] * sc; }
    const float inv = 1.f / L;
    u16* dst = (dry ? (u16*)(p.ws + WS_END) : OA + (size_t)TP * 512) + (size_t)(b * 16 + qq) * 512 + h * 64 + 2 * dp;
    *(unsigned*)dst = pk2(a0 * inv, a1 * inv); }
  __syncthreads();
}

template <class CT> __device__ __forceinline__ float ldc(const CT* p);
template <> __device__ __forceinline__ float ldc<u16>(const u16* p) { return bf2f(*p); }
template <> __device__ __forceinline__ float ldc<float>(const float* p) { return *p; }

template <int L, int MODE> __device__ __forceinline__ void mlstm_unit(const Params& p, int b, int h, int c, unsigned char* lds, int tid, int dry = 0) {
  typedef typename std::conditional<MODE == 2, float, u16>::type CT;
  constexpr int CP = (MODE == 2) ? 129 : 130;
  constexpr int OFF_Q = 0, OFF_K = L * 260, OFF_V = 2 * L * 260, OFF_C = 3 * L * 260, OFF_A = OFF_C + 128 * CP * (int)sizeof(CT), OFF_H = OFF_A + L * (L + 1) * 4, OFF_S = OFF_H + L * 128 * 4;
  static_assert(OFF_S + 1024 * 4 <= MISC_OFF && (OFF_C % 4) == 0 && (OFF_A % 4) == 0, "mlstm lds");
  unsigned char* ws = p.ws;
  u16* qs = (u16*)(lds + OFF_Q); u16* ks = (u16*)(lds + OFF_K); u16* vs = (u16*)(lds + OFF_V); CT* Cs = (CT*)(lds + OFF_C); float* A = (float*)(lds + OFF_A); float* Hs = (float*)(lds + OFF_H);
  float* sc = (float*)(lds + OFF_S); float *bt = sc, *ig = sc + 64, *mt = sc + 128, *wint = sc + 192, *den = sc + 256, *nq = sc + 320, *wsv = sc + 384, *ns = sc + 448, *misc = sc + 576;
  const u16* PRE = (const u16*)(ws + WS_PRE); u16* MV = (u16*)(ws + WS_MV); const u16* SIGO = (const u16*)(ws + WS_SIGO);
  const float* MI = (const float*)(ws + WS_MI); const float* MLF = (const float*)(ws + WS_MLF);
  const int sq = b * 4 + h; const int item = sq * 256 + c;
  const size_t r0 = (MODE == 2) ? (size_t)TP + b * 16 : (size_t)b * SEQ + (size_t)c * 64;
  const float* cw = p.in[17]; const float* cb = p.in[18];
  { constexpr int NI = (MODE == 0) ? L * 16 : L * 32;
    for (int idx = tid; idx < NI; idx += NTHR) { const int l = (MODE == 0) ? idx >> 4 : idx >> 5, chk = (MODE == 0) ? 16 + (idx & 15) : idx & 31;
      const int col0 = chk < 16 ? h * 128 + chk * 8 : 512 + h * 128 + (chk - 16) * 8;
      float val[8]; { const f32x4 b0 = *(const f32x4*)(cb + col0), b1 = *(const f32x4*)(cb + col0 + 4);
#pragma unroll
        for (int e = 0; e < 4; ++e) { val[e] = b0[e]; val[4 + e] = b1[e]; } }
#pragma unroll
      for (int j = 0; j < 4; ++j) { const int rr = l - 3 + j; float x[8];
        if (rr >= 0 || (MODE != 2 && c > 0)) { const u32x4 pv = *(const u32x4*)(PRE + (r0 + rr) * 1024 + col0);
#pragma unroll
          for (int e = 0; e < 4; ++e) { x[2 * e] = __uint_as_float(pv[e] << 16); x[2 * e + 1] = __uint_as_float(pv[e] & 0xffff0000u); } }
        else if (MODE == 2) { const float* hp = p.in[8] + ((size_t)b * 3 + (3 + rr)) * 1024 + col0; const f32x4 h0 = *(const f32x4*)hp, h1 = *(const f32x4*)(hp + 4);
#pragma unroll
          for (int e = 0; e < 4; ++e) { x[e] = h0[e]; x[4 + e] = h1[e]; } }
        else {
#pragma unroll
          for (int e = 0; e < 8; ++e) x[e] = 0.f; }
        const f32x4 w0 = *(const f32x4*)(cw + j * 1024 + col0), w1 = *(const f32x4*)(cw + j * 1024 + col0 + 4);
#pragma unroll
        for (int e = 0; e < 4; ++e) { val[e] += x[e] * w0[e]; val[4 + e] += x[4 + e] * w1[e]; } }
      const float scl = chk < 16 ? 1.f : 0.08838834764831845f;
#pragma unroll
      for (int e = 0; e < 8; ++e) val[e] = siluf(val[e]) * scl;
      unsigned* dst = (unsigned*)((chk < 16 ? qs + l * 130 + chk * 8 : ks + l * 130 + (chk - 16) * 8));
      dst[0] = pk2(val[0], val[1]); dst[1] = pk2(val[2], val[3]); dst[2] = pk2(val[4], val[5]); dst[3] = pk2(val[6], val[7]); }
    for (int idx = tid; idx < L * 16; idx += NTHR) { const int l = idx >> 4, ch = idx & 15; const u32x4 v = *(const u32x4*)(MV + (r0 + l) * 512 + h * 128 + ch * 8);
      unsigned* dst = (unsigned*)(vs + l * 130 + ch * 8); dst[0] = v[0]; dst[1] = v[1]; dst[2] = v[2]; dst[3] = v[3]; } }
  float m0;
  if (MODE == 2) { m0 = p.in[7][sq];
    if (tid == 0) { float bs = 0.f, m = m0; for (int l = 0; l < L; ++l) { const float lf = MLF[(r0 + l) * 4 + h], g = MI[(r0 + l) * 4 + h]; bs += lf; m = fmaxf(lf + m, g); bt[l] = bs; ig[l] = g; mt[l] = m; } }
    for (int i = tid; i < 128; i += NTHR) ns[i] = p.in[6][sq * 128 + i];
  } else { m0 = ((const float*)(ws + WS_MST))[item];
    if (tid < L) { bt[tid] = ((const float*)(ws + WS_MB))[(r0 + tid) * 4 + h]; ig[tid] = MI[(r0 + tid) * 4 + h]; mt[tid] = ((const float*)(ws + WS_MM))[(r0 + tid) * 4 + h]; }
    if (MODE == 1) for (int i = tid; i < 128; i += NTHR) ns[i] = ((const float*)(ws + WS_UN))[(size_t)item * 128 + i]; }
  if (MODE == 1) { const u16* Cg = (const u16*)(ws + WS_U) + (size_t)item * 16384;
#pragma unroll
    for (int i = 0; i < 4; ++i) { const int idx = tid + NTHR * i, v = idx >> 4, ch = idx & 15; const u32x4 x = *(const u32x4*)(Cg + v * 128 + ch * 8); unsigned* dst = (unsigned*)((u16*)Cs + v * CP + ch * 8); dst[0] = x[0]; dst[1] = x[1]; dst[2] = x[2]; dst[3] = x[3]; } }
  if (MODE == 2) { const float* Cg = p.in[5] + (size_t)sq * 16384;
#pragma unroll
    for (int i = 0; i < 8; ++i) { const int idx = tid + NTHR * i, v = idx >> 5, c4 = idx & 31; const f32x4 x = *(const f32x4*)(Cg + v * 128 + c4 * 4); float* dst = (float*)Cs + v * CP + c4 * 4; dst[0] = x[0]; dst[1] = x[1]; dst[2] = x[2]; dst[3] = x[3]; } }
  __syncthreads();
  if (tid < L) { wint[tid] = __expf(bt[tid] + m0 - mt[tid]); wsv[tid] = __expf(bt[L - 1] - bt[tid] + ig[tid] - mt[L - 1]); }
  const float mnew = mt[L - 1]; const float wstate = __expf(bt[L - 1] + m0 - mnew);
  if (MODE != 0) {
#pragma unroll 1
    for (int idx = tid; idx < L * L; idx += NTHR) { const int t = idx / L, s = idx % L; float a = 0.f;
      if (s <= t) { float dot = 0.f;
#pragma unroll 8
        for (int d = 0; d < 128; ++d) dot += bf2f(qs[t * 130 + d]) * bf2f(ks[s * 130 + d]);
        a = __expf(bt[t] - bt[s] + ig[s] - mt[t]) * dot; }
      A[t * (L + 1) + s] = a; }
    __syncthreads();
    if (tid < L) { float s = 0.f; for (int j = 0; j <= tid; ++j) s += A[tid * (L + 1) + j]; den[tid] = s; }
    else if (tid >= 64 && tid < 64 + L) { const int t = tid - 64; float s = 0.f; for (int d = 0; d < 128; ++d) s += ns[d] * bf2f(qs[t * 130 + d]); nq[t] = s; }
    __syncthreads();
#pragma unroll 1
    for (int idx = tid; idx < L * 128; idx += NTHR) { const int t = idx >> 7, v = idx & 127; float n1 = 0.f, n2 = 0.f;
#pragma unroll 1
      for (int s = 0; s <= t; ++s) n1 += A[t * (L + 1) + s] * bf2f(vs[s * 130 + v]);
#pragma unroll 8
      for (int d = 0; d < 128; ++d) n2 += ldc<CT>(Cs + v * CP + d) * bf2f(qs[t * 130 + d]);
      const float wi = wint[t]; const float dn = den[t] + wi * nq[t];
      Hs[t * 128 + v] = (n1 + wi * n2) / fmaxf(fabsf(dn), __expf(-mt[t])); }
    __syncthreads();
    { const int lane = tid & 63, wave = tid >> 6;
      for (int t = wave; t < L; t += 8) { const float x0 = Hs[t * 128 + lane], x1 = Hs[t * 128 + 64 + lane]; const float mu = wsum(x0 + x1) * (1.f / 128.f);
        const float y0 = x0 - mu, y1 = x1 - mu; const float rstd = rsqrtf(wsum(y0 * y0 + y1 * y1) * (1.f / 128.f) + LN_EPS);
        const size_t ro = (r0 + t) * 512 + h * 128; const float* ng = p.in[19] + h * 128;
        u16* MO = dry ? (u16*)(ws + WS_END) + (ro & 0x3fffff) : MV + ro; MO[lane] = f2bf(y0 * rstd * ng[lane] * bf2f(SIGO[ro + lane])); MO[64 + lane] = f2bf(y1 * rstd * ng[64 + lane] * bf2f(SIGO[ro + 64 + lane])); } }
  }
  if (MODE != 1) {
    __syncthreads();
    const int v = tid >> 2, dg = tid & 3; float acc[32];
#pragma unroll
    for (int i = 0; i < 32; ++i) acc[i] = 0.f;
#pragma unroll 1
    for (int s = 0; s < L; ++s) { const float wv = wsv[s] * bf2f(vs[s * 130 + v]);
#pragma unroll
      for (int i = 0; i < 32; ++i) acc[i] += wv * bf2f(ks[s * 130 + dg * 32 + i]); }
    if (MODE == 0) { u16* Ug = (u16*)(ws + WS_U) + (size_t)item * 16384 + v * 128 + dg * 32;
#pragma unroll
      for (int i = 0; i < 4; ++i) { u32x4 w = {pk2(acc[8 * i], acc[8 * i + 1]), pk2(acc[8 * i + 2], acc[8 * i + 3]), pk2(acc[8 * i + 4], acc[8 * i + 5]), pk2(acc[8 * i + 6], acc[8 * i + 7])}; *(u32x4*)(Ug + 8 * i) = w; }
      if (tid < 128) { float s = 0.f; for (int j = 0; j < L; ++j) s += wsv[j] * bf2f(ks[j * 130 + tid]); ((float*)(ws + WS_UN))[(size_t)item * 128 + tid] = s; } }
    else { float* Cg = p.out + O_CS + (size_t)sq * 16384 + v * 128 + dg * 32;
#pragma unroll
      for (int i = 0; i < 32; ++i) Cg[i] = wstate * ldc<CT>(Cs + v * CP + dg * 32 + i) + acc[i];
      if (tid < 128) { float s = 0.f; for (int j = 0; j < L; ++j) s += wsv[j] * bf2f(ks[j * 130 + tid]); p.out[O_NS + sq * 128 + tid] = wstate * ns[tid] + s; }
      if (tid == 0) p.out[O_MS + sq] = mnew; }
  }
  __syncthreads();
}

__device__ __forceinline__ void conv8(const u16* PRE, const float* cw, const float* cb, size_t r0, int l, int col0, bool hasprev, float scl, float (&val)[8]) {
  { const f32x4 b0 = *(const f32x4*)(cb + col0), b1 = *(const f32x4*)(cb + col0 + 4);
#pragma unroll
    for (int e = 0; e < 4; ++e) { val[e] = b0[e]; val[4 + e] = b1[e]; } }
#pragma unroll
  for (int j = 0; j < 4; ++j) { const int rr = l - 3 + j;
    if (rr >= 0 || hasprev) { const u32x4 pv = *(const u32x4*)(PRE + (r0 + rr) * 1024 + col0);
      const f32x4 w0 = *(const f32x4*)(cw + j * 1024 + col0), w1 = *(const f32x4*)(cw + j * 1024 + col0 + 4);
#pragma unroll
      for (int e = 0; e < 4; ++e) { const float x0 = __uint_as_float(pv[e] << 16), x1 = __uint_as_float(pv[e] & 0xffff0000u);
        const float wa = (2 * e < 4) ? w0[(2 * e) & 3] : w1[(2 * e) & 3], wb = (2 * e + 1 < 4) ? w0[(2 * e + 1) & 3] : w1[(2 * e + 1) & 3];
        val[2 * e] += x0 * wa; val[2 * e + 1] += x1 * wb; } } }
#pragma unroll
  for (int e = 0; e < 8; ++e) val[e] = siluf(val[e]) * scl;
}

__device__ __forceinline__ void mlstm_h1_unit(const Params& p, int b, int h, int c, unsigned char* lds, int tid) {
  unsigned char* ws = p.ws;
  u16* vT = (u16*)lds; u16* kT = (u16*)(lds + 18432); float* wsv = (float*)(lds + 36864);
  const u16* PRE = (const u16*)(ws + WS_PRE); const u16* MV = (const u16*)(ws + WS_MV);
  const float* MI = (const float*)(ws + WS_MI); const float* MB = (const float*)(ws + WS_MB); const float* MM = (const float*)(ws + WS_MM);
  const int sq = b * 4 + h, item = sq * 256 + c; const size_t r0 = (size_t)b * SEQ + (size_t)c * 64;
  const int lane = tid & 63, wave = tid >> 6, r32 = lane & 31, hi = lane >> 5;
  if (tid < 64) wsv[tid] = __expf(MB[(r0 + 63) * 4 + h] - MB[(r0 + tid) * 4 + h] + MI[(r0 + tid) * 4 + h] - MM[(r0 + 63) * 4 + h]);
  __syncthreads();
#pragma unroll
  for (int it = 0; it < 2; ++it) { const int idx = tid + NTHR * it, l = idx >> 4, chk = idx & 15; float val[8];
    conv8(PRE, p.in[17], p.in[18], r0, l, 512 + h * 128 + chk * 8, c > 0, 0.08838834764831845f, val);
#pragma unroll
    for (int e = 0; e < 8; ++e) kT[(chk * 8 + e) * 72 + l] = f2bf(val[e]); }
#pragma unroll
  for (int it = 0; it < 2; ++it) { const int idx = tid + NTHR * it, l = idx >> 4, ch = idx & 15; const u32x4 v = *(const u32x4*)(MV + (r0 + l) * 512 + h * 128 + ch * 8); const float w = wsv[l];
#pragma unroll
    for (int e = 0; e < 4; ++e) { vT[(ch * 8 + 2 * e) * 72 + l] = f2bf(__uint_as_float(v[e] << 16) * w); vT[(ch * 8 + 2 * e + 1) * 72 + l] = f2bf(__uint_as_float(v[e] & 0xffff0000u) * w); } }
  __syncthreads();
  u16* Ug = (u16*)(ws + WS_U) + (size_t)item * 16384;
#pragma unroll
  for (int ti = 0; ti < 2; ++ti) { const int i = wave * 2 + ti, vb = i >> 2, db = i & 3; f32x16 acc;
#pragma unroll
    for (int r = 0; r < 16; ++r) acc[r] = 0.f;
#pragma unroll
    for (int k0 = 0; k0 < 64; k0 += 16) { const bf16x8 a = *(const bf16x8*)(vT + (vb * 32 + r32) * 72 + k0 + 8 * hi), bb = *(const bf16x8*)(kT + (db * 32 + r32) * 72 + k0 + 8 * hi);
      acc = __builtin_amdgcn_mfma_f32_32x32x16_bf16(a, bb, acc, 0, 0, 0); }
#pragma unroll
    for (int r = 0; r < 16; ++r) Ug[(vb * 32 + crow(r, hi)) * 128 + db * 32 + r32] = f2bf(acc[r]); }
  if (tid < 128) { float s2 = 0.f;
#pragma unroll 8
    for (int j = 0; j < 64; ++j) s2 += bf2f(kT[tid * 72 + j]) * wsv[j];
    ((float*)(ws + WS_UN))[(size_t)item * 128 + tid] = s2; }
  __syncthreads();
}

__device__ __forceinline__ void mlstm_h3_unit(const Params& p, int b, int h, int c, unsigned char* lds, int tid, int dry = 0) {
  unsigned char* ws = p.ws;
  u16* qs = (u16*)lds; u16* ks = (u16*)(lds + 17408); u16* vT = (u16*)(lds + 34816); u16* Cs = (u16*)(lds + 53248); u16* At = (u16*)(lds + 88064); float* Hs = (float*)(lds + 97280);
  float* sc = (float*)(lds + 130048); float *bt = sc, *ig = sc + 64, *mt = sc + 128, *wint = sc + 192, *den = sc + 256, *nq = sc + 320, *ns = sc + 384;
  const u16* PRE = (const u16*)(ws + WS_PRE); u16* MV = (u16*)(ws + WS_MV); const u16* SIGO = (const u16*)(ws + WS_SIGO);
  const float* MI = (const float*)(ws + WS_MI); const float* MB = (const float*)(ws + WS_MB); const float* MM = (const float*)(ws + WS_MM);
  const int sq = b * 4 + h, item = sq * 256 + c; const size_t r0 = (size_t)b * SEQ + (size_t)c * 64;
  const int lane = tid & 63, wave = tid >> 6, r32 = lane & 31, hi = lane >> 5;
  if (tid < 64) { const float m0 = ((const float*)(ws + WS_MST))[item]; const float bb = MB[(r0 + tid) * 4 + h], mm = MM[(r0 + tid) * 4 + h]; bt[tid] = bb; ig[tid] = MI[(r0 + tid) * 4 + h]; mt[tid] = mm; wint[tid] = __expf(bb + m0 - mm); }
  else if (tid >= 128 && tid < 256) ns[tid - 128] = ((const float*)(ws + WS_UN))[(size_t)item * 128 + tid - 128];
#pragma unroll
  for (int it = 0; it < 4; ++it) { const int idx = tid + NTHR * it, l = idx >> 5, chk = idx & 31; float val[8];
    const int col0 = chk < 16 ? h * 128 + chk * 8 : 512 + h * 128 + (chk - 16) * 8;
    conv8(PRE, p.in[17], p.in[18], r0, l, col0, c > 0, chk < 16 ? 1.f : 0.08838834764831845f, val);
    u32x4 w = {pk2(val[0], val[1]), pk2(val[2], val[3]), pk2(val[4], val[5]), pk2(val[6], val[7])};
    *(u32x4*)((chk < 16 ? qs : ks) + l * 136 + (chk & 15) * 8) = w; }
#pragma unroll
  for (int it = 0; it < 2; ++it) { const int idx = tid + NTHR * it, l = idx >> 4, ch = idx & 15; const u32x4 v = *(const u32x4*)(MV + (r0 + l) * 512 + h * 128 + ch * 8);
#pragma unroll
    for (int e = 0; e < 4; ++e) { vT[(ch * 8 + 2 * e) * 72 + l] = (u16)(v[e] & 0xffffu); vT[(ch * 8 + 2 * e + 1) * 72 + l] = (u16)(v[e] >> 16); } }
  { const u16* Cg = (const u16*)(ws + WS_U) + (size_t)item * 16384;
#pragma unroll
    for (int it = 0; it < 4; ++it) { const int idx = tid + NTHR * it, v = idx >> 4, ch = idx & 15; *(u32x4*)(Cs + v * 136 + ch * 8) = *(const u32x4*)(Cg + v * 128 + ch * 8); } }
  __syncthreads();
  { const int l15 = lane & 15, l4 = lane >> 4;
#pragma unroll
    for (int ti = 0; ti < 2; ++ti) { const int i = wave * 2 + ti, tb = i >> 2, sb = i & 3; const int t = tb * 16 + l15, s0 = sb * 16 + 4 * l4; uint2 w; w.x = 0u; w.y = 0u;
      if (sb <= tb) { f32x4 acc = {0.f, 0.f, 0.f, 0.f};
#pragma unroll
        for (int k0 = 0; k0 < 128; k0 += 32) { const bf16x8 a = *(const bf16x8*)(ks + (sb * 16 + l15) * 136 + k0 + 8 * l4), bq = *(const bf16x8*)(qs + (tb * 16 + l15) * 136 + k0 + 8 * l4);
          acc = __builtin_amdgcn_mfma_f32_16x16x32_bf16(a, bq, acc, 0, 0, 0); }
        float av[4]; const float bmt = bt[t] - mt[t];
#pragma unroll
        for (int r = 0; r < 4; ++r) { const int s2 = s0 + r; av[r] = (s2 <= t) ? __expf(bmt - bt[s2] + ig[s2]) * acc[r] : 0.f; }
        w.x = pk2(av[0], av[1]); w.y = pk2(av[2], av[3]); }
      *(uint2*)(At + t * 72 + s0) = w; } }
  __syncthreads();
  if (tid < 64) { float s2 = 0.f;
#pragma unroll 8
    for (int j = 0; j < 64; ++j) s2 += bf2f(At[tid * 72 + j]); den[tid] = s2; }
  else if (tid < 128) { const int t = tid - 64; float s2 = 0.f;
#pragma unroll 8
    for (int d = 0; d < 128; ++d) s2 += ns[d] * bf2f(qs[t * 136 + d]); nq[t] = s2; }
  f32x16 a1, a2;
  { const int tb = wave >> 2, vb = wave & 3;
#pragma unroll
    for (int r = 0; r < 16; ++r) { a1[r] = 0.f; a2[r] = 0.f; }
#pragma unroll
    for (int k0 = 0; k0 < 64; k0 += 16) { const bf16x8 a = *(const bf16x8*)(At + (tb * 32 + r32) * 72 + k0 + 8 * hi), bv = *(const bf16x8*)(vT + (vb * 32 + r32) * 72 + k0 + 8 * hi);
      a1 = __builtin_amdgcn_mfma_f32_32x32x16_bf16(a, bv, a1, 0, 0, 0); }
#pragma unroll
    for (int k0 = 0; k0 < 128; k0 += 16) { const bf16x8 a = *(const bf16x8*)(qs + (tb * 32 + r32) * 136 + k0 + 8 * hi), bc = *(const bf16x8*)(Cs + (vb * 32 + r32) * 136 + k0 + 8 * hi);
      a2 = __builtin_amdgcn_mfma_f32_32x32x16_bf16(a, bc, a2, 0, 0, 0); } }
  __syncthreads();
  { const int tb = wave >> 2, vb = wave & 3;
#pragma unroll
    for (int r = 0; r < 16; ++r) { const int t = tb * 32 + crow(r, hi); const float wi = wint[t]; const float dn = den[t] + wi * nq[t];
      Hs[t * 128 + vb * 32 + r32] = (a1[r] + wi * a2[r]) / fmaxf(fabsf(dn), __expf(-mt[t])); } }
  __syncthreads();
  for (int t = wave; t < 64; t += 8) { const float x0 = Hs[t * 128 + lane], x1 = Hs[t * 128 + 64 + lane]; const float mu = wsum(x0 + x1) * (1.f / 128.f);
    const float y0 = x0 - mu, y1 = x1 - mu; const float rstd = rsqrtf(wsum(y0 * y0 + y1 * y1) * (1.f / 128.f) + LN_EPS);
    const size_t ro = (r0 + t) * 512 + h * 128; const float* ng = p.in[19] + h * 128;
    u16* MO = dry ? (u16*)(ws + WS_END) + (ro & 0x3fffff) : MV + ro; MO[lane] = f2bf(y0 * rstd * ng[lane] * bf2f(SIGO[ro + lane])); MO[64 + lane] = f2bf(y1 * rstd * ng[64 + lane] * bf2f(SIGO[ro + 64 + lane])); }
  __syncthreads();
}

__device__ __forceinline__ void state_scan_phase(const Params& p, int tid) {
  unsigned char* ws = p.ws; const float* WST = (const float*)(ws + WS_MST) + 2048;
  for (int u = blockIdx.x; u < 130; u += gridDim.x) {
    const int gi = u * NTHR + tid;
    if (gi < 65536) { const int sq = gi >> 13, e2 = gi & 8191; unsigned* U = (unsigned*)((u16*)(ws + WS_U) + (size_t)sq * 256 * 16384) + e2; const float* w = WST + sq * 256; float C0 = 0.f, C1 = 0.f;
      for (int c0 = 0; c0 < 256; c0 += 16) { unsigned tmp[16];
#pragma unroll
        for (int i = 0; i < 16; ++i) tmp[i] = U[(size_t)(c0 + i) * 8192];
#pragma unroll
        for (int i = 0; i < 16; ++i) { U[(size_t)(c0 + i) * 8192] = pk2(C0, C1); const float wc = w[c0 + i]; C0 = wc * C0 + __uint_as_float(tmp[i] << 16); C1 = wc * C1 + __uint_as_float(tmp[i] & 0xffff0000u); } }
      p.out[O_CP + 2 * gi] = C0; p.out[O_CP + 2 * gi + 1] = C1; }
    else if (gi < 65536 + 1024) { const int g2 = gi - 65536, sq = g2 >> 7, e = g2 & 127; float* U = (float*)(ws + WS_UN) + (size_t)sq * 256 * 128 + e; const float* w = WST + sq * 256; float C = 0.f;
      for (int c0 = 0; c0 < 256; c0 += 16) { float tmp[16];
#pragma unroll
        for (int i = 0; i < 16; ++i) tmp[i] = U[(size_t)(c0 + i) * 128];
#pragma unroll
        for (int i = 0; i < 16; ++i) { U[(size_t)(c0 + i) * 128] = C; C = w[c0 + i] * C + tmp[i]; } }
      p.out[O_NP + g2] = C; }
  }
}

__global__ void __launch_bounds__(NTHR, 2) fwd_kernel(Params p) {
  extern __shared__ __attribute__((aligned(16))) unsigned char lds[];
  cg::grid_group grid = cg::this_grid();
#define OTID() ({ int t_ = threadIdx.x; asm volatile("" : "+v"(t_)); t_; })
  int tid = OTID(); unsigned char* ws = p.ws;
  int* ctl = (int*)(ws + WS_CTL); int* s_u = (int*)(lds + MISC_OFF);
  float* X = (float*)(ws + WS_X); u16* H = (u16*)(ws + WS_H); u16* ACT = (u16*)(ws + WS_ACT); const float* mod = (const float*)(ws + WS_MOD);
  volatile LAS unsigned* st = (volatile LAS unsigned*)(lds + MISC_OFF + 16);
  if (tid == 0) { st[0] = 0u; st[1] = 0u; }
  __syncthreads();
  prep_phase(p, lds, tid);
  grid.sync(); tid = OTID();
  XcdBarrier xbar = xcd_barrier_post((unsigned*)(ws + WS_CTL) + 4096, st);
#if PROBE == 3
  prep_phase(p, lds, tid); xcd_barrier(xbar); tid = OTID();
  for (int i = 0; i < 16; ++i) xcd_barrier(xbar);
  row_phase<0>(p, 0, 0, 1024); xcd_barrier(xbar); tid = OTID();
#endif
  row_phase<0>(p, 0, 0, 1024);
  xcd_barrier(xbar); tid = OTID();
  { EpiGU E; E.ACT = ACT; run_gemm(lds, H, (const u16*)(ws + WS_WGU1), T, 2 * FF, D, E); }
  xcd_barrier(xbar); tid = OTID();
#if PROBE == 4
  { EpiGU E; E.ACT = ACT; run_gemm(lds, H, (const u16*)(ws + WS_WGU1), T, 2 * FF, D, E); }
  xcd_barrier(xbar); tid = OTID();
#endif
  { EpiRes E; E.xp = p.in[0]; E.xs = p.in[1]; E.X = X; E.gate = mod + 2048; E.gs = 0.5f; run_gemm(lds, ACT, (const u16*)(ws + WS_WD1), TP, D, FF, E);
    EpiResAtomic EA; EA.X = X; EA.gate = E.gate; EA.gs = E.gs; run_gemm_split(lds, ACT, (const u16*)(ws + WS_WD1), FF, EA); }
  xcd_barrier(xbar); tid = OTID();
  row_phase<1>(p, 0, 3072, 4096);
  xcd_barrier(xbar); tid = OTID();
  { EpiIn E; E.AQ = (u16*)(ws + WS_AQ); E.AK = (u16*)(ws + WS_AK); E.AV = (u16*)(ws + WS_AV); E.PRE = (u16*)(ws + WS_PRE); E.MV = (u16*)(ws + WS_MV); E.SIGO = (u16*)(ws + WS_SIGO);
    E.MI = (float*)(ws + WS_MI); E.MLF = (float*)(ws + WS_MLF); E.bias = (const float*)(ws + WS_BIN); E.out = p.out; run_gemm(lds, H, (const u16*)(ws + WS_WIN), T, 3840, D, E); }
  xcd_barrier(xbar); tid = OTID();
#if PROBE == 5
  { EpiIn E; E.AQ = (u16*)(ws + WS_AQ); E.AK = (u16*)(ws + WS_AK); E.AV = (u16*)(ws + WS_AV); E.PRE = (u16*)(ws + WS_PRE); E.MV = (u16*)(ws + WS_MV); E.SIGO = (u16*)(ws + WS_SIGO);
    E.MI = (float*)(ws + WS_MI); E.MLF = (float*)(ws + WS_MLF); E.bias = (const float*)(ws + WS_BIN); E.out = p.out; run_gemm(lds, H, (const u16*)(ws + WS_WIN), T, 3840, D, E); }
  xcd_barrier(xbar); tid = OTID();
#endif
  scan_phase(p, lds, tid);
  xcd_barrier(xbar); tid = OTID();
#if PROBE == 1
  for (;;) { __syncthreads(); if (tid == 0) *s_u = atomicAdd(&ctl[3], 1); __syncthreads(); const int u = *s_u; if (u >= 128 + 1024) break; asm volatile("" : "+v"(tid));
    if (u < 128) attn_sample_unit(p, u >> 3, u & 7, lds, tid, 1);
    else { const int v = u - 128; attn_prompt_unit(p, (v & 15) >> 3, v & 7, 63 - (v >> 4), lds, tid, 1); } }
  xcd_barrier(xbar); tid = OTID();
#endif
#if PROBE == 3
  scan_phase(p, lds, tid); xcd_barrier(xbar); tid = OTID();
#endif
  for (;;) { __syncthreads(); if (tid == 0) *s_u = atomicAdd(&ctl[0], 1); __syncthreads(); const int u = *s_u; if (u >= 128 + 1024) break; asm volatile("" : "+v"(tid));
    if (u < 128) attn_sample_unit(p, u >> 3, u & 7, lds, tid);
    else { const int v = u - 128; attn_prompt_unit(p, (v & 15) >> 3, v & 7, 63 - (v >> 4), lds, tid); } }
  xcd_barrier(xbar); tid = OTID();
#if PROBE == 2
  for (;;) { __syncthreads(); if (tid == 0) *s_u = atomicAdd(&ctl[5], 1); __syncthreads(); const int u = *s_u; if (u >= 2048) break; asm volatile("" : "+v"(tid));
    mlstm_h1_unit(p, u >> 10, (u >> 8) & 3, u & 255, lds, tid); }
  xcd_barrier(xbar); tid = OTID();
#endif
  for (;;) { __syncthreads(); if (tid == 0) *s_u = atomicAdd(&ctl[1], 1); __syncthreads(); const int u = *s_u; if (u >= 64 + 2048) break; asm volatile("" : "+v"(tid));
    if (u < 64) mlstm_unit<16, 2>(p, u >> 2, u & 3, 0, lds, tid);
    else { const int v = u - 64; mlstm_h1_unit(p, v >> 10, (v >> 8) & 3, v & 255, lds, tid); } }
  xcd_barrier(xbar); tid = OTID();
  state_scan_phase(p, tid);
  xcd_barrier(xbar); tid = OTID();
#if PROBE == 2
  for (;;) { __syncthreads(); if (tid == 0) *s_u = atomicAdd(&ctl[4], 1); __syncthreads(); const int u = *s_u; if (u >= 2048) break; asm volatile("" : "+v"(tid));
    mlstm_h3_unit(p, u >> 10, (u >> 8) & 3, u & 255, lds, tid, 1); }
  xcd_barrier(xbar); tid = OTID();
#endif
  for (;;) { __syncthreads(); if (tid == 0) *s_u = atomicAdd(&ctl[2], 1); __syncthreads(); const int u = *s_u; if (u >= 2048) break; asm volatile("" : "+v"(tid));
    mlstm_h3_unit(p, u >> 10, (u >> 8) & 3, u & 255, lds, tid); }
  xcd_barrier(xbar); tid = OTID();
  { const float* bias = (const float*)(ws + WS_BIN); u16* GA = (u16*)(ws + WS_GA); u16* GB = (u16*)(ws + WS_GB); const u16* WIN = (const u16*)(ws + WS_WIN);
    { EpiMerge<0> E; E.O = GA; E.Aa = nullptr; E.bias = bias + 3840; run_gemm(lds, H, WIN + (size_t)3840 * D, T, D, D, E); }
    { EpiMerge<1> E; E.O = GA; E.Aa = nullptr; E.bias = nullptr; run_gemm(lds, (const u16*)(ws + WS_AQ), (const u16*)(ws + WS_WBA), T, D, 512, E); }
    { EpiMerge<0> E; E.O = GB; E.Aa = nullptr; E.bias = bias + 4864; run_gemm(lds, H, WIN + (size_t)4864 * D, T, D, D, E); }
    { EpiMerge<2> E; E.O = GB; E.Aa = GA; E.bias = nullptr; run_gemm(lds, (const u16*)(ws + WS_MV), (const u16*)(ws + WS_WBB), T, D, 512, E); } }
  xcd_barrier(xbar); tid = OTID();
#if PROBE == 5
  { const float* bias = (const float*)(ws + WS_BIN); u16* GA = (u16*)(ws + WS_GA); u16* GB = (u16*)(ws + WS_GB); const u16* WIN = (const u16*)(ws + WS_WIN);
    { EpiMerge<0> E; E.O = GA; E.Aa = nullptr; E.bias = bias + 3840; run_gemm(lds, H, WIN + (size_t)3840 * D, T, D, D, E); }
    { EpiMerge<1> E; E.O = GA; E.Aa = nullptr; E.bias = nullptr; run_gemm(lds, (const u16*)(ws + WS_AQ), (const u16*)(ws + WS_WBA), T, D, 512, E); }
    { EpiMerge<0> E; E.O = GB; E.Aa = nullptr; E.bias = bias + 4864; run_gemm(lds, H, WIN + (size_t)4864 * D, T, D, D, E); }
    { EpiMerge<2> E; E.O = GB; E.Aa = GA; E.bias = nullptr; run_gemm(lds, (const u16*)(ws + WS_MV), (const u16*)(ws + WS_WBB), T, D, 512, E); } }
  xcd_barrier(xbar); tid = OTID();
#endif
  { EpiRes E; E.xp = X; E.xs = X + (size_t)TP * D; E.X = X; E.gate = mod + 5120; E.gs = 1.0f; run_gemm(lds, (const u16*)(ws + WS_GB), (const u16*)(ws + WS_WOUT), TP, D, D, E);
    EpiResAtomic EA; EA.X = X; EA.gate = E.gate; EA.gs = E.gs; run_gemm_split(lds, (const u16*)(ws + WS_GB), (const u16*)(ws + WS_WOUT), D, EA); }
  xcd_barrier(xbar); tid = OTID();
  row_phase<1>(p, 1, 6144, 7168);
  xcd_barrier(xbar); tid = OTID();
  { EpiGU E; E.ACT = ACT; run_gemm(lds, H, (const u16*)(ws + WS_WGU2), T, 2 * FF, D, E); }
  xcd_barrier(xbar); tid = OTID();
  { EpiRes E; E.xp = X; E.xs = X + (size_t)TP * D; E.X = X; E.gate = mod + 8192; E.gs = 0.5f; run_gemm(lds, ACT, (const u16*)(ws + WS_WD2), TP, D, FF, E);
    EpiResAtomic EA; EA.X = X; EA.gate = E.gate; EA.gs = E.gs; run_gemm_split(lds, ACT, (const u16*)(ws + WS_WD2), FF, EA); }
  xcd_barrier(xbar); tid = OTID();
  row_phase<2>(p, 2, 0, 0);
}

extern "C" void kernel_launch(void* const* d_in, const int* in_sizes, int n_in, void* d_out, int out_size, void* d_ws, size_t ws_size, hipStream_t stream) {
  static int grid = 0;
  if (grid == 0) {
    if (n_in != 27 || ws_size < WS_END) { fprintf(stderr, "kernel_launch: unexpected n_in %d / ws_size %zu (need %zu)\n", n_in, ws_size, (size_t)WS_END); grid = -1; return; }
    int dev = 0, cus = 0, per_cu = 0;
    hipGetDevice(&dev); hipDeviceGetAttribute(&cus, hipDeviceAttributeMultiprocessorCount, dev);
    if (hipFuncSetAttribute((const void*)fwd_kernel, hipFuncAttributeMaxDynamicSharedMemorySize, LDS_BYTES) != hipSuccess) { fprintf(stderr, "kernel_launch: hipFuncSetAttribute failed\n"); grid = -1; return; }
    if (hipOccupancyMaxActiveBlocksPerMultiprocessor(&per_cu, (const void*)fwd_kernel, NTHR, LDS_BYTES) != hipSuccess || per_cu < 1) { fprintf(stderr, "kernel_launch: occupancy query says %d\n", per_cu); per_cu = 1; }
    (void)hipGetLastError();
    grid = cus * 1;
  }
  if (grid < 0) return;
  Params p{};
  for (int i = 0; i < 27; ++i) p.in[i] = (const float*)d_in[i];
  p.out = (float*)d_out; p.ws = (unsigned char*)d_ws;
  void* args[] = {&p};
  hipError_t e = hipLaunchCooperativeKernel((const void*)fwd_kernel, dim3(grid), dim3(NTHR), args, LDS_BYTES, stream);
  if (e != hipSuccess) fprintf(stderr, "cooperative launch failed: %s (grid %d)\n", hipGetErrorString(e), grid);
}
```

```cpp
#include <hip/hip_runtime.h>
#include <hip/hip_cooperative_groups.h>
#include <cstdio>
#include <cstdint>
#include <type_traits>
namespace cg = cooperative_groups;
namespace pg8 {
#define PG8_LAS __attribute__((address_space(3)))
typedef unsigned short bf16_t;
typedef short bf16x8 __attribute__((ext_vector_type(8)));
typedef float f32x4 __attribute__((ext_vector_type(4)));
typedef unsigned u32x4 __attribute__((ext_vector_type(4)));
constexpr int BM = 256, BK = 64, HALF = 128, HTB = HALF * BK * 2  , STAGE_BYTES = 8 * HTB, NXCD = 8, WGM = 8;

__host__ __device__ __forceinline__ int lds_byte(int r, int c) { const int st = (r >> 4) * 2 + (c >> 5), rr = r & 15, cc = c & 31, ob = rr * 64 + cc * 2; return st * 1024 + (ob ^ (((ob >> 9) & 1) << 5)); }
__host__ __device__ __forceinline__ void stage_rc(int b, int& R, int& C) { const int st = b / 1024, sb = b % 1024, swz = sb ^ (((sb >> 9) & 1) << 5); R = (st >> 1) * 16 + swz / 64; C = (st & 1) * 32 + (swz % 64) / 2; }
__host__ __device__ __forceinline__ int perm32(int rho) { const int n = rho >> 4, i = rho & 15; return 8 * (i >> 2) + 4 * n + (i & 3); }

struct Unit { int pm, pn; };
struct Gemm { const bf16_t* A; const bf16_t* Bt; int M, N, K, ld; };

struct StaticOrder {
    int nM, nN, nwg, G, c;
    __host__ __device__ void init(int M, int N, int G_, int c_) { nM = M / BM; nN = N / BM; nwg = nM * nN; G = G_; c = c_; }
    __host__ __device__ bool next(int i, Unit& u) const {
        const long L = (long)i * G + c; if (L >= nwg) return false;
        int wgid = (int)L; { const int q = nwg / NXCD, r = nwg % NXCD, xcd = wgid % NXCD, off = wgid / NXCD; wgid = (xcd < r ? xcd * (q + 1) : r * (q + 1) + (xcd - r) * q) + off; }
        const int nig = WGM * nN, gid = wgid / nig, fm = gid * WGM, gsz = (nM - fm) < WGM ? (nM - fm) : WGM;
        u.pm = fm + ((wgid % nig) % gsz); u.pn = (wgid % nig) / gsz; return true;
    }
    __device__ __forceinline__ void a_ready(const Unit&) const {}
    __device__ __forceinline__ void done(const Unit&) const {}
};

__device__ __forceinline__ unsigned cvt_pk_bf16(float lo, float hi) { unsigned r; asm volatile("v_cvt_pk_bf16_f32 %0, %1, %2" : "=v"(r) : "v"(lo), "v"(hi)); return r; }
template <class Epi, class Sched, bool ALIGN_EPI = false, bool SP2 = false>
__device__ __forceinline__ void gemm_phase(PG8_LAS unsigned char* lds, const Gemm g, const Sched& S, const Epi& E) {
    int tid_ = threadIdx.x; asm volatile("" : "+v"(tid_));
    const int tid = tid_, wid = __builtin_amdgcn_readfirstlane(tid >> 6), lane = tid & 63, wr = wid >> 2, wc = wid & 3, fr = lane & 15, fq = lane >> 4;
    const int K = g.K, nt = K / BK;
    unsigned voffA[2], voffB[2];
#pragma unroll
    for (int i = 0; i < 2; ++i) { int R, C; stage_rc(tid * 16 + i * 8192, R, C); const int Rb = Epi::PERM ? ((R & ~31) + perm32(R & 31)) : R;
        voffA[i] = (unsigned)(R * g.ld + C) * 2u; voffB[i] = (unsigned)(Rb * g.ld + C) * 2u; }
    const size_t kstep = (size_t)(BK * 2);
    const size_t hstep = (size_t)HALF * g.ld * 2;
    const size_t tstep = 2 * hstep;
    const unsigned ldsw = (unsigned)wid * 1024u;
    const int aoff = lds_byte(wr * 64 + fr, fq * 8), boff = lds_byte(wc * 32 + fr, fq * 8);
#define PG8_SA(b, h) (((b) * 2 + (h)) * HTB)
#define PG8_SB(b, h) ((4 + (b) * 2 + (h)) * HTB)
#define PG8_STAGE(bufoff, gbase, voff) do { _Pragma("unroll") for (int _i = 0; _i < 2; ++_i) \
        __builtin_amdgcn_global_load_lds((const unsigned*)((const char*)(gbase) + (voff)[_i]), (PG8_LAS unsigned*)(lds + (bufoff) + ldsw + _i * 8192), 16, 0, 0); } while (0)
#define PG8_LDA(dst, b, h) do { _Pragma("unroll") for (int m = 0; m < 4; ++m) _Pragma("unroll") for (int k = 0; k < 2; ++k) dst[m][k] = *(const PG8_LAS bf16x8*)(lds + PG8_SA(b, h) + aoff + m * 2048 + k * 1024); } while (0)
#define PG8_LDB(dst, b, h) do { _Pragma("unroll") for (int n = 0; n < 2; ++n) _Pragma("unroll") for (int k = 0; k < 2; ++k) dst[n][k] = *(const PG8_LAS bf16x8*)(lds + PG8_SB(b, h) + boff + n * 2048 + k * 1024); } while (0)
#define PG8_MMA(ai, bj, At, Bt) do { __builtin_amdgcn_s_setprio(1); _Pragma("unroll") for (int m = 0; m < 4; ++m) _Pragma("unroll") for (int n = 0; n < 2; ++n) _Pragma("unroll") for (int k = 0; k < 2; ++k) \
        acc[ai][bj][m][n] = __builtin_amdgcn_mfma_f32_16x16x32_bf16(Bt[n][k], At[m][k], acc[ai][bj][m][n], 0, 0, 0); __builtin_amdgcn_s_setprio(0); } while (0)
#define PG8_WAIT_V(n) asm volatile("s_waitcnt vmcnt(" #n ")" ::: "memory")
#define PG8_WAIT_L(n) asm volatile("s_waitcnt lgkmcnt(" #n ")" ::: "memory")
#define PG8_BAR __builtin_amdgcn_s_barrier()
#define PG8_SCHED __builtin_amdgcn_sched_barrier(0)
    Unit cur, nxt; int ui = 0;
    if (!S.next(0, cur)) return;
    f32x4 acc[2][2][4][2];
#pragma unroll
    for (int a = 0; a < 2; ++a)
#pragma unroll
        for (int b = 0; b < 2; ++b)
#pragma unroll
            for (int m = 0; m < 4; ++m)
#pragma unroll
                for (int n = 0; n < 2; ++n) acc[a][b][m][n] = (f32x4){0.f, 0.f, 0.f, 0.f};
    bf16x8 At[4][2], B0[2][2], B1[2][2];
    const char* cA = (const char*)g.A + (size_t)cur.pm * tstep; const char* cB = (const char*)g.Bt + (size_t)cur.pn * tstep;
    S.a_ready(cur);
    if constexpr (SP2) {
        PG8_STAGE(PG8_SB(0, 0), cB, voffB); PG8_STAGE(PG8_SB(0, 1), cB + hstep, voffB); PG8_STAGE(PG8_SA(0, 0), cA, voffA); PG8_STAGE(PG8_SA(0, 1), cA + hstep, voffA);
        if (wr == 1) PG8_BAR;
        PG8_WAIT_V(2); PG8_BAR;
        PG8_STAGE(PG8_SB(1, 0), cB + kstep, voffB); PG8_STAGE(PG8_SA(1, 0), cA + kstep, voffA); PG8_STAGE(PG8_SB(1, 1), cB + hstep + kstep, voffB);
        PG8_WAIT_V(6); PG8_BAR;
    } else {
        PG8_STAGE(PG8_SB(0, 0), cB, voffB); PG8_STAGE(PG8_SA(0, 0), cA, voffA); PG8_STAGE(PG8_SB(0, 1), cB + hstep, voffB); PG8_STAGE(PG8_SA(0, 1), cA + hstep, voffA);
        if (wr == 1) PG8_BAR;
        PG8_WAIT_V(4); PG8_BAR;
        PG8_STAGE(PG8_SB(1, 0), cB + kstep, voffB); PG8_STAGE(PG8_SA(1, 0), cA + kstep, voffA); PG8_STAGE(PG8_SB(1, 1), cB + hstep + kstep, voffB);
        PG8_WAIT_V(6); PG8_BAR;
    }
    for (;;) {
        const bool has_next = S.next(ui + 1, nxt);
        const char* nA = has_next ? (const char*)g.A + (size_t)nxt.pm * tstep : cA; const char* nB = has_next ? (const char*)g.Bt + (size_t)nxt.pn * tstep : cB;
        for (int t = 0; t < nt; t += 2) {
            const bool last = (t == nt - 2);
            const char* a1 = cA + (size_t)(t + 1) * kstep;
            const char* a2 = last ? nA : cA + (size_t)(t + 2) * kstep; const char* b2 = last ? nB : cB + (size_t)(t + 2) * kstep;
            const char* a3 = a2 + kstep; const char* b3 = b2 + kstep;
            if (last && has_next) S.a_ready(nxt);
            if constexpr (SP2) {
            PG8_LDB(B0, 0, 0); PG8_LDB(B1, 0, 1); PG8_SCHED; PG8_LDA(At, 0, 0); PG8_STAGE(PG8_SA(1, 1), a1 + hstep, voffA);
            PG8_WAIT_V(8); PG8_WAIT_L(0); PG8_BAR; PG8_MMA(0, 0, At, B0); PG8_MMA(0, 1, At, B1); PG8_BAR; PG8_SCHED;
            PG8_LDA(At, 0, 1); PG8_STAGE(PG8_SB(0, 0), b2, voffB); PG8_STAGE(PG8_SB(0, 1), b2 + hstep, voffB); PG8_STAGE(PG8_SA(0, 0), a2, voffA);
            PG8_WAIT_V(8); PG8_WAIT_L(0); PG8_BAR; PG8_MMA(1, 0, At, B0); PG8_MMA(1, 1, At, B1); PG8_BAR; PG8_SCHED;
            PG8_LDB(B0, 1, 0); PG8_LDB(B1, 1, 1); PG8_SCHED; PG8_LDA(At, 1, 0); PG8_STAGE(PG8_SA(0, 1), a2 + hstep, voffA);
            PG8_WAIT_V(8); PG8_WAIT_L(0); PG8_BAR; PG8_MMA(0, 0, At, B0); PG8_MMA(0, 1, At, B1); PG8_BAR; PG8_SCHED;
            PG8_LDA(At, 1, 1); PG8_STAGE(PG8_SB(1, 0), b3, voffB); PG8_STAGE(PG8_SB(1, 1), b3 + hstep, voffB); PG8_STAGE(PG8_SA(1, 0), a3, voffA);
            PG8_WAIT_V(8); PG8_WAIT_L(0); PG8_BAR; PG8_MMA(1, 0, At, B0); PG8_MMA(1, 1, At, B1); PG8_BAR; PG8_SCHED;
            } else {
            PG8_LDB(B0, 0, 0); PG8_SCHED; PG8_LDA(At, 0, 0); PG8_STAGE(PG8_SA(1, 1), a1 + hstep, voffA);
            PG8_WAIT_L(8); PG8_BAR; PG8_WAIT_L(0); PG8_MMA(0, 0, At, B0); PG8_BAR; PG8_SCHED;
            PG8_LDB(B1, 0, 1); PG8_STAGE(PG8_SB(0, 0), b2, voffB);
            PG8_BAR; PG8_WAIT_L(0); PG8_MMA(0, 1, At, B1); PG8_BAR;
            PG8_LDA(At, 0, 1); PG8_STAGE(PG8_SA(0, 0), a2, voffA);
            PG8_BAR; PG8_WAIT_L(0); PG8_MMA(1, 0, At, B0); PG8_BAR; PG8_SCHED;
            PG8_STAGE(PG8_SB(0, 1), b2 + hstep, voffB);
            PG8_WAIT_V(6); PG8_BAR; PG8_MMA(1, 1, At, B1); PG8_BAR;
            PG8_LDB(B0, 1, 0); PG8_SCHED; PG8_LDA(At, 1, 0); PG8_STAGE(PG8_SA(0, 1), a2 + hstep, voffA);
            PG8_WAIT_L(8); PG8_BAR; PG8_WAIT_L(0); PG8_MMA(0, 0, At, B0); PG8_BAR; PG8_SCHED;
            PG8_LDB(B1, 1, 1); PG8_STAGE(PG8_SB(1, 0), b3, voffB);
            PG8_BAR; PG8_WAIT_L(0); PG8_MMA(0, 1, At, B1); PG8_BAR;
            PG8_LDA(At, 1, 1); PG8_STAGE(PG8_SA(1, 0), a3, voffA);
            PG8_BAR; PG8_WAIT_L(0); PG8_MMA(1, 0, At, B0); PG8_BAR; PG8_SCHED;
            PG8_STAGE(PG8_SB(1, 1), b3 + hstep, voffB);
            PG8_WAIT_V(6); PG8_BAR; PG8_MMA(1, 1, At, B1); PG8_BAR;
            }
        }
        if constexpr (ALIGN_EPI) { if (wr == 0) PG8_BAR; }
        if constexpr (!Epi::AFTER_DRAIN) { E(acc, cur, wr, wc, fr, fq); S.done(cur); }
        if (!has_next) break;
#pragma unroll
        for (int a = 0; a < 2; ++a)
#pragma unroll
            for (int b = 0; b < 2; ++b)
#pragma unroll
                for (int m = 0; m < 4; ++m)
#pragma unroll
                    for (int n = 0; n < 2; ++n) acc[a][b][m][n] = (f32x4){0.f, 0.f, 0.f, 0.f};
        cur = nxt; cA = nA; cB = nB; ++ui;
        if constexpr (ALIGN_EPI) { if (wr == 1) PG8_BAR; }
    }
    PG8_WAIT_V(0);
    if constexpr (!ALIGN_EPI) { if (wr == 0) PG8_BAR; }
    PG8_BAR;
    if constexpr (Epi::AFTER_DRAIN) { E.fused(acc, cur, wr, wc, fr, fq, lds, wid, lane); S.done(cur); }
#undef PG8_SA
#undef PG8_SB
#undef PG8_STAGE
#undef PG8_LDA
#undef PG8_LDB
#undef PG8_MMA
#undef PG8_WAIT_V
#undef PG8_WAIT_L
#undef PG8_BAR
#undef PG8_SCHED
}
}
typedef unsigned short u16;
using pg8::f32x4; using pg8::u32x4; using pg8::bf16x8;
typedef float f32x16 __attribute__((ext_vector_type(16)));

constexpr int TP = 32768, TS = 256, T = TP + TS, D = 1024, FF = 2816, SEQ = 16384, PAST = 2048;
constexpr float ALPHA = 1.189207115002721f, LN_EPS = 1e-5f, LOG2E = 1.4426950408889634f, C2 = 0.125f * LOG2E;
constexpr int NTHR = 512, LDS_BYTES = 148480, MISC_OFF = 147712;
#ifndef PROBE
#define PROBE 0
#endif
#ifndef GEMM_SP2
#define GEMM_SP2 true
#endif
#ifndef GEMM_ALIGN
#define GEMM_ALIGN true
#endif
#ifndef PROBE_MASK
#define PROBE_MASK 0
#endif
#ifndef GU_SPLIT
#define GU_SPLIT 0
#endif
#ifndef PRUNE
#define PRUNE 1
#endif
constexpr float PRUNE_TH = 32.f;

constexpr size_t O_YP = 0, O_YS = 33554432, O_KP = 33816576, O_VP = 50593792, O_LFP = 67371008, O_CP = 67633152, O_NP = 67764224, O_MP = 67765248,
                 O_CONVP = 67765256, O_KS = 67771400, O_VS = 67902472, O_LFS = 68033544, O_CS = 68035592, O_NS = 69084168, O_MS = 69092360, O_CONVS = 69092424;
constexpr size_t MiB = 1u << 20;
constexpr size_t WS_CTL = 0, WS_ST = 65536  , WS_MOD = 1 * MiB, WS_BIN = 2 * MiB;
constexpr size_t WS_F2 = 3 * MiB;
constexpr size_t WS_MI = 4 * MiB;
constexpr size_t WS_MLF = 5 * MiB;
constexpr size_t WS_MB = 6 * MiB;
constexpr size_t WS_MM = 7 * MiB;
constexpr size_t WS_UN = 8 * MiB;
constexpr size_t WS_MST = 9 * MiB;
constexpr size_t WS_WGU1 = 10 * MiB, WS_WD1 = 21 * MiB, WS_WIN = 27 * MiB, WS_WBA = 39 * MiB, WS_WBB = 40 * MiB, WS_WOUT = 41 * MiB, WS_WGU2 = 43 * MiB, WS_WD2 = 54 * MiB;
constexpr size_t WS_X = 60 * MiB  , WS_XS = 124 * MiB  , WS_H = 189 * MiB, WS_ACT = 254 * MiB;
constexpr size_t QSZ = (size_t)T * 512 * 2;
constexpr size_t WS_AQ = WS_ACT, WS_AK = WS_AQ + QSZ, WS_AV = WS_AK + QSZ, WS_PRE = WS_AV + QSZ;
constexpr size_t WS_GA = WS_PRE, WS_GB = WS_AK;
constexpr size_t O_Z = 16777216;
constexpr size_t WS_MV = 432 * MiB, WS_SIGO = WS_MV + QSZ, WS_END = WS_SIGO + QSZ;
constexpr size_t WS_PB = WS_END;
static_assert(WS_PRE + 2 * QSZ <= WS_ACT + (size_t)T * FF * 2 + 16 * MiB && WS_ACT + (size_t)T * FF * 2 <= WS_MV && WS_END <= 512 * MiB, "ws map");

struct Params { const float* in[27]; float* out; unsigned char* ws; };

__device__ __forceinline__ float bf2f(u16 b) { return __uint_as_float(((unsigned)b) << 16); }
typedef float f32x2_t __attribute__((ext_vector_type(2))); typedef __bf16 bf16x2_t __attribute__((ext_vector_type(2)));
__device__ __forceinline__ unsigned pk2(float lo, float hi) { f32x2_t v = {lo, hi}; bf16x2_t b = __builtin_convertvector(v, bf16x2_t); return __builtin_bit_cast(unsigned, b); }
__device__ __forceinline__ u16 f2bf(float f) { return (u16)(pk2(f, 0.f) & 0xffffu); }
__device__ __forceinline__ float sigm(float x) { return __builtin_amdgcn_rcpf(1.f + __expf(-x)); }
__device__ __forceinline__ float siluf(float x) { return x * __builtin_amdgcn_rcpf(1.f + __expf(-x)); }
__device__ __forceinline__ float logsig(float x) { return fminf(x, 0.f) - log1pf(__expf(-fabsf(x))); }
__device__ __forceinline__ int modrow(int t) { return t < TP ? (t >> 14) : 2 + ((t - TP) >> 4); }
__device__ __forceinline__ float wsum(float v) { for (int m = 32; m >= 1; m >>= 1) v += __shfl_xor(v, m); return v; }
__device__ __forceinline__ float wmax(float v) { for (int m = 32; m >= 1; m >>= 1) v = fmaxf(v, __shfl_xor(v, m)); return v; }
__device__ __forceinline__ int crow(int r, int hi) { return (r & 3) + 8 * (r >> 2) + 4 * hi; }

#define LAS __attribute__((address_space(3)))
#define XB_TMO      128
#define XB_XCNT(j)  (256  + 64 * (j))
#define XB_XSUB(j)  (1280 + 64 * (j))
#define XB_XGEN(j)  (2304 + 64 * (j))
#define XB_TOP      3328
#define XB_TOPGEN   3392
#define XCD_BAR_WORDS 3456
#define XB_SPIN_CAP (1u << 18)
__device__ __forceinline__ unsigned xb_ld(unsigned* p)              { return __hip_atomic_load(p, __ATOMIC_RELAXED, __HIP_MEMORY_SCOPE_AGENT); }
__device__ __forceinline__ unsigned xb_add(unsigned* p, unsigned v) { return __hip_atomic_fetch_add(p, v, __ATOMIC_RELAXED, __HIP_MEMORY_SCOPE_AGENT); }
__device__ __forceinline__ unsigned xb_xcc_id() { return (unsigned)__builtin_amdgcn_s_getreg((3 << 11) | 20) & 0xFu; }
#define XB_SPIN(cond, bar) do { unsigned _sp = 0; while (cond) { __builtin_amdgcn_s_sleep(1); \
    if ((++_sp & 255u) == 0u) { if (xb_ld(&(bar)[XB_TMO])) break; if (_sp > XB_SPIN_CAP) { atomicAdd(&(bar)[XB_TMO], 1u); break; } } } } while (0)
struct XcdBarrier { unsigned* bar; unsigned x; volatile LAS unsigned* st; };
__device__ __forceinline__ XcdBarrier xcd_barrier_post(unsigned* bar, volatile LAS unsigned* st) {
    XcdBarrier b; b.bar = bar; b.x = xb_xcc_id(); b.st = st;
    if (threadIdx.x == 0) (void)xb_add(&bar[XB_XCNT(b.x)], 1u);
    return b;
}
__device__ __forceinline__ void xcd_barrier_complete(unsigned* bar, unsigned x, unsigned& nloc, unsigned& nx) {
    const unsigned G = gridDim.x * gridDim.y * gridDim.z;
    unsigned sum, cnt, mine, sp = 0u;
    for (;;) {
        sum = 0u; cnt = 0u; mine = 0u;
#pragma unroll
        for (unsigned j = 0; j < 16; ++j) { const unsigned c = xb_ld(&bar[XB_XCNT(j)]); sum += c; cnt += (c > 0u) ? 1u : 0u; mine = (j == x) ? c : mine; }
        if (sum == G) break;
        __builtin_amdgcn_s_sleep(1);
        if ((++sp & 255u) == 0u) { if (xb_ld(&bar[XB_TMO])) break; if (sp > XB_SPIN_CAP) { atomicAdd(&bar[XB_TMO], 1u); break; } }
    }
    nloc = mine > 0u ? mine : 1u; nx = cnt > 0u ? cnt : 1u;
}
__device__ __forceinline__ void xcd_barrier(const XcdBarrier& b) {
    asm volatile("s_waitcnt vmcnt(0)" ::: "memory");
    __syncthreads();
    if (threadIdx.x == 0) {
        unsigned* bar = b.bar;
        __builtin_amdgcn_s_waitcnt(0);
        unsigned nloc = b.st[0], nx = b.st[1];
        if (nloc == 0u) { xcd_barrier_complete(bar, b.x, nloc, nx); b.st[0] = nloc; b.st[1] = nx; }
        const unsigned old = xb_add(&bar[XB_XSUB(b.x)], 1u);
        const unsigned gen = old / nloc;
        if (old + 1u == (gen + 1u) * nloc) {
            __builtin_amdgcn_fence(__ATOMIC_RELEASE, "agent");
            asm volatile("s_waitcnt vmcnt(0)" ::: "memory");
            const unsigned og = xb_add(&bar[XB_TOP], 1u);
            const unsigned tg = og / nx;
            if (og + 1u == (tg + 1u) * nx) xb_add(&bar[XB_TOPGEN], 1u);
            else XB_SPIN(xb_ld(&bar[XB_TOPGEN]) == tg, bar);
            __builtin_amdgcn_fence(__ATOMIC_ACQUIRE, "agent");
            xb_add(&bar[XB_XGEN(b.x)], 1u);
            asm volatile("s_waitcnt vmcnt(0)" ::: "memory");
        } else {
            XB_SPIN(xb_ld(&bar[XB_XGEN(b.x)]) == gen, bar);
            __builtin_amdgcn_fence(__ATOMIC_ACQUIRE, "agent");
            asm volatile("s_waitcnt vmcnt(0)" ::: "memory");
        }
    }
    __syncthreads();
}

struct EpiGU { static constexpr bool PERM = true, AFTER_DRAIN = false; u16* ACT;
  __device__ __forceinline__ void operator()(const f32x4 (&acc)[2][2][4][2], const pg8::Unit& u, int wr, int wc, int fr, int fq) const {
    const int row0 = u.pm * 256 + wr * 64 + fr, col0 = u.pn * 128 + wc * 32 + 8 * fq;
#pragma unroll
    for (int ai = 0; ai < 2; ++ai)
#pragma unroll
      for (int m = 0; m < 4; ++m) { const size_t row = row0 + ai * 128 + m * 16;
        const f32x4 g0 = acc[ai][0][m][0], g1 = acc[ai][0][m][1], u0 = acc[ai][1][m][0], u1 = acc[ai][1][m][1];
        u32x4 o; o[0] = pk2(siluf(g0[0]) * u0[0], siluf(g0[1]) * u0[1]); o[1] = pk2(siluf(g0[2]) * u0[2], siluf(g0[3]) * u0[3]);
        o[2] = pk2(siluf(g1[0]) * u1[0], siluf(g1[1]) * u1[1]); o[3] = pk2(siluf(g1[2]) * u1[2], siluf(g1[3]) * u1[3]);
        *(u32x4*)(ACT + row * FF + col0) = o; }
  } };

template <bool LNX> struct EpiRes { static constexpr bool PERM = false, AFTER_DRAIN = false; const float* xp; u16* XB; const float* gate; const float* st; const float* lg; const float* lb; float gs; float pad_;
  __device__ __forceinline__ void operator()(const f32x4 (&acc)[2][2][4][2], const pg8::Unit& u, int wr, int wc, int fr, int fq) const {
    int fr2 = fr, fq2 = fq; asm volatile("" : "+v"(fr2), "+v"(fq2));
    const int row0 = u.pm * 256 + wr * 64 + fr2, col0 = u.pn * 256 + wc * 32 + 4 * fq2;
    const float* gr = gate + (u.pm >> 6) * 9216;
    f32x4 gv[2][2], g4[2][2], b4[2][2];
#pragma unroll
    for (int bj = 0; bj < 2; ++bj)
#pragma unroll
      for (int n = 0; n < 2; ++n) { const int c = col0 + bj * 128 + n * 16; gv[bj][n] = *(const f32x4*)(gr + c) * gs; if (LNX) { g4[bj][n] = *(const f32x4*)(lg + c); b4[bj][n] = *(const f32x4*)(lb + c); } }
#pragma unroll
    for (int ai = 0; ai < 2; ++ai)
#pragma unroll
      for (int m = 0; m < 4; ++m) { const int row = row0 + ai * 128 + m * 16; u16* o = XB + (size_t)row * D;
        float mu = 0.f, rs = 1.f; if (LNX) { mu = st[2 * (size_t)row]; rs = st[2 * (size_t)row + 1]; }
#pragma unroll
        for (int bj = 0; bj < 2; ++bj)
#pragma unroll
          for (int n = 0; n < 2; ++n) { const int c = col0 + bj * 128 + n * 16; f32x4 xv;
            if (LNX) { const uint2 r = *(const uint2*)(o + c); xv = (f32x4){__uint_as_float(r.x << 16), __uint_as_float(r.x & 0xffff0000u), __uint_as_float(r.y << 16), __uint_as_float(r.y & 0xffff0000u)};
              xv = (xv - mu) * rs * g4[bj][n] + b4[bj][n]; }
            else xv = *(const f32x4*)(xp + (size_t)row * D + c);
            const f32x4 ov = xv * ALPHA + gv[bj][n] * acc[ai][bj][m][n]; uint2 w; w.x = pk2(ov[0], ov[1]); w.y = pk2(ov[2], ov[3]); *(uint2*)(o + c) = w; } }
  } };

struct EpiIn { static constexpr bool PERM = true, AFTER_DRAIN = false; u16 *AQ, *AK, *AV, *PRE, *MV, *SIGO; float *MI, *MLF; const float* bias; float* out;
  __device__ __forceinline__ void operator()(const f32x4 (&acc)[2][2][4][2], const pg8::Unit& u, int wr, int wc, int fr, int fq) const {
    const int row0 = u.pm * 256 + wr * 64 + fr, pn = u.pn;
    f32x4 bz[2][2];
#pragma unroll
    for (int bj = 0; bj < 2; ++bj) { const int pc0 = 256 * pn + 128 * bj + 32 * wc + 8 * fq; bz[bj][0] = *(const f32x4*)(bias + pc0); bz[bj][1] = *(const f32x4*)(bias + pc0 + 4); }
#pragma unroll
    for (int ai = 0; ai < 2; ++ai)
#pragma unroll
      for (int m = 0; m < 4; ++m) { const int row = row0 + ai * 128 + m * 16;
#pragma unroll
        for (int bj = 0; bj < 2; ++bj) { const int cl = 128 * bj + 32 * wc + 8 * fq, pc = 256 * pn + cl;
          f32x4 v0 = acc[ai][bj][m][0] + bz[bj][0], v1 = acc[ai][bj][m][1] + bz[bj][1];
          if (pn < 2) { u32x4 o = {pk2(v0[0] * C2, v0[1] * C2), pk2(v0[2] * C2, v0[3] * C2), pk2(v1[0] * C2, v1[1] * C2), pk2(v1[2] * C2, v1[3] * C2)};
            *(u32x4*)(AQ + (size_t)row * 512 + pc) = o; }
          else if (pn < 6) { const int col = (pn < 4) ? pc - 512 : pc - 1024; u16* B = (pn < 4) ? AK : AV;
            u32x4 o = {pk2(v0[0], v0[1]), pk2(v0[2], v0[3]), pk2(v1[0], v1[1]), pk2(v1[2], v1[3])}; *(u32x4*)(B + (size_t)row * 512 + col) = o;
            float* op = (row < TP) ? out + ((pn < 4) ? O_KP : O_VP) + (size_t)row * 512 + col : out + ((pn < 4) ? O_KS : O_VS) + (size_t)(row - TP) * 512 + col;
            *(f32x4*)op = v0; *(f32x4*)(op + 4) = v1; }
          else if (pn < 10) { const int col = pc - 1536;
            u32x4 o = {pk2(v0[0], v0[1]), pk2(v0[2], v0[3]), pk2(v1[0], v1[1]), pk2(v1[2], v1[3])}; *(u32x4*)(PRE + (size_t)row * 1024 + col) = o;
            if (row < TP) { const int s = row & (SEQ - 1); if (s >= SEQ - 3) { float* op = out + O_CONVP + ((size_t)(row >> 14) * 3 + (s - (SEQ - 3))) * 1024 + col; *(f32x4*)op = v0; *(f32x4*)(op + 4) = v1; } }
            else { const int l = (row - TP) & 15; if (l >= 13) { float* op = out + O_CONVS + ((size_t)((row - TP) >> 4) * 3 + (l - 13)) * 1024 + col; *(f32x4*)op = v0; *(f32x4*)(op + 4) = v1; } } }
          else if (pn < 12) { u32x4 o = {pk2(v0[0], v0[1]), pk2(v0[2], v0[3]), pk2(v1[0], v1[1]), pk2(v1[2], v1[3])}; *(u32x4*)(MV + (size_t)row * 512 + (pc - 2560)) = o; }
          else if (pn < 14) { u32x4 o = {pk2(sigm(v0[0]), sigm(v0[1])), pk2(sigm(v0[2]), sigm(v0[3])), pk2(sigm(v1[0]), sigm(v1[1])), pk2(sigm(v1[2]), sigm(v1[3]))};
            *(u32x4*)(SIGO + (size_t)row * 512 + (pc - 3072)) = o; }
          else { if (bj == 0 && wc == 0) {
              if (fq == 0) { float* op = (row < TP) ? out + O_LFP + (size_t)row * 8 : out + O_LFS + (size_t)(row - TP) * 8;
                f32x4 a = {logsig(v0[0]), logsig(v0[1]), logsig(v0[2]), logsig(v0[3])}, b = {logsig(v1[0]), logsig(v1[1]), logsig(v1[2]), logsig(v1[3])};
                *(f32x4*)op = a; *(f32x4*)(op + 4) = b; }
              else if (fq == 1) { *(f32x4*)(MI + (size_t)row * 4) = v0; f32x4 b = {logsig(v1[0]), logsig(v1[1]), logsig(v1[2]), logsig(v1[3])}; *(f32x4*)(MLF + (size_t)row * 4) = b; } } }
        } }
  } };

template <int MODE> struct EpiMerge { static constexpr bool PERM = true, AFTER_DRAIN = false; u16* O; const u16* Aa; const float* bias;
  __device__ __forceinline__ void operator()(const f32x4 (&acc)[2][2][4][2], const pg8::Unit& u, int wr, int wc, int fr, int fq) const {
    const int row0 = u.pm * 256 + wr * 64 + fr, col0 = u.pn * 256 + wc * 32 + 8 * fq;
    f32x4 bz[2][2];
    if (MODE == 0) {
#pragma unroll
      for (int bj = 0; bj < 2; ++bj) { bz[bj][0] = *(const f32x4*)(bias + col0 + bj * 128); bz[bj][1] = *(const f32x4*)(bias + col0 + bj * 128 + 4); } }
#pragma unroll
    for (int ai = 0; ai < 2; ++ai)
#pragma unroll
      for (int m = 0; m < 4; ++m) { const size_t row = row0 + ai * 128 + m * 16;
#pragma unroll
        for (int bj = 0; bj < 2; ++bj) { const int c = col0 + bj * 128; u16* op = O + row * D + c; float r[8];
          const f32x4 a0 = acc[ai][bj][m][0], a1 = acc[ai][bj][m][1];
          if (MODE == 0) { const f32x4 b0 = bz[bj][0], b1 = bz[bj][1];
#pragma unroll
            for (int j = 0; j < 4; ++j) { r[j] = sigm(a0[j] + b0[j]); r[4 + j] = sigm(a1[j] + b1[j]); } }
          else { const u32x4 ov = *(const u32x4*)op; float o[8];
#pragma unroll
            for (int j = 0; j < 4; ++j) { o[2 * j] = __uint_as_float(ov[j] << 16); o[2 * j + 1] = __uint_as_float(ov[j] & 0xffff0000u); }
            if (MODE == 1) {
#pragma unroll
              for (int j = 0; j < 4; ++j) { r[j] = o[j] * a0[j]; r[4 + j] = o[4 + j] * a1[j]; } }
            else { const u32x4 av = *(const u32x4*)(Aa + row * D + c); const float accv[8] = {a0[0], a0[1], a0[2], a0[3], a1[0], a1[1], a1[2], a1[3]};
#pragma unroll
              for (int j = 0; j < 4; ++j) { const float x0 = __uint_as_float(av[j] << 16), x1 = __uint_as_float(av[j] & 0xffff0000u);
                r[2 * j] = x0 + o[2 * j] * accv[2 * j]; r[2 * j + 1] = x1 + o[2 * j + 1] * accv[2 * j + 1]; } } }
          u32x4 w = {pk2(r[0], r[1]), pk2(r[2], r[3]), pk2(r[4], r[5]), pk2(r[6], r[7])}; *(u32x4*)op = w; } }
  } };

struct EpiResSlice { static constexpr bool PERM = false, AFTER_DRAIN = false; float* B; int ldb; const float* gate; float gs;
  __device__ __forceinline__ void operator()(const f32x4 (&acc)[2][2][4][2], const pg8::Unit& u, int wr, int wc, int fr, int fq) const {
    int fr2 = fr, fq2 = fq; asm volatile("" : "+v"(fr2), "+v"(fq2));
    const int row0 = wr * 64 + fr2, col0 = u.pn * 256 + wc * 32 + 4 * fq2;
#pragma unroll
    for (int ai = 0; ai < 2; ++ai)
#pragma unroll
      for (int m = 0; m < 4; ++m) { const int lr = row0 + ai * 128 + m * 16; const float* gr = gate + (2 + (lr >> 4)) * 9216; float* o = B + (size_t)lr * ldb;
#pragma unroll
        for (int bj = 0; bj < 2; ++bj)
#pragma unroll
          for (int n = 0; n < 2; ++n) { const int c = col0 + bj * 128 + n * 16; const f32x4 gv = *(const f32x4*)(gr + c); *(f32x4*)(o + c) = gv * acc[ai][bj][m][n] * gs; } }
  } };
struct EpiSlice { static constexpr bool PERM = false, AFTER_DRAIN = false; float* B; int ldb;
  __device__ __forceinline__ void operator()(const f32x4 (&acc)[2][2][4][2], const pg8::Unit& u, int wr, int wc, int fr, int fq) const {
    int fr2 = fr, fq2 = fq; asm volatile("" : "+v"(fr2), "+v"(fq2));
    const int row0 = wr * 64 + fr2, col0 = u.pn * 256 + wc * 32 + 4 * fq2;
#pragma unroll
    for (int ai = 0; ai < 2; ++ai)
#pragma unroll
      for (int m = 0; m < 4; ++m) { float* o = B + (size_t)(row0 + ai * 128 + m * 16) * ldb;
#pragma unroll
        for (int bj = 0; bj < 2; ++bj)
#pragma unroll
          for (int n = 0; n < 2; ++n) *(f32x4*)(o + col0 + bj * 128 + n * 16) = acc[ai][bj][m][n]; }
  } };
struct SplitOrder { int c, n, npn;
  __device__ __forceinline__ bool next(int i, pg8::Unit& u) const { if (i != 0 || c >= n) return false; u.pm = 0; u.pn = c % npn; return true; }
  __device__ __forceinline__ void a_ready(const pg8::Unit&) const {}
  __device__ __forceinline__ void done(const pg8::Unit&) const {} };

template <class Epi> __device__ __forceinline__ void run_gemm(unsigned char* lds, const u16* A, const u16* Bt, int M, int N, int K, const Epi& E) {
  pg8::Gemm g; g.A = A; g.Bt = Bt; g.M = M; g.N = N; g.K = K; g.ld = K;
  pg8::StaticOrder S; S.init(M, N, (int)gridDim.x, (int)blockIdx.x);
  pg8::gemm_phase<Epi, pg8::StaticOrder, GEMM_ALIGN, GEMM_SP2>((PG8_LAS unsigned char*)lds, g, S, E);
  __syncthreads();
}
template <class Epi> __device__ __forceinline__ void run_gemm_split(unsigned char* lds, const u16* A, const u16* Bt, int K, const Epi& E, int blk0 = 0, int N = 1024) {
  const int npn = N / 256; const int cc = (int)blockIdx.x - blk0; const int c = cc < 0 ? 1 << 20 : cc, ks = c / npn;
  pg8::Gemm g; g.A = A + (size_t)TP * K + ks * 256; g.Bt = Bt + ks * 256; g.M = 256; g.N = N; g.K = 256; g.ld = K;
  SplitOrder S; S.c = c; S.n = npn * (K / 256); S.npn = npn;
  Epi E2 = E; E2.B = E.B + (size_t)(c < S.n ? ks : 0) * 256 * E.ldb;
  pg8::gemm_phase<Epi, SplitOrder, GEMM_ALIGN, GEMM_SP2>((PG8_LAS unsigned char*)lds, g, S, E2);
  __syncthreads();
}
__device__ __forceinline__ void gu_finish(const float* Z, u16* ACT, int ks, int tid) {
  const int r = tid >> 1, half = tid & 1; const float* zr = Z + (size_t)r * (2 * FF) + 512 * ks + 256 * half; u16* ar = ACT + (size_t)(TP + r) * FF + 256 * ks + 128 * half;
  constexpr size_t SL = (size_t)256 * 2 * FF;
#pragma unroll 2
  for (int i = 0; i < 16; ++i) { f32x4 g0 = *(const f32x4*)(zr + 8 * i), g1 = *(const f32x4*)(zr + 8 * i + 4), u0 = *(const f32x4*)(zr + 128 + 8 * i), u1 = *(const f32x4*)(zr + 128 + 8 * i + 4);
#pragma unroll
    for (int sl = 1; sl < 4; ++sl) { g0 += *(const f32x4*)(zr + sl * SL + 8 * i); g1 += *(const f32x4*)(zr + sl * SL + 8 * i + 4); u0 += *(const f32x4*)(zr + sl * SL + 128 + 8 * i); u1 += *(const f32x4*)(zr + sl * SL + 128 + 8 * i + 4); }
    u32x4 o = {pk2(siluf(g0[0]) * u0[0], siluf(g0[1]) * u0[1]), pk2(siluf(g0[2]) * u0[2], siluf(g0[3]) * u0[3]), pk2(siluf(g1[0]) * u1[0], siluf(g1[1]) * u1[1]), pk2(siluf(g1[2]) * u1[2], siluf(g1[3]) * u1[3])};
    *(u32x4*)(ar + 8 * i) = o; }
  __builtin_amdgcn_fence(__ATOMIC_RELEASE, "agent"); asm volatile("s_waitcnt vmcnt(0)" ::: "memory");
  __syncthreads();
  __builtin_amdgcn_fence(__ATOMIC_ACQUIRE, "agent"); asm volatile("s_waitcnt vmcnt(0)" ::: "memory");
  __syncthreads();
}

__device__ __forceinline__ int gu_map(int p) { const int t = p >> 8, r = p & 255; return r < 128 ? t * 128 + r : FF + t * 128 + (r - 128); }
__device__ __forceinline__ int in_map(int p) {
  if (p < 1536) return p; if (p < 2560) return 1544 + (p - 1536); if (p < 3072) return 2568 + (p - 2560); if (p < 3584) return 3088 + (p - 3072);
  if (p < 3592) return 1536 + (p - 3584); if (p < 3596) return 3080 + (p - 3592); if (p < 3600) return 3084 + (p - 3596); if (p < 3840) return -1;
  if (p < 4864) return 3600 + (p - 3840); return 4624 + (p - 4864); }

__device__ __forceinline__ void adaln_unit(const Params& p, float* mod, int unit, unsigned char* lds, int tid) {
  float* sc = (float*)lds; float* red = (float*)(lds + 73728);
  for (int i = tid; i < 18 * 1024; i += NTHR) { const int r = i >> 10, k = i & 1023; const float c = r < 2 ? p.in[9][r * 1024 + k] : p.in[10][(r - 2) * 1024 + k]; sc[i] = siluf(c); }
  __syncthreads();
  const int col = tid & 63, kg = tid >> 6; const float* W = p.in[11] + unit * 64 + col;
  float acc[18];
#pragma unroll
  for (int r = 0; r < 18; ++r) acc[r] = 0.f;
  for (int k0 = kg * 128; k0 < kg * 128 + 128; k0 += 16) { float w[16];
#pragma unroll
    for (int i = 0; i < 16; ++i) w[i] = W[(size_t)(k0 + i) * 9216];
#pragma unroll
    for (int i = 0; i < 16; ++i)
#pragma unroll
      for (int r = 0; r < 18; ++r) acc[r] += sc[r * 1024 + k0 + i] * w[i]; }
#pragma unroll
  for (int r = 0; r < 18; ++r) red[(kg * 18 + r) * 64 + col] = acc[r];
  __syncthreads();
  for (int i = tid; i < 18 * 64; i += NTHR) { const int r = i >> 6, c = i & 63; float s = 0.f; for (int g = 0; g < 8; ++g) s += red[(g * 18 + r) * 64 + c]; mod[r * 9216 + unit * 64 + c] = s + p.in[12][unit * 64 + c]; }
  __syncthreads();
}
template <int MAP> __device__ __forceinline__ void transpose_tile(const float* src, int ld, int K, u16* dst, int p0, int k0, unsigned char* lds, int tid) {
  u16* tl = (u16*)lds;
  { const int pp = tid & 63, kk = tid >> 6; const int sc = MAP == 0 ? p0 + pp : (MAP == 1 ? gu_map(p0 + pp) : in_map(p0 + pp));
#pragma unroll
    for (int i = 0; i < 8; ++i) { const int k = kk + 8 * i; const float v = sc >= 0 ? src[(size_t)(k0 + k) * ld + sc] : 0.f; tl[pp * 66 + k] = f2bf(v); } }
  __syncthreads();
  { const int row = tid >> 3, ch = tid & 7; const unsigned* s = (const unsigned*)(tl + row * 66 + ch * 8); u32x4 v = {s[0], s[1], s[2], s[3]};
    *(u32x4*)(dst + (size_t)(p0 + row) * K + k0 + ch * 8) = v; }
  __syncthreads();
}
__device__ __forceinline__ void prep_phase(const Params& p, unsigned char* lds, int tid_in) { int tid = tid_in;
  unsigned char* ws = p.ws;
  if (blockIdx.x == 0) { int* ctl = (int*)(ws + WS_CTL); if (tid < 64) ctl[tid] = 0; for (int i = tid; i < XCD_BAR_WORDS; i += NTHR) ctl[4096 + i] = 0;
    float* bp = (float*)(ws + WS_BIN); for (int i = tid; i < 5888; i += NTHR) { const int s = in_map(i); bp[i] = s >= 0 ? p.in[16][s] : 0.f; } }
  constexpr int N0 = 88 * 16, N1 = 16 * 44, N2 = 92 * 16, N3 = 16 * 8, N4 = 16 * 8, N5 = 16 * 16, N6 = 88 * 16, N7 = 16 * 44;
  constexpr int total = 144 + N0 + N1 + N2 + N3 + N4 + N5 + N6 + N7;
  for (int w = blockIdx.x; w < total; w += gridDim.x) { asm volatile("" : "+v"(tid));
    if (w < 144) { adaln_unit(p, (float*)(ws + WS_MOD), w, lds, tid); continue; }
    int q = w - 144, j = 0;
    if (q >= N0) { q -= N0; j = 1; if (q >= N1) { q -= N1; j = 2; if (q >= N2) { q -= N2; j = 3; if (q >= N3) { q -= N3; j = 4; if (q >= N4) { q -= N4; j = 5; if (q >= N5) { q -= N5; j = 6; if (q >= N6) { q -= N6; j = 7; } } } } } } }
    switch (j) {
      case 0: transpose_tile<1>(p.in[13], 2 * FF, 1024, (u16*)(ws + WS_WGU1), (q >> 4) * 64, (q & 15) * 64, lds, tid); break;
      case 1: transpose_tile<0>(p.in[14], D, FF, (u16*)(ws + WS_WD1), (q / 44) * 64, (q % 44) * 64, lds, tid); break;
      case 2: transpose_tile<2>(p.in[15], 5648, 1024, (u16*)(ws + WS_WIN), (q >> 4) * 64, (q & 15) * 64, lds, tid); break;
      case 3: transpose_tile<0>(p.in[20], D, 512, (u16*)(ws + WS_WBA), (q >> 3) * 64, (q & 7) * 64, lds, tid); break;
      case 4: transpose_tile<0>(p.in[21], D, 512, (u16*)(ws + WS_WBB), (q >> 3) * 64, (q & 7) * 64, lds, tid); break;
      case 5: transpose_tile<0>(p.in[22], D, 1024, (u16*)(ws + WS_WOUT), (q >> 4) * 64, (q & 15) * 64, lds, tid); break;
      case 6: transpose_tile<1>(p.in[23], 2 * FF, 1024, (u16*)(ws + WS_WGU2), (q >> 4) * 64, (q & 15) * 64, lds, tid); break;
      default: transpose_tile<0>(p.in[24], D, FF, (u16*)(ws + WS_WD2), (q / 44) * 64, (q % 44) * 64, lds, tid); break;
    }
  }
}

template <int MODE, int NSLAB> __device__ __forceinline__ void row_one(const Params& p, int row, int lane, int lnidx, const f32x4 (&g)[4], const f32x4 (&b)[4], const f32x4 (&sh)[4], const f32x4 (&sc)[4]) {
  const u16* XB = (const u16*)(p.ws + WS_X); float* XS = (float*)(p.ws + WS_XS); u16* H = (u16*)(p.ws + WS_H);
  f32x4 v[4];
  if (MODE != 0 && row < TP) {
#pragma unroll
    for (int i = 0; i < 4; ++i) { const uint2 r = *(const uint2*)(XB + (size_t)row * D + lane * 4 + 256 * i);
      v[i] = (f32x4){__uint_as_float(r.x << 16), __uint_as_float(r.x & 0xffff0000u), __uint_as_float(r.y << 16), __uint_as_float(r.y & 0xffff0000u)}; } }
  else { const float* src = MODE == 0 ? (row < TP ? p.in[0] + (size_t)row * D : p.in[1] + (size_t)(row - TP) * D) : XS + (size_t)(row - TP) * D;
#pragma unroll
    for (int i = 0; i < 4; ++i) v[i] = *(const f32x4*)(src + lane * 4 + 256 * i); }
  if (MODE != 0 && row >= TP) { const float* pb = (const float*)(p.ws + WS_PB) + (size_t)(row - TP) * D + lane * 4;
    for (int sl = 0; sl < NSLAB; ++sl) {
#pragma unroll
      for (int i = 0; i < 4; ++i) v[i] += *(const f32x4*)(pb + (size_t)sl * 262144 + 256 * i); } }
  if (MODE != 0) {
    float s = 0.f;
#pragma unroll
    for (int i = 0; i < 4; ++i) s += v[i][0] + v[i][1] + v[i][2] + v[i][3];
    const float mu = wsum(s) * (1.f / D); float q = 0.f;
#pragma unroll
    for (int i = 0; i < 4; ++i) { v[i] = v[i] - mu; q += v[i][0] * v[i][0] + v[i][1] * v[i][1] + v[i][2] * v[i][2] + v[i][3] * v[i][3]; }
    const float rstd = rsqrtf(wsum(q) * (1.f / D) + LN_EPS);
    if (MODE == 1 && row < TP && lane == 0) { float2 sv; sv.x = mu; sv.y = rstd; *(float2*)((float*)(p.ws + WS_ST) + 2 * ((size_t)lnidx * TP + row)) = sv; }
#pragma unroll
    for (int i = 0; i < 4; ++i) v[i] = v[i] * rstd * g[i] + b[i];
  }
  if (MODE == 2) { float* dst = row < TP ? p.out + O_YP + (size_t)row * D : p.out + O_YS + (size_t)(row - TP) * D;
#pragma unroll
    for (int i = 0; i < 4; ++i) *(f32x4*)(dst + lane * 4 + 256 * i) = v[i]; }
  else {
#pragma unroll
    for (int i = 0; i < 4; ++i) { const int c = lane * 4 + 256 * i; if (row >= TP) *(f32x4*)(XS + (size_t)(row - TP) * D + c) = v[i] * ALPHA;
      const f32x4 h = v[i] * (sc[i] + 1.f) + sh[i];
      uint2 w; w.x = pk2(h[0], h[1]); w.y = pk2(h[2], h[3]); *(uint2*)(H + (size_t)row * D + c) = w; } }
}
template <int MODE, int NSLAB = 0> __device__ __forceinline__ void row_phase(const Params& p, int lnidx, int sh_off, int sc_off) {
  int t_ = threadIdx.x; asm volatile("" : "+v"(t_)); const int lane = t_ & 63, wave = t_ >> 6;
  const float* mod = (const float*)(p.ws + WS_MOD);
  f32x4 g[4], b[4], sh[4], sc[4];
#pragma unroll
  for (int i = 0; i < 4; ++i) { const int c = lane * 4 + 256 * i; g[i] = b[i] = sh[i] = sc[i] = (f32x4){0.f, 0.f, 0.f, 0.f};
    if (MODE != 0) { g[i] = *(const f32x4*)(p.in[25] + lnidx * D + c); b[i] = *(const f32x4*)(p.in[26] + lnidx * D + c); } }
  for (int wg = blockIdx.x * 8 + wave; wg < TP / 16; wg += gridDim.x * 8) {
    if (MODE != 2) { const float* mr = mod + (wg >> 10) * 9216;
#pragma unroll
      for (int i = 0; i < 4; ++i) { const int c = lane * 4 + 256 * i; sh[i] = *(const f32x4*)(mr + sh_off + c); sc[i] = *(const f32x4*)(mr + sc_off + c); } }
#pragma unroll 2
    for (int k = 0; k < 16; ++k) row_one<MODE, NSLAB>(p, wg * 16 + k, lane, lnidx, g, b, sh, sc);
  }
  for (int sr = blockIdx.x * 8 + wave; sr < TS; sr += gridDim.x * 8) { const int row = TP + sr;
    if (MODE != 2) { const float* mr = mod + modrow(row) * 9216;
#pragma unroll
      for (int i = 0; i < 4; ++i) { const int c = lane * 4 + 256 * i; sh[i] = *(const f32x4*)(mr + sh_off + c); sc[i] = *(const f32x4*)(mr + sc_off + c); } }
    row_one<MODE, NSLAB>(p, row, lane, lnidx, g, b, sh, sc); }
}

__device__ __forceinline__ void scan_phase(const Params& p, unsigned char* lds, int tid_in) {
  unsigned char* ws = p.ws; float* sm = (float*)lds;
  const float* MI = (const float*)(ws + WS_MI); const float* MLF = (const float*)(ws + WS_MLF);
  for (int u = blockIdx.x; u < 24 + 512; u += gridDim.x) { int tid = tid_in; asm volatile("" : "+v"(tid));
    if (u < 16) {
      const int b = u >> 3, h = u & 7; const float* lf = p.out + O_LFP + ((size_t)b * SEQ) * 8 + h; float* F2 = (float*)(ws + WS_F2) + ((size_t)b * SEQ) * 8 + h;
      float loc[32]; float tot = 0.f;
#pragma unroll
      for (int i = 0; i < 32; ++i) { tot += lf[(size_t)(tid * 32 + i) * 8]; loc[i] = tot; }
      sm[tid] = tot; __syncthreads();
      for (int off = 1; off < NTHR; off <<= 1) { const float v = tid >= off ? sm[tid - off] : 0.f; __syncthreads(); sm[tid] += v; __syncthreads(); }
      const float pre = sm[tid] - tot;
#pragma unroll
      for (int i = 0; i < 32; ++i) F2[(size_t)(tid * 32 + i) * 8] = (pre + loc[i]) * LOG2E;
      __syncthreads();
    } else if (u < 24) {
      const int sq = u - 16, b = sq >> 2, h = sq & 3; const size_t r0 = (size_t)b * SEQ;
      float* MB = (float*)(ws + WS_MB); float* MM = (float*)(ws + WS_MM); float* MST = (float*)(ws + WS_MST);
      float* lfs = sm; float* igs = sm + 16640; float* sA = sm + 33280, *sC = sA + 256, *sE = sA + 512;
#pragma unroll 8
      for (int i = 0; i < 32; ++i) { const int tok = tid + NTHR * i; lfs[tok + (tok >> 6)] = MLF[(r0 + tok) * 4 + h]; igs[tok + (tok >> 6)] = MI[(r0 + tok) * 4 + h]; }
      __syncthreads();
      if (tid < 256) { float bsum = 0.f, ml = -INFINITY; for (int i = 0; i < 64; ++i) { const float lf = lfs[tid * 65 + i], ig = igs[tid * 65 + i]; bsum += lf; ml = fmaxf(lf + ml, ig); } sA[tid] = bsum; sC[tid] = ml; }
      __syncthreads();
      for (int off = 1; off < 256; off <<= 1) { float ap = 0.f, cp = -INFINITY; const bool act = tid < 256 && tid >= off; if (act) { ap = sA[tid - off]; cp = sC[tid - off]; } __syncthreads();
        if (act) { sC[tid] = fmaxf(sA[tid] + cp, sC[tid]); sA[tid] += ap; } __syncthreads(); }
      if (tid < 256) sE[tid] = fmaxf(sA[tid], sC[tid]);
      __syncthreads();
      if (tid < 256) { const float ms = tid > 0 ? sE[tid - 1] : 0.f; float bsum = 0.f, m = ms; for (int i = 0; i < 64; ++i) { const float lf = lfs[tid * 65 + i], ig = igs[tid * 65 + i]; bsum += lf; m = fmaxf(lf + m, ig); lfs[tid * 65 + i] = bsum; igs[tid * 65 + i] = m; }
        MST[sq * 256 + tid] = ms; MST[2048 + sq * 256 + tid] = __expf(bsum + ms - m); if (tid == 255) p.out[O_MP + sq] = m; }
      __syncthreads();
#pragma unroll 8
      for (int i = 0; i < 32; ++i) { const int tok = tid + NTHR * i; MB[(r0 + tok) * 4 + h] = lfs[tok + (tok >> 6)]; MM[(r0 + tok) * 4 + h] = igs[tok + (tok >> 6)]; }
      __syncthreads();
    } else {
      const int v = u - 24, b = v >> 8, tile = v & 255; unsigned* mx = (unsigned*)lds;
      if (tid < 16) mx[tid] = 0u; __syncthreads();
      const int row = tid >> 3, h = tid & 7; const size_t r = (size_t)b * SEQ + tile * 64 + row;
      const u16* kp = (const u16*)(ws + WS_AK) + r * 512 + h * 64; const u16* qp = (const u16*)(ws + WS_AQ) + r * 512 + h * 64;
      float nk = 0.f, nq = 0.f;
#pragma unroll
      for (int i = 0; i < 8; ++i) { const u32x4 a = *(const u32x4*)(kp + i * 8), c = *(const u32x4*)(qp + i * 8);
#pragma unroll
        for (int j = 0; j < 4; ++j) { float x = __uint_as_float(a[j] << 16), y = __uint_as_float(a[j] & 0xffff0000u); nk += x * x + y * y; x = __uint_as_float(c[j] << 16); y = __uint_as_float(c[j] & 0xffff0000u); nq += x * x + y * y; } }
      atomicMax(&mx[h], __float_as_uint(nk)); atomicMax(&mx[8 + h], __float_as_uint(nq)); __syncthreads();
      if (tid < 16) { float* MST = (float*)(ws + WS_MST); const int hh = tid & 7; MST[(tid < 8 ? 4096 : 8192) + (b * 8 + hh) * 256 + tile] = sqrtf(__uint_as_float(mx[tid])) * 1.0001f; }
      __syncthreads();
    }
  }
}

__device__ __forceinline__ void attn_prompt_unit(const Params& p, int b, int h, int qb, unsigned char* lds, int tid, int dry = 0) {
  unsigned char* ws = p.ws;
  const u16* AQ = (const u16*)(ws + WS_AQ); const u16* AK = (const u16*)(ws + WS_AK); const u16* AV = (const u16*)(ws + WS_AV); u16* OA = (u16*)(ws + WS_AQ);
  const float* F2 = (const float*)(ws + WS_F2); const float* MST = (const float*)(ws + WS_MST);
  u16* Ks = (u16*)lds;
  u16* Vt = (u16*)(lds + 18432);
  float* Fk = (float*)(lds + 36864);
  int* si = (int*)(lds + 37376);
  const int lane = tid & 63, wave = tid >> 6, r32 = lane & 31, hi = lane >> 5;
  const size_t rb = (size_t)b * SEQ; const int q0 = qb * 256; const int qrow = q0 + wave * 32 + r32;
  const int tend = 4 * qb + 3;
  int tstart = 0;
#if PRUNE
  { if (tid == 0) si[0] = 4 * qb; __syncthreads();
    const float* KM = MST + 4096 + (b * 8 + h) * 256; const float* QM = MST + 8192 + (b * 8 + h) * 256;
    const float q2 = fmaxf(fmaxf(QM[4 * qb], QM[4 * qb + 1]), fmaxf(QM[4 * qb + 2], QM[4 * qb + 3]));
    const float kd = fmaxf(fmaxf(KM[4 * qb], KM[4 * qb + 1]), fmaxf(KM[4 * qb + 2], KM[4 * qb + 3]));
    const float lower = -q2 * kd; const float fq0 = F2[(rb + q0) * 8 + h];
    if (tid < 4 * qb) { const float upper = q2 * KM[tid] + fq0 - F2[(rb + tid * 64 + 63) * 8 + h]; if (!(upper - lower < -PRUNE_TH)) atomicMin(&si[0], tid); }
    __syncthreads(); tstart = si[0]; __syncthreads(); }
#endif
  bf16x8 qr[4];
#pragma unroll
  for (int d0 = 0; d0 < 4; ++d0) qr[d0] = *(const bf16x8*)(AQ + (rb + qrow) * 512 + h * 64 + d0 * 16 + hi * 8);
  const float fq = F2[(rb + qrow) * 8 + h];
  f32x16 o0, o1;
#pragma unroll
  for (int r = 0; r < 16; ++r) { o0[r] = 0.f; o1[r] = 0.f; }
  float mrun = -INFINITY, lrun = 0.f;
  const int srow = tid >> 3, sch = tid & 7;
  const int vcol = srow ^ (sch << 3);
  const int sw0 = (r32 >> 3) << 3, sw1 = ((r32 >> 3) + 4) << 3;
  u32x4 kA, vA, kB, vB; float fA = 0.f, fB = 0.f;
#define ATT_LOAD(KR, VR, FR, t_) do { const size_t r_ = rb + (size_t)(t_) * 64 + srow; KR = *(const u32x4*)(AK + r_ * 512 + h * 64 + sch * 8); VR = *(const u32x4*)(AV + r_ * 512 + h * 64 + sch * 8); \
    if (tid < 64) FR = F2[(rb + (size_t)(t_) * 64 + tid) * 8 + h]; } while (0)
#define ATT_TILE(KR, VR, FR, t) do { \
    u16* Kb = Ks + buf * 4608; u16* Vb = Vt + buf * 4608; float* Fb = Fk + buf * 64; \
    *(u32x4*)(Kb + srow * 72 + sch * 8) = KR; \
    _Pragma("unroll") for (int j = 0; j < 4; ++j) { Vb[(sch * 8 + 2 * j) * 72 + vcol] = (u16)(VR[j] & 0xffffu); Vb[(sch * 8 + 2 * j + 1) * 72 + vcol] = (u16)(VR[j] >> 16); } \
    if (tid < 64) Fb[tid] = FR; \
    __syncthreads(); \
    if ((t) + 2 <= tend) ATT_LOAD(KR, VR, FR, (t) + 2); \
    f32x2_t pq[2][8]; const f32x2_t fq2 = {fq, fq}; \
    _Pragma("unroll") for (int blk = 0; blk < 2; ++blk) { f32x16 c; \
      _Pragma("unroll") for (int g = 0; g < 4; ++g) { const f32x4 fk = *(const f32x4*)(Fb + 32 * blk + 8 * g + 4 * hi); const f32x2_t a_ = fq2 - (f32x2_t){fk[0], fk[1]}, b_ = fq2 - (f32x2_t){fk[2], fk[3]}; \
        c[4 * g] = a_[0]; c[4 * g + 1] = a_[1]; c[4 * g + 2] = b_[0]; c[4 * g + 3] = b_[1]; } \
      __builtin_amdgcn_s_setprio(1); \
      _Pragma("unroll") for (int d0 = 0; d0 < 4; ++d0) { const bf16x8 a = *(const bf16x8*)(Kb + (32 * blk + r32) * 72 + d0 * 16 + hi * 8); c = __builtin_amdgcn_mfma_f32_32x32x16_bf16(a, qr[d0], c, 0, 0, 0); } \
      __builtin_amdgcn_s_setprio(0); \
      if ((t) >= 4 * qb) { const int kb0 = (t) * 64; \
        _Pragma("unroll") for (int r = 0; r < 16; ++r) { const int kv = kb0 + 32 * blk + crow(r, hi); if (kv > qrow) c[r] = -INFINITY; } } \
      _Pragma("unroll") for (int i = 0; i < 8; ++i) pq[blk][i] = (f32x2_t){c[2 * i], c[2 * i + 1]}; } \
    f32x2_t m2 = __builtin_elementwise_max(pq[0][0], pq[1][0]); \
    _Pragma("unroll") for (int i = 1; i < 8; ++i) m2 = __builtin_elementwise_max(m2, __builtin_elementwise_max(pq[0][i], pq[1][i])); \
    float rm = fmaxf(m2[0], m2[1]); \
    rm = fmaxf(rm, __shfl_xor(rm, 32)); \
    const float mnew = fmaxf(mrun, rm); const float al = __builtin_amdgcn_exp2f(mrun - mnew); const f32x2_t mn2 = {mnew, mnew}; f32x2_t rs2 = {0.f, 0.f}; \
    _Pragma("unroll") for (int blk = 0; blk < 2; ++blk) _Pragma("unroll") for (int i = 0; i < 8; ++i) { const f32x2_t d_ = pq[blk][i] - mn2; f32x2_t e_; e_[0] = __builtin_amdgcn_exp2f(d_[0]); e_[1] = __builtin_amdgcn_exp2f(d_[1]); pq[blk][i] = e_; rs2 += e_; } \
    lrun = lrun * al + (rs2[0] + rs2[1]); mrun = mnew; \
    o0 *= al; o1 *= al; \
    __builtin_amdgcn_s_setprio(1); \
    _Pragma("unroll") for (int blk = 0; blk < 2; ++blk) _Pragma("unroll") for (int s = 0; s < 2; ++s) { \
        u32x4 pw = {__builtin_bit_cast(unsigned, __builtin_convertvector(pq[blk][4 * s], bf16x2_t)), __builtin_bit_cast(unsigned, __builtin_convertvector(pq[blk][4 * s + 1], bf16x2_t)), \
                    __builtin_bit_cast(unsigned, __builtin_convertvector(pq[blk][4 * s + 2], bf16x2_t)), __builtin_bit_cast(unsigned, __builtin_convertvector(pq[blk][4 * s + 3], bf16x2_t))}; \
        const bf16x8 pf = __builtin_bit_cast(bf16x8, pw); const int kvo = 32 * blk + 16 * s + 4 * hi; \
        { const uint2 x = *(const uint2*)(Vb + r32 * 72 + (kvo ^ sw0)), y = *(const uint2*)(Vb + r32 * 72 + ((kvo + 8) ^ sw0)); u32x4 a = {x.x, x.y, y.x, y.y}; \
          o0 = __builtin_amdgcn_mfma_f32_32x32x16_bf16(__builtin_bit_cast(bf16x8, a), pf, o0, 0, 0, 0); } \
        { const uint2 x = *(const uint2*)(Vb + (32 + r32) * 72 + (kvo ^ sw1)), y = *(const uint2*)(Vb + (32 + r32) * 72 + ((kvo + 8) ^ sw1)); u32x4 a = {x.x, x.y, y.x, y.y}; \
          o1 = __builtin_amdgcn_mfma_f32_32x32x16_bf16(__builtin_bit_cast(bf16x8, a), pf, o1, 0, 0, 0); } } \
    __builtin_amdgcn_s_setprio(0); \
    buf ^= 1; } while (0)
  ATT_LOAD(kA, vA, fA, tstart);
  if (tstart + 1 <= tend) ATT_LOAD(kB, vB, fB, tstart + 1);
  int buf = 0;
  { int t = tstart;
    for (; t + 1 <= tend; t += 2) { ATT_TILE(kA, vA, fA, t); ATT_TILE(kB, vB, fB, t + 1); }
    if (t <= tend) ATT_TILE(kA, vA, fA, t); }
#undef ATT_LOAD
#undef ATT_TILE
  lrun += __shfl_xor(lrun, 32);
  const float inv = 1.f / lrun;
  u16* orow = dry ? (u16*)(ws + WS_END) + (((rb + qrow) * 512 + h * 64) & 0x3fffff) : OA + (rb + qrow) * 512 + h * 64;
#pragma unroll
  for (int g = 0; g < 4; ++g) { uint2 w; w.x = pk2(o0[4 * g] * inv, o0[4 * g + 1] * inv); w.y = pk2(o0[4 * g + 2] * inv, o0[4 * g + 3] * inv); *(uint2*)(orow + 8 * g + 4 * hi) = w;
    w.x = pk2(o1[4 * g] * inv, o1[4 * g + 1] * inv); w.y = pk2(o1[4 * g + 2] * inv, o1[4 * g + 3] * inv); *(uint2*)(orow + 32 + 8 * g + 4 * hi) = w; }
  __syncthreads();
}

__device__ __forceinline__ void attn_sample_unit(const Params& p, int b, int h, unsigned char* lds, int tid, int dry = 0) {
  constexpr int NK = PAST + 16, NTILE = (NK + 31) / 32;
  float* Ft = (float*)lds;
  float* red = (float*)(lds + 8320);
  const int lane = tid & 63, wave = tid >> 6, r32 = lane & 31, hi = lane >> 5, q = r32 & 15;
  unsigned char* wreg = lds + 10752 + wave * 12288;
  u16* Kw = (u16*)wreg; u16* Vw = (u16*)(wreg + 4608); float* Ow = (float*)wreg; float* MLw = (float*)(wreg + 8192);
  const u16* AQ = (const u16*)(p.ws + WS_AQ); u16* OA = (u16*)(p.ws + WS_AQ);
  const float* ck = p.in[2]; const float* cv = p.in[3]; const float* clf = p.in[4];
  { float loc[5]; float tot = 0.f;
#pragma unroll
    for (int i = 0; i < 5; ++i) { const int j = tid * 5 + i; float v = 0.f; if (j < PAST) v = clf[((size_t)b * PAST + j) * 8 + h]; else if (j < NK) v = p.out[O_LFS + (size_t)(b * 16 + j - PAST) * 8 + h]; tot += v; loc[i] = tot; }
    red[tid] = tot; __syncthreads();
    for (int off = 1; off < NTHR; off <<= 1) { const float v = tid >= off ? red[tid - off] : 0.f; __syncthreads(); red[tid] += v; __syncthreads(); }
    const float pre = red[tid] - tot;
#pragma unroll
    for (int i = 0; i < 5; ++i) { const int j = tid * 5 + i; if (j < 2080) Ft[j] = (pre + loc[i]) * LOG2E; }
    __syncthreads(); }
  bf16x8 qr[4];
#pragma unroll
  for (int d0 = 0; d0 < 4; ++d0) qr[d0] = *(const bf16x8*)(AQ + (size_t)(TP + b * 16 + q) * 512 + h * 64 + d0 * 16 + hi * 8);
  const float fq = Ft[PAST + q];
  f32x16 o0, o1;
#pragma unroll
  for (int r = 0; r < 16; ++r) { o0[r] = 0.f; o1[r] = 0.f; }
  float mrun = -INFINITY, lrun = 0.f;
  const int kk = lane >> 1, hh = lane & 1;
  f32x4 kreg[8], vreg[8];
#define SAMPLE_LOAD(t_) do { const int j_ = 32 * (t_) + kk; \
    if (j_ < NK) { const float* kp_ = j_ < PAST ? ck + (((size_t)b * PAST + j_) * 8 + h) * 64 : p.out + O_KS + (size_t)(b * 16 + j_ - PAST) * 512 + h * 64; \
      const float* vp_ = j_ < PAST ? cv + (((size_t)b * PAST + j_) * 8 + h) * 64 : p.out + O_VS + (size_t)(b * 16 + j_ - PAST) * 512 + h * 64; \
      _Pragma("unroll") for (int i_ = 0; i_ < 8; ++i_) { kreg[i_] = *(const f32x4*)(kp_ + hh * 32 + i_ * 4); vreg[i_] = *(const f32x4*)(vp_ + hh * 32 + i_ * 4); } } \
    else { _Pragma("unroll") for (int i_ = 0; i_ < 8; ++i_) { kreg[i_] = (f32x4){0.f, 0.f, 0.f, 0.f}; vreg[i_] = (f32x4){0.f, 0.f, 0.f, 0.f}; } } } while (0)
  SAMPLE_LOAD(wave);
  for (int t = wave; t < NTILE; t += 8) {
#pragma unroll
    for (int i = 0; i < 2; ++i) { u32x4 w0 = {pk2(kreg[4 * i][0], kreg[4 * i][1]), pk2(kreg[4 * i][2], kreg[4 * i][3]), pk2(kreg[4 * i + 1][0], kreg[4 * i + 1][1]), pk2(kreg[4 * i + 1][2], kreg[4 * i + 1][3])};
      u32x4 w1 = {pk2(kreg[4 * i + 2][0], kreg[4 * i + 2][1]), pk2(kreg[4 * i + 2][2], kreg[4 * i + 2][3]), pk2(kreg[4 * i + 3][0], kreg[4 * i + 3][1]), pk2(kreg[4 * i + 3][2], kreg[4 * i + 3][3])};
      *(u32x4*)(Kw + kk * 72 + hh * 32 + i * 16) = w0; *(u32x4*)(Kw + kk * 72 + hh * 32 + i * 16 + 8) = w1; }
#pragma unroll
    for (int i = 0; i < 8; ++i)
#pragma unroll
      for (int e = 0; e < 4; ++e) Vw[(hh * 32 + i * 4 + e) * 40 + kk] = f2bf(vreg[i][e]);
    if (t + 8 < NTILE) SAMPLE_LOAD(t + 8);
    f32x16 c;
#pragma unroll
    for (int g = 0; g < 4; ++g) { const f32x4 fk = *(const f32x4*)(Ft + 32 * t + 8 * g + 4 * hi); c[4 * g] = fq - fk[0]; c[4 * g + 1] = fq - fk[1]; c[4 * g + 2] = fq - fk[2]; c[4 * g + 3] = fq - fk[3]; }
#pragma unroll
    for (int d0 = 0; d0 < 4; ++d0) { const bf16x8 a = *(const bf16x8*)(Kw + r32 * 72 + d0 * 16 + hi * 8); c = __builtin_amdgcn_mfma_f32_32x32x16_bf16(a, qr[d0], c, 0, 0, 0); }
    if (32 * t + 31 > PAST) {
#pragma unroll
      for (int r = 0; r < 16; ++r) { const int kv = 32 * t + crow(r, hi); if (kv > PAST + q) c[r] = -INFINITY; } }
    float rm = -INFINITY;
#pragma unroll
    for (int r = 0; r < 16; ++r) rm = fmaxf(rm, c[r]);
    rm = fmaxf(rm, __shfl_xor(rm, 32));
    const float mnew = fmaxf(mrun, rm); const float al = __builtin_amdgcn_exp2f(mrun - mnew); float rs = 0.f;
#pragma unroll
    for (int r = 0; r < 16; ++r) { const float e = __builtin_amdgcn_exp2f(c[r] - mnew); c[r] = e; rs += e; }
    lrun = lrun * al + rs; mrun = mnew;
#pragma unroll
    for (int r = 0; r < 16; ++r) { o0[r] *= al; o1[r] *= al; }
#pragma unroll
    for (int s2 = 0; s2 < 2; ++s2) {
      u32x4 pw = {pk2(c[8 * s2], c[8 * s2 + 1]), pk2(c[8 * s2 + 2], c[8 * s2 + 3]), pk2(c[8 * s2 + 4], c[8 * s2 + 5]), pk2(c[8 * s2 + 6], c[8 * s2 + 7])};
      const bf16x8 pf = __builtin_bit_cast(bf16x8, pw); const int kvo = 16 * s2 + 4 * hi;
      { const uint2 x = *(const uint2*)(Vw + r32 * 40 + kvo), y = *(const uint2*)(Vw + r32 * 40 + kvo + 8); u32x4 a = {x.x, x.y, y.x, y.y};
        o0 = __builtin_amdgcn_mfma_f32_32x32x16_bf16(__builtin_bit_cast(bf16x8, a), pf, o0, 0, 0, 0); }
      { const uint2 x = *(const uint2*)(Vw + (32 + r32) * 40 + kvo), y = *(const uint2*)(Vw + (32 + r32) * 40 + kvo + 8); u32x4 a = {x.x, x.y, y.x, y.y};
        o1 = __builtin_amdgcn_mfma_f32_32x32x16_bf16(__builtin_bit_cast(bf16x8, a), pf, o1, 0, 0, 0); } }
  }
#undef SAMPLE_LOAD
  lrun += __shfl_xor(lrun, 32);
#pragma unroll
  for (int r = 0; r < 16; ++r) { Ow[crow(r, hi) * 32 + r32] = o0[r]; Ow[(32 + crow(r, hi)) * 32 + r32] = o1[r]; }
  if (hi == 0) { MLw[r32] = mrun; MLw[32 + r32] = lrun; }
  __syncthreads();
  { const int qq = tid & 15, dp = tid >> 4; float M = -INFINITY;
#pragma unroll
    for (int w = 0; w < 8; ++w) M = fmaxf(M, ((const float*)(lds + 10752 + w * 12288 + 8192))[qq]);
    float L = 0.f, a0 = 0.f, a1 = 0.f;
#pragma unroll
    for (int w = 0; w < 8; ++w) { const float* ml = (const float*)(lds + 10752 + w * 12288 + 8192); const float* ow = (const float*)(lds + 10752 + w * 12288); const float sc = __builtin_amdgcn_exp2f(ml[qq] - M);
      L += ml[32 + qq] * sc; a0 += ow[(2 * dp) * 32 + qq] * sc; a1 += ow[(2 * dp + 1) * 32 + qq] * sc; }
    const float inv = 1.f / L;
    u16* dst = (dry ? (u16*)(p.ws + WS_END) : OA + (size_t)TP * 512) + (size_t)(b * 16 + qq) * 512 + h * 64 + 2 * dp;
    *(unsigned*)dst = pk2(a0 * inv, a1 * inv); }
  __syncthreads();
}

template <class CT> __device__ __forceinline__ float ldc(const CT* p);
template <> __device__ __forceinline__ float ldc<u16>(const u16* p) { return bf2f(*p); }
template <> __device__ __forceinline__ float ldc<float>(const float* p) { return *p; }

template <int L, int MODE> __device__ __forceinline__ void mlstm_unit(const Params& p, int b, int h, int c, unsigned char* lds, int tid, int dry = 0) {
  typedef typename std::conditional<MODE == 2, float, u16>::type CT;
  constexpr int CP = (MODE == 2) ? 129 : 130;
  constexpr int OFF_Q = 0, OFF_K = L * 260, OFF_V = 2 * L * 260, OFF_C = 3 * L * 260, OFF_A = OFF_C + 128 * CP * (int)sizeof(CT), OFF_H = OFF_A + L * (L + 1) * 4, OFF_S = OFF_H + L * 128 * 4;
  static_assert(OFF_S + 1024 * 4 <= MISC_OFF && (OFF_C % 4) == 0 && (OFF_A % 4) == 0, "mlstm lds");
  unsigned char* ws = p.ws;
  u16* qs = (u16*)(lds + OFF_Q); u16* ks = (u16*)(lds + OFF_K); u16* vs = (u16*)(lds + OFF_V); CT* Cs = (CT*)(lds + OFF_C); float* A = (float*)(lds + OFF_A); float* Hs = (float*)(lds + OFF_H);
  float* sc = (float*)(lds + OFF_S); float *bt = sc, *ig = sc + 64, *mt = sc + 128, *wint = sc + 192, *den = sc + 256, *nq = sc + 320, *wsv = sc + 384, *ns = sc + 448, *misc = sc + 576;
  const u16* PRE = (const u16*)(ws + WS_PRE); u16* MV = (u16*)(ws + WS_MV); const u16* SIGO = (const u16*)(ws + WS_SIGO);
  const float* MI = (const float*)(ws + WS_MI); const float* MLF = (const float*)(ws + WS_MLF);
  const int sq = b * 4 + h; const int item = sq * 256 + c;
  const size_t r0 = (MODE == 2) ? (size_t)TP + b * 16 : (size_t)b * SEQ + (size_t)c * 64;
  const float* cw = p.in[17]; const float* cb = p.in[18];
  { constexpr int NI = (MODE == 0) ? L * 16 : L * 32;
    for (int idx = tid; idx < NI; idx += NTHR) { const int l = (MODE == 0) ? idx >> 4 : idx >> 5, chk = (MODE == 0) ? 16 + (idx & 15) : idx & 31;
      const int col0 = chk < 16 ? h * 128 + chk * 8 : 512 + h * 128 + (chk - 16) * 8;
      float val[8]; { const f32x4 b0 = *(const f32x4*)(cb + col0), b1 = *(const f32x4*)(cb + col0 + 4);
#pragma unroll
        for (int e = 0; e < 4; ++e) { val[e] = b0[e]; val[4 + e] = b1[e]; } }
#pragma unroll
      for (int j = 0; j < 4; ++j) { const int rr = l - 3 + j; float x[8];
        if (rr >= 0 || (MODE != 2 && c > 0)) { const u32x4 pv = *(const u32x4*)(PRE + (r0 + rr) * 1024 + col0);
#pragma unroll
          for (int e = 0; e < 4; ++e) { x[2 * e] = __uint_as_float(pv[e] << 16); x[2 * e + 1] = __uint_as_float(pv[e] & 0xffff0000u); } }
        else if (MODE == 2) { const float* hp = p.in[8] + ((size_t)b * 3 + (3 + rr)) * 1024 + col0; const f32x4 h0 = *(const f32x4*)hp, h1 = *(const f32x4*)(hp + 4);
#pragma unroll
          for (int e = 0; e < 4; ++e) { x[e] = h0[e]; x[4 + e] = h1[e]; } }
        else {
#pragma unroll
          for (int e = 0; e < 8; ++e) x[e] = 0.f; }
        const f32x4 w0 = *(const f32x4*)(cw + j * 1024 + col0), w1 = *(const f32x4*)(cw + j * 1024 + col0 + 4);
#pragma unroll
        for (int e = 0; e < 4; ++e) { val[e] += x[e] * w0[e]; val[4 + e] += x[4 + e] * w1[e]; } }
      const float scl = chk < 16 ? 1.f : 0.08838834764831845f;
#pragma unroll
      for (int e = 0; e < 8; ++e) val[e] = siluf(val[e]) * scl;
      unsigned* dst = (unsigned*)((chk < 16 ? qs + l * 130 + chk * 8 : ks + l * 130 + (chk - 16) * 8));
      dst[0] = pk2(val[0], val[1]); dst[1] = pk2(val[2], val[3]); dst[2] = pk2(val[4], val[5]); dst[3] = pk2(val[6], val[7]); }
    for (int idx = tid; idx < L * 16; idx += NTHR) { const int l = idx >> 4, ch = idx & 15; const u32x4 v = *(const u32x4*)(MV + (r0 + l) * 512 + h * 128 + ch * 8);
      unsigned* dst = (unsigned*)(vs + l * 130 + ch * 8); dst[0] = v[0]; dst[1] = v[1]; dst[2] = v[2]; dst[3] = v[3]; } }
  float m0;
  if (MODE == 2) { m0 = p.in[7][sq];
    if (tid == 0) { float bs = 0.f, m = m0; for (int l = 0; l < L; ++l) { const float lf = MLF[(r0 + l) * 4 + h], g = MI[(r0 + l) * 4 + h]; bs += lf; m = fmaxf(lf + m, g); bt[l] = bs; ig[l] = g; mt[l] = m; } }
    for (int i = tid; i < 128; i += NTHR) ns[i] = p.in[6][sq * 128 + i];
  } else { m0 = ((const float*)(ws + WS_MST))[item];
    if (tid < L) { bt[tid] = ((const float*)(ws + WS_MB))[(r0 + tid) * 4 + h]; ig[tid] = MI[(r0 + tid) * 4 + h]; mt[tid] = ((const float*)(ws + WS_MM))[(r0 + tid) * 4 + h]; }
    if (MODE == 1) for (int i = tid; i < 128; i += NTHR) ns[i] = ((const float*)(ws + WS_UN))[(size_t)item * 128 + i]; }
  if (MODE == 1) { const u16* Cg = (const u16*)(p.out + O_YP) + (size_t)item * 16384;
#pragma unroll
    for (int i = 0; i < 4; ++i) { const int idx = tid + NTHR * i, v = idx >> 4, ch = idx & 15; const u32x4 x = *(const u32x4*)(Cg + v * 128 + ch * 8); unsigned* dst = (unsigned*)((u16*)Cs + v * CP + ch * 8); dst[0] = x[0]; dst[1] = x[1]; dst[2] = x[2]; dst[3] = x[3]; } }
  if (MODE == 2) { const float* Cg = p.in[5] + (size_t)sq * 16384;
#pragma unroll
    for (int i = 0; i < 8; ++i) { const int idx = tid + NTHR * i, v = idx >> 5, c4 = idx & 31; const f32x4 x = *(const f32x4*)(Cg + v * 128 + c4 * 4); float* dst = (float*)Cs + v * CP + c4 * 4; dst[0] = x[0]; dst[1] = x[1]; dst[2] = x[2]; dst[3] = x[3]; } }
  __syncthreads();
  if (tid < L) { wint[tid] = __expf(bt[tid] + m0 - mt[tid]); wsv[tid] = __expf(bt[L - 1] - bt[tid] + ig[tid] - mt[L - 1]); }
  const float mnew = mt[L - 1]; const float wstate = __expf(bt[L - 1] + m0 - mnew);
  if (MODE != 0) {
#pragma unroll 1
    for (int idx = tid; idx < L * L; idx += NTHR) { const int t = idx / L, s = idx % L; float a = 0.f;
      if (s <= t) { float dot = 0.f;
#pragma unroll 8
        for (int d = 0; d < 128; ++d) dot += bf2f(qs[t * 130 + d]) * bf2f(ks[s * 130 + d]);
        a = __expf(bt[t] - bt[s] + ig[s] - mt[t]) * dot; }
      A[t * (L + 1) + s] = a; }
    __syncthreads();
    if (tid < L) { float s = 0.f; for (int j = 0; j <= tid; ++j) s += A[tid * (L + 1) + j]; den[tid] = s; }
    else if (tid >= 64 && tid < 64 + L) { const int t = tid - 64; float s = 0.f; for (int d = 0; d < 128; ++d) s += ns[d] * bf2f(qs[t * 130 + d]); nq[t] = s; }
    __syncthreads();
#pragma unroll 1
    for (int idx = tid; idx < L * 128; idx += NTHR) { const int t = idx >> 7, v = idx & 127; float n1 = 0.f, n2 = 0.f;
#pragma unroll 1
      for (int s = 0; s <= t; ++s) n1 += A[t * (L + 1) + s] * bf2f(vs[s * 130 + v]);
#pragma unroll 8
      for (int d = 0; d < 128; ++d) n2 += ldc<CT>(Cs + v * CP + d) * bf2f(qs[t * 130 + d]);
      const float wi = wint[t]; const float dn = den[t] + wi * nq[t];
      Hs[t * 128 + v] = (n1 + wi * n2) / fmaxf(fabsf(dn), __expf(-mt[t])); }
    __syncthreads();
    { const int lane = tid & 63, wave = tid >> 6;
      for (int t = wave; t < L; t += 8) { const float x0 = Hs[t * 128 + lane], x1 = Hs[t * 128 + 64 + lane]; const float mu = wsum(x0 + x1) * (1.f / 128.f);
        const float y0 = x0 - mu, y1 = x1 - mu; const float rstd = rsqrtf(wsum(y0 * y0 + y1 * y1) * (1.f / 128.f) + LN_EPS);
        const size_t ro = (r0 + t) * 512 + h * 128; const float* ng = p.in[19] + h * 128;
        u16* MO = dry ? (u16*)(ws + WS_END) + (ro & 0x3fffff) : MV + ro; MO[lane] = f2bf(y0 * rstd * ng[lane] * bf2f(SIGO[ro + lane])); MO[64 + lane] = f2bf(y1 * rstd * ng[64 + lane] * bf2f(SIGO[ro + 64 + lane])); } }
  }
  if (MODE != 1) {
    __syncthreads();
    const int v = tid >> 2, dg = tid & 3; float acc[32];
#pragma unroll
    for (int i = 0; i < 32; ++i) acc[i] = 0.f;
#pragma unroll 1
    for (int s = 0; s < L; ++s) { const float wv = wsv[s] * bf2f(vs[s * 130 + v]);
#pragma unroll
      for (int i = 0; i < 32; ++i) acc[i] += wv * bf2f(ks[s * 130 + dg * 32 + i]); }
    if (MODE == 0) { u16* Ug = (u16*)(p.out + O_YP) + (size_t)item * 16384 + v * 128 + dg * 32;
#pragma unroll
      for (int i = 0; i < 4; ++i) { u32x4 w = {pk2(acc[8 * i], acc[8 * i + 1]), pk2(acc[8 * i + 2], acc[8 * i + 3]), pk2(acc[8 * i + 4], acc[8 * i + 5]), pk2(acc[8 * i + 6], acc[8 * i + 7])}; *(u32x4*)(Ug + 8 * i) = w; }
      if (tid < 128) { float s = 0.f; for (int j = 0; j < L; ++j) s += wsv[j] * bf2f(ks[j * 130 + tid]); ((float*)(ws + WS_UN))[(size_t)item * 128 + tid] = s; } }
    else { float* Cg = p.out + O_CS + (size_t)sq * 16384 + v * 128 + dg * 32;
#pragma unroll
      for (int i = 0; i < 32; ++i) Cg[i] = wstate * ldc<CT>(Cs + v * CP + dg * 32 + i) + acc[i];
      if (tid < 128) { float s = 0.f; for (int j = 0; j < L; ++j) s += wsv[j] * bf2f(ks[j * 130 + tid]); p.out[O_NS + sq * 128 + tid] = wstate * ns[tid] + s; }
      if (tid == 0) p.out[O_MS + sq] = mnew; }
  }
  __syncthreads();
}

__device__ __forceinline__ void conv8(const u16* PRE, const float* cw, const float* cb, size_t r0, int l, int col0, bool hasprev, float scl, float (&val)[8]) {
  { const f32x4 b0 = *(const f32x4*)(cb + col0), b1 = *(const f32x4*)(cb + col0 + 4);
#pragma unroll
    for (int e = 0; e < 4; ++e) { val[e] = b0[e]; val[4 + e] = b1[e]; } }
#pragma unroll
  for (int j = 0; j < 4; ++j) { const int rr = l - 3 + j;
    if (rr >= 0 || hasprev) { const u32x4 pv = *(const u32x4*)(PRE + (r0 + rr) * 1024 + col0);
      const f32x4 w0 = *(const f32x4*)(cw + j * 1024 + col0), w1 = *(const f32x4*)(cw + j * 1024 + col0 + 4);
#pragma unroll
      for (int e = 0; e < 4; ++e) { const float x0 = __uint_as_float(pv[e] << 16), x1 = __uint_as_float(pv[e] & 0xffff0000u);
        const float wa = (2 * e < 4) ? w0[(2 * e) & 3] : w1[(2 * e) & 3], wb = (2 * e + 1 < 4) ? w0[(2 * e + 1) & 3] : w1[(2 * e + 1) & 3];
        val[2 * e] += x0 * wa; val[2 * e + 1] += x1 * wb; } } }
#pragma unroll
  for (int e = 0; e < 8; ++e) val[e] = siluf(val[e]) * scl;
}

template <int NR> __device__ __forceinline__ void convN(const u16* PRE, const float* cw, const float* cb, size_t r0, int l0, int col0, bool hasprev, float scl, float (&out)[NR][8]) {
  float w[4][8], bb[8];
  { const f32x4 b0 = *(const f32x4*)(cb + col0), b1 = *(const f32x4*)(cb + col0 + 4);
#pragma unroll
    for (int e = 0; e < 4; ++e) { bb[e] = b0[e]; bb[4 + e] = b1[e]; } }
#pragma unroll
  for (int j = 0; j < 4; ++j) { const f32x4 w0 = *(const f32x4*)(cw + j * 1024 + col0), w1 = *(const f32x4*)(cw + j * 1024 + col0 + 4);
#pragma unroll
    for (int e = 0; e < 4; ++e) { w[j][e] = w0[e]; w[j][4 + e] = w1[e]; } }
  u32x4 xr[NR + 3];
#pragma unroll
  for (int i = 0; i < NR + 3; ++i) { const int rr = l0 - 3 + i; xr[i] = (rr >= 0 || hasprev) ? *(const u32x4*)(PRE + (r0 + rr) * 1024 + col0) : (u32x4){0u, 0u, 0u, 0u}; }
#pragma unroll
  for (int r = 0; r < NR; ++r) {
#pragma unroll
    for (int e = 0; e < 8; ++e) out[r][e] = bb[e];
#pragma unroll
    for (int j = 0; j < 4; ++j) { const u32x4 pv = xr[r + j];
#pragma unroll
      for (int e = 0; e < 4; ++e) { out[r][2 * e] += __uint_as_float(pv[e] << 16) * w[j][2 * e]; out[r][2 * e + 1] += __uint_as_float(pv[e] & 0xffff0000u) * w[j][2 * e + 1]; } }
#pragma unroll
    for (int e = 0; e < 8; ++e) out[r][e] = siluf(out[r][e]) * scl; }
}

__device__ __forceinline__ void mlstm_h1_unit(const Params& p, int b, int h, int c, unsigned char* lds, int tid) {
  unsigned char* ws = p.ws;
  u16* vT = (u16*)lds; u16* kT = (u16*)(lds + 18432); float* wsv = (float*)(lds + 36864);
  const u16* PRE = (const u16*)(ws + WS_PRE); const u16* MV = (const u16*)(ws + WS_MV);
  const float* MI = (const float*)(ws + WS_MI); const float* MB = (const float*)(ws + WS_MB); const float* MM = (const float*)(ws + WS_MM);
  const int sq = b * 4 + h, item = sq * 256 + c; const size_t r0 = (size_t)b * SEQ + (size_t)c * 64;
  const int lane = tid & 63, wave = tid >> 6, r32 = lane & 31, hi = lane >> 5;
  if (tid < 64) wsv[tid] = __expf(MB[(r0 + 63) * 4 + h] - MB[(r0 + tid) * 4 + h] + MI[(r0 + tid) * 4 + h] - MM[(r0 + 63) * 4 + h]);
  __syncthreads();
  { const int chk = tid & 15, l0 = (tid >> 4) * 2; float val[2][8];
    convN<2>(PRE, p.in[17], p.in[18], r0, l0, 512 + h * 128 + chk * 8, c > 0, 0.08838834764831845f, val);
#pragma unroll
    for (int r = 0; r < 2; ++r)
#pragma unroll
      for (int e = 0; e < 8; ++e) kT[(chk * 8 + e) * 72 + l0 + r] = f2bf(val[r][e]); }
#pragma unroll
  for (int it = 0; it < 2; ++it) { const int idx = tid + NTHR * it, l = idx >> 4, ch = idx & 15; const u32x4 v = *(const u32x4*)(MV + (r0 + l) * 512 + h * 128 + ch * 8); const float w = wsv[l];
#pragma unroll
    for (int e = 0; e < 4; ++e) { vT[(ch * 8 + 2 * e) * 72 + l] = f2bf(__uint_as_float(v[e] << 16) * w); vT[(ch * 8 + 2 * e + 1) * 72 + l] = f2bf(__uint_as_float(v[e] & 0xffff0000u) * w); } }
  __syncthreads();
  u16* Ug = (u16*)(p.out + O_YP) + (size_t)item * 16384;
#pragma unroll
  for (int ti = 0; ti < 2; ++ti) { const int i = wave * 2 + ti, vb = i >> 2, db = i & 3; f32x16 acc;
#pragma unroll
    for (int r = 0; r < 16; ++r) acc[r] = 0.f;
#pragma unroll
    for (int k0 = 0; k0 < 64; k0 += 16) { const bf16x8 a = *(const bf16x8*)(vT + (vb * 32 + r32) * 72 + k0 + 8 * hi), bb = *(const bf16x8*)(kT + (db * 32 + r32) * 72 + k0 + 8 * hi);
      acc = __builtin_amdgcn_mfma_f32_32x32x16_bf16(a, bb, acc, 0, 0, 0); }
#pragma unroll
    for (int r = 0; r < 16; ++r) Ug[(vb * 32 + crow(r, hi)) * 128 + db * 32 + r32] = f2bf(acc[r]); }
  if (tid < 128) { float s2 = 0.f;
#pragma unroll 8
    for (int j = 0; j < 64; ++j) s2 += bf2f(kT[tid * 72 + j]) * wsv[j];
    ((float*)(ws + WS_UN))[(size_t)item * 128 + tid] = s2; }
  __syncthreads();
}

__device__ __forceinline__ void mlstm_h3_unit(const Params& p, int b, int h, int c, unsigned char* lds, int tid, int dry = 0) {
  unsigned char* ws = p.ws;
  u16* qs = (u16*)lds; u16* ks = (u16*)(lds + 17408); u16* vT = (u16*)(lds + 34816); u16* Cs = (u16*)(lds + 53248); u16* At = (u16*)(lds + 88064); float* Hs = (float*)(lds + 97280);
  float* sc = (float*)(lds + 130048); float *bt = sc, *ig = sc + 64, *mt = sc + 128, *wint = sc + 192, *den = sc + 256, *nq = sc + 320, *ns = sc + 384;
  const u16* PRE = (const u16*)(ws + WS_PRE); u16* MV = (u16*)(ws + WS_MV); const u16* SIGO = (const u16*)(ws + WS_SIGO);
  const float* MI = (const float*)(ws + WS_MI); const float* MB = (const float*)(ws + WS_MB); const float* MM = (const float*)(ws + WS_MM);
  const int sq = b * 4 + h, item = sq * 256 + c; const size_t r0 = (size_t)b * SEQ + (size_t)c * 64;
  const int lane = tid & 63, wave = tid >> 6, r32 = lane & 31, hi = lane >> 5;
  if (tid < 64) { const float m0 = ((const float*)(ws + WS_MST))[item]; const float bb = MB[(r0 + tid) * 4 + h], mm = MM[(r0 + tid) * 4 + h]; bt[tid] = bb; ig[tid] = MI[(r0 + tid) * 4 + h]; mt[tid] = mm; wint[tid] = __expf(bb + m0 - mm); }
  else if (tid >= 128 && tid < 256) ns[tid - 128] = ((const float*)(ws + WS_UN))[(size_t)item * 128 + tid - 128];
  { const int chk = tid & 31, l0 = (tid >> 5) * 4; float val[4][8];
    const int col0 = chk < 16 ? h * 128 + chk * 8 : 512 + h * 128 + (chk - 16) * 8;
    convN<4>(PRE, p.in[17], p.in[18], r0, l0, col0, c > 0, chk < 16 ? 1.f : 0.08838834764831845f, val);
#pragma unroll
    for (int r = 0; r < 4; ++r) { u32x4 w = {pk2(val[r][0], val[r][1]), pk2(val[r][2], val[r][3]), pk2(val[r][4], val[r][5]), pk2(val[r][6], val[r][7])};
      *(u32x4*)((chk < 16 ? qs : ks) + (l0 + r) * 136 + (chk & 15) * 8) = w; } }
#pragma unroll
  for (int it = 0; it < 2; ++it) { const int idx = tid + NTHR * it, l = idx >> 4, ch = idx & 15; const u32x4 v = *(const u32x4*)(MV + (r0 + l) * 512 + h * 128 + ch * 8);
#pragma unroll
    for (int e = 0; e < 4; ++e) { vT[(ch * 8 + 2 * e) * 72 + l] = (u16)(v[e] & 0xffffu); vT[(ch * 8 + 2 * e + 1) * 72 + l] = (u16)(v[e] >> 16); } }
  { const u16* Cg = (const u16*)(p.out + O_YP) + (size_t)item * 16384;
#pragma unroll
    for (int it = 0; it < 4; ++it) { const int idx = tid + NTHR * it, v = idx >> 4, ch = idx & 15; *(u32x4*)(Cs + v * 136 + ch * 8) = *(const u32x4*)(Cg + v * 128 + ch * 8); } }
  float sg0[8], sg1[8]; float ng0, ng1;
  { const float* ng = p.in[19] + h * 128; ng0 = ng[lane]; ng1 = ng[64 + lane];
#pragma unroll
    for (int i = 0; i < 8; ++i) { const size_t ro = (r0 + wave + 8 * i) * 512 + h * 128; sg0[i] = bf2f(SIGO[ro + lane]); sg1[i] = bf2f(SIGO[ro + 64 + lane]); } }
  __syncthreads();
  { const int l15 = lane & 15, l4 = lane >> 4;
#pragma unroll
    for (int ti = 0; ti < 2; ++ti) { const int i = wave * 2 + ti, tb = i >> 2, sb = i & 3; const int t = tb * 16 + l15, s0 = sb * 16 + 4 * l4; uint2 w; w.x = 0u; w.y = 0u;
      if (sb <= tb) { f32x4 acc = {0.f, 0.f, 0.f, 0.f};
#pragma unroll
        for (int k0 = 0; k0 < 128; k0 += 32) { const bf16x8 a = *(const bf16x8*)(ks + (sb * 16 + l15) * 136 + k0 + 8 * l4), bq = *(const bf16x8*)(qs + (tb * 16 + l15) * 136 + k0 + 8 * l4);
          acc = __builtin_amdgcn_mfma_f32_16x16x32_bf16(a, bq, acc, 0, 0, 0); }
        float av[4]; const float bmt = bt[t] - mt[t];
#pragma unroll
        for (int r = 0; r < 4; ++r) { const int s2 = s0 + r; av[r] = (s2 <= t) ? __expf(bmt - bt[s2] + ig[s2]) * acc[r] : 0.f; }
        w.x = pk2(av[0], av[1]); w.y = pk2(av[2], av[3]); }
      *(uint2*)(At + t * 72 + s0) = w; } }
  __syncthreads();
  { const int t = tid >> 3, part = tid & 7; float s2 = 0.f, s3 = 0.f;
#pragma unroll
    for (int j = 0; j < 8; ++j) s2 += bf2f(At[t * 72 + part * 8 + j]);
#pragma unroll
    for (int j = 0; j < 16; ++j) s3 += ns[part * 16 + j] * bf2f(qs[t * 136 + part * 16 + j]);
    s2 += __shfl_xor(s2, 1); s3 += __shfl_xor(s3, 1); s2 += __shfl_xor(s2, 2); s3 += __shfl_xor(s3, 2); s2 += __shfl_xor(s2, 4); s3 += __shfl_xor(s3, 4);
    if (part == 0) { den[t] = s2; nq[t] = s3; } }
  f32x16 a1, a2;
  { const int tb = wave >> 2, vb = wave & 3;
#pragma unroll
    for (int r = 0; r < 16; ++r) { a1[r] = 0.f; a2[r] = 0.f; }
#pragma unroll
    for (int k0 = 0; k0 < 64; k0 += 16) { const bf16x8 a = *(const bf16x8*)(At + (tb * 32 + r32) * 72 + k0 + 8 * hi), bv = *(const bf16x8*)(vT + (vb * 32 + r32) * 72 + k0 + 8 * hi);
      a1 = __builtin_amdgcn_mfma_f32_32x32x16_bf16(a, bv, a1, 0, 0, 0); }
#pragma unroll
    for (int k0 = 0; k0 < 128; k0 += 16) { const bf16x8 a = *(const bf16x8*)(qs + (tb * 32 + r32) * 136 + k0 + 8 * hi), bc = *(const bf16x8*)(Cs + (vb * 32 + r32) * 136 + k0 + 8 * hi);
      a2 = __builtin_amdgcn_mfma_f32_32x32x16_bf16(a, bc, a2, 0, 0, 0); } }
  __syncthreads();
  { const int tb = wave >> 2, vb = wave & 3;
#pragma unroll
    for (int r = 0; r < 16; ++r) { const int t = tb * 32 + crow(r, hi); const float wi = wint[t]; const float dn = den[t] + wi * nq[t];
      Hs[t * 128 + vb * 32 + r32] = (a1[r] + wi * a2[r]) * __builtin_amdgcn_rcpf(fmaxf(fabsf(dn), __expf(-mt[t]))); } }
  __syncthreads();
#pragma unroll
  for (int i = 0; i < 8; ++i) { const int t = wave + 8 * i; const float x0 = Hs[t * 128 + lane], x1 = Hs[t * 128 + 64 + lane];
    float s1 = x0 + x1, s2 = x0 * x0 + x1 * x1;
#pragma unroll
    for (int m = 32; m >= 1; m >>= 1) { s1 += __shfl_xor(s1, m); s2 += __shfl_xor(s2, m); }
    const float mu = s1 * (1.f / 128.f); const float rstd = rsqrtf(fmaxf(s2 * (1.f / 128.f) - mu * mu, 0.f) + LN_EPS);
    const size_t ro = (r0 + t) * 512 + h * 128;
    u16* MO = dry ? (u16*)(ws + WS_END) + (ro & 0x3fffff) : MV + ro; MO[lane] = f2bf((x0 - mu) * rstd * ng0 * sg0[i]); MO[64 + lane] = f2bf((x1 - mu) * rstd * ng1 * sg1[i]); }
  __syncthreads();
}

__device__ __forceinline__ void state_scan_phase(const Params& p, int tid) {
  unsigned char* ws = p.ws; const float* WST = (const float*)(ws + WS_MST) + 2048;
  for (int u = blockIdx.x; u < 130; u += gridDim.x) {
    const int gi = u * NTHR + tid;
    if (gi < 65536) { const int sq = gi >> 13, e2 = gi & 8191; unsigned* U = (unsigned*)((u16*)(p.out + O_YP) + (size_t)sq * 256 * 16384) + e2; const float* w = WST + sq * 256; float C0 = 0.f, C1 = 0.f;
      for (int c0 = 0; c0 < 256; c0 += 16) { unsigned tmp[16];
#pragma unroll
        for (int i = 0; i < 16; ++i) tmp[i] = U[(size_t)(c0 + i) * 8192];
#pragma unroll
        for (int i = 0; i < 16; ++i) { U[(size_t)(c0 + i) * 8192] = pk2(C0, C1); const float wc = w[c0 + i]; C0 = wc * C0 + __uint_as_float(tmp[i] << 16); C1 = wc * C1 + __uint_as_float(tmp[i] & 0xffff0000u); } }
      p.out[O_CP + 2 * gi] = C0; p.out[O_CP + 2 * gi + 1] = C1; }
    else if (gi < 65536 + 1024) { const int g2 = gi - 65536, sq = g2 >> 7, e = g2 & 127; float* U = (float*)(ws + WS_UN) + (size_t)sq * 256 * 128 + e; const float* w = WST + sq * 256; float C = 0.f;
      for (int c0 = 0; c0 < 256; c0 += 16) { float tmp[16];
#pragma unroll
        for (int i = 0; i < 16; ++i) tmp[i] = U[(size_t)(c0 + i) * 128];
#pragma unroll
        for (int i = 0; i < 16; ++i) { U[(size_t)(c0 + i) * 128] = C; C = w[c0 + i] * C + tmp[i]; } }
      p.out[O_NP + g2] = C; }
  }
}

#define PH_SWITCH(k) do { if ((k) > 0 && ((PROBE_MASK >> ((k) > 0 ? (k) - 1 : 0)) & 1)) { const unsigned long long t1_ = __builtin_amdgcn_s_memrealtime(); const unsigned long long dt_ = t1_ - tph; \
      while (__builtin_amdgcn_s_memrealtime() - t1_ < dt_) __builtin_amdgcn_s_sleep(8); } \
    if ((PROBE_MASK >> (k)) & 1) tph = __builtin_amdgcn_s_memrealtime(); } while (0)
__global__ void __launch_bounds__(NTHR, 2) fwd_kernel(Params p) {
  extern __shared__ __attribute__((aligned(16))) unsigned char lds[];
  cg::grid_group grid = cg::this_grid();
#define OTID() ({ int t_ = threadIdx.x; asm volatile("" : "+v"(t_)); t_; })
  int tid = OTID(); unsigned char* ws = p.ws;
  int* ctl = (int*)(ws + WS_CTL); int* s_u = (int*)(lds + MISC_OFF);
  float* X = (float*)(ws + WS_X); u16* H = (u16*)(ws + WS_H); u16* ACT = (u16*)(ws + WS_ACT); const float* mod = (const float*)(ws + WS_MOD);
  unsigned long long tph = 0; (void)tph;
  volatile LAS unsigned* st = (volatile LAS unsigned*)(lds + MISC_OFF + 16);
  if (tid == 0) { st[0] = 0u; st[1] = 0u; }
  __syncthreads();
  PH_SWITCH(0);
  prep_phase(p, lds, tid);
  grid.sync(); tid = OTID();
  XcdBarrier xbar = xcd_barrier_post((unsigned*)(ws + WS_CTL) + 4096, st);
#if PROBE == 3
  prep_phase(p, lds, tid); xcd_barrier(xbar); tid = OTID();
  for (int i = 0; i < 16; ++i) xcd_barrier(xbar);
  row_phase<0>(p, 0, 0, 1024); xcd_barrier(xbar); tid = OTID();
#endif
  PH_SWITCH(1);
  row_phase<0>(p, 0, 0, 1024);
  xcd_barrier(xbar); tid = OTID();
  PH_SWITCH(2);
  { EpiGU E; E.ACT = ACT; run_gemm(lds, H, (const u16*)(ws + WS_WGU1), GU_SPLIT ? TP : T, 2 * FF, D, E);
    if (GU_SPLIT) { EpiSlice EZ; EZ.B = p.out + O_YP + O_Z; EZ.ldb = 2 * FF; run_gemm_split(lds, H, (const u16*)(ws + WS_WGU1), D, EZ, 0, 2 * FF); } }
  xcd_barrier(xbar); tid = OTID();
#if PROBE == 4
  { EpiGU E; E.ACT = ACT; run_gemm(lds, H, (const u16*)(ws + WS_WGU1), T, 2 * FF, D, E); }
  xcd_barrier(xbar); tid = OTID();
#endif
  PH_SWITCH(3);
  { EpiRes<false> E; E.xp = p.in[0]; E.st = nullptr; E.lg = nullptr; E.lb = nullptr; E.XB = (u16*)(ws + WS_X); E.gate = mod + 2048; E.gs = 0.5f; run_gemm(lds, ACT, (const u16*)(ws + WS_WD1), TP, D, FF, E);
    if (GU_SPLIT && blockIdx.x < 44) gu_finish(p.out + O_YP + O_Z, ACT, (int)blockIdx.x >> 2, tid);
    EpiResSlice EA; EA.B = (float*)(ws + WS_PB); EA.ldb = D; EA.gs = E.gs; EA.gate = E.gate; run_gemm_split(lds, ACT, (const u16*)(ws + WS_WD1), FF, EA); }
  xcd_barrier(xbar); tid = OTID();
  PH_SWITCH(4);
  row_phase<1, 11>(p, 0, 3072, 4096);
  xcd_barrier(xbar); tid = OTID();
  PH_SWITCH(5);
  { EpiIn E; E.AQ = (u16*)(ws + WS_AQ); E.AK = (u16*)(ws + WS_AK); E.AV = (u16*)(ws + WS_AV); E.PRE = (u16*)(ws + WS_PRE); E.MV = (u16*)(ws + WS_MV); E.SIGO = (u16*)(ws + WS_SIGO);
    E.MI = (float*)(ws + WS_MI); E.MLF = (float*)(ws + WS_MLF); E.bias = (const float*)(ws + WS_BIN); E.out = p.out; run_gemm(lds, H, (const u16*)(ws + WS_WIN), T, 3840, D, E); }
  xcd_barrier(xbar); tid = OTID();
#if PROBE == 5
  { EpiIn E; E.AQ = (u16*)(ws + WS_AQ); E.AK = (u16*)(ws + WS_AK); E.AV = (u16*)(ws + WS_AV); E.PRE = (u16*)(ws + WS_PRE); E.MV = (u16*)(ws + WS_MV); E.SIGO = (u16*)(ws + WS_SIGO);
    E.MI = (float*)(ws + WS_MI); E.MLF = (float*)(ws + WS_MLF); E.bias = (const float*)(ws + WS_BIN); E.out = p.out; run_gemm(lds, H, (const u16*)(ws + WS_WIN), T, 3840, D, E); }
  xcd_barrier(xbar); tid = OTID();
#endif
  PH_SWITCH(6);
  scan_phase(p, lds, tid);
  xcd_barrier(xbar); tid = OTID();
#if PROBE == 1
  for (;;) { __syncthreads(); if (tid == 0) *s_u = atomicAdd(&ctl[3], 1); __syncthreads(); const int u = *s_u; if (u >= 128 + 1024) break; asm volatile("" : "+v"(tid));
    if (u < 128) attn_sample_unit(p, u >> 3, u & 7, lds, tid, 1);
    else { const int v = u - 128; attn_prompt_unit(p, (v & 15) >> 3, v & 7, 63 - (v >> 4), lds, tid, 1); } }
  xcd_barrier(xbar); tid = OTID();
#endif
#if PROBE == 3
  scan_phase(p, lds, tid); xcd_barrier(xbar); tid = OTID();
#endif
  PH_SWITCH(7);
  for (;;) { __syncthreads(); if (tid == 0) *s_u = atomicAdd(&ctl[0], 1); __syncthreads(); const int u = *s_u; if (u >= 64 + 128 + 1024 + 2048) break; asm volatile("" : "+v"(tid));
    if (u < 64) mlstm_unit<16, 2>(p, u >> 2, u & 3, 0, lds, tid);
    else if (u < 192) { const int v = u - 64; attn_sample_unit(p, v >> 3, v & 7, lds, tid); }
    else if (u < 1216) { const int v = u - 192; attn_prompt_unit(p, (v & 15) >> 3, v & 7, 63 - (v >> 4), lds, tid); }
    else { const int v = u - 1216; mlstm_h1_unit(p, v >> 10, (v >> 8) & 3, v & 255, lds, tid); } }
  xcd_barrier(xbar); tid = OTID();
  PH_SWITCH(8);
  PH_SWITCH(9);
  state_scan_phase(p, tid);
  xcd_barrier(xbar); tid = OTID();
#if PROBE == 2
  for (;;) { __syncthreads(); if (tid == 0) *s_u = atomicAdd(&ctl[4], 1); __syncthreads(); const int u = *s_u; if (u >= 2048) break; asm volatile("" : "+v"(tid));
    mlstm_h3_unit(p, u >> 10, (u >> 8) & 3, u & 255, lds, tid, 1); }
  xcd_barrier(xbar); tid = OTID();
#endif
  PH_SWITCH(10);
  for (int u = blockIdx.x; u < 2048; u += gridDim.x) { asm volatile("" : "+v"(tid));
    mlstm_h3_unit(p, u >> 10, (u >> 8) & 3, u & 255, lds, tid); }
  xcd_barrier(xbar); tid = OTID();
  PH_SWITCH(11);
  { const float* bias = (const float*)(ws + WS_BIN); u16* GA = (u16*)(ws + WS_GA); u16* GB = (u16*)(ws + WS_GB); const u16* WIN = (const u16*)(ws + WS_WIN); float* MB4 = (float*)(ws + WS_END);
    { EpiMerge<0> E; E.O = GA; E.Aa = nullptr; E.bias = bias + 3840; run_gemm(lds, H, WIN + (size_t)3840 * D, TP, D, D, E); }
    { EpiMerge<1> E; E.O = GA; E.Aa = nullptr; E.bias = nullptr; run_gemm(lds, (const u16*)(ws + WS_AQ), (const u16*)(ws + WS_WBA), TP, D, 512, E); }
    { EpiMerge<0> E; E.O = GB; E.Aa = nullptr; E.bias = bias + 4864; run_gemm(lds, H, WIN + (size_t)4864 * D, TP, D, D, E); }
    { EpiMerge<2> E; E.O = GB; E.Aa = GA; E.bias = nullptr; run_gemm(lds, (const u16*)(ws + WS_MV), (const u16*)(ws + WS_WBB), TP, D, 512, E); }
    { EpiSlice E; E.ldb = D; E.B = MB4; run_gemm_split(lds, H, WIN + (size_t)3840 * D, D, E, 0); }
    { EpiSlice E; E.ldb = D; E.B = MB4 + 4 * 262144; run_gemm_split(lds, (const u16*)(ws + WS_AQ), (const u16*)(ws + WS_WBA), 512, E, 16); }
    { EpiSlice E; E.ldb = D; E.B = MB4 + 6 * 262144; run_gemm_split(lds, H, WIN + (size_t)4864 * D, D, E, 24); }
    { EpiSlice E; E.ldb = D; E.B = MB4 + 10 * 262144; run_gemm_split(lds, (const u16*)(ws + WS_MV), (const u16*)(ws + WS_WBB), 512, E, 40); } }
  xcd_barrier(xbar); tid = OTID();
  { const float* bias = (const float*)(ws + WS_BIN); const float* MB4 = (const float*)(ws + WS_END); u16* GB = (u16*)(ws + WS_GB);
    const int idx = ((int)blockIdx.x * NTHR + tid) * 2, c = idx & 1023;
    float r[2];
#pragma unroll
    for (int j = 0; j < 2; ++j) { const float* q = MB4 + idx + j; const float a1 = q[0] + q[262144] + q[2 * 262144] + q[3 * 262144], a2 = q[4 * 262144] + q[5 * 262144],
        a3 = q[6 * 262144] + q[7 * 262144] + q[8 * 262144] + q[9 * 262144], a4 = q[10 * 262144] + q[11 * 262144];
      r[j] = sigm(a1 + bias[3840 + c + j]) * a2 + sigm(a3 + bias[4864 + c + j]) * a4; }
    if (idx < 262144) *(unsigned*)(GB + (size_t)TP * D + idx) = pk2(r[0], r[1]); }
  xcd_barrier(xbar); tid = OTID();
#if PROBE == 5
  { const float* bias = (const float*)(ws + WS_BIN); u16* GA = (u16*)(ws + WS_GA); u16* GB = (u16*)(ws + WS_GB); const u16* WIN = (const u16*)(ws + WS_WIN);
    { EpiMerge<0> E; E.O = GA; E.Aa = nullptr; E.bias = bias + 3840; run_gemm(lds, H, WIN + (size_t)3840 * D, T, D, D, E); }
    { EpiMerge<1> E; E.O = GA; E.Aa = nullptr; E.bias = nullptr; run_gemm(lds, (const u16*)(ws + WS_AQ), (const u16*)(ws + WS_WBA), T, D, 512, E); }
    { EpiMerge<0> E; E.O = GB; E.Aa = nullptr; E.bias = bias + 4864; run_gemm(lds, H, WIN + (size_t)4864 * D, T, D, D, E); }
    { EpiMerge<2> E; E.O = GB; E.Aa = GA; E.bias = nullptr; run_gemm(lds, (const u16*)(ws + WS_MV), (const u16*)(ws + WS_WBB), T, D, 512, E); } }
  xcd_barrier(xbar); tid = OTID();
#endif
  PH_SWITCH(12);
  { EpiRes<true> E; E.xp = nullptr; E.st = (const float*)(ws + WS_ST); E.lg = p.in[25]; E.lb = p.in[26]; E.XB = (u16*)(ws + WS_X); E.gate = mod + 5120; E.gs = 1.0f; run_gemm(lds, (const u16*)(ws + WS_GB), (const u16*)(ws + WS_WOUT), TP, D, D, E);
    EpiResSlice EA; EA.B = (float*)(ws + WS_PB); EA.ldb = D; EA.gs = E.gs; EA.gate = E.gate; run_gemm_split(lds, (const u16*)(ws + WS_GB), (const u16*)(ws + WS_WOUT), D, EA); }
  xcd_barrier(xbar); tid = OTID();
  PH_SWITCH(13);
  row_phase<1, 4>(p, 1, 6144, 7168);
  xcd_barrier(xbar); tid = OTID();
  PH_SWITCH(14);
  { EpiGU E; E.ACT = ACT; run_gemm(lds, H, (const u16*)(ws + WS_WGU2), GU_SPLIT ? TP : T, 2 * FF, D, E);
    if (GU_SPLIT) { EpiSlice EZ; EZ.B = p.out + O_YP + O_Z; EZ.ldb = 2 * FF; run_gemm_split(lds, H, (const u16*)(ws + WS_WGU2), D, EZ, 0, 2 * FF); } }
  xcd_barrier(xbar); tid = OTID();
  PH_SWITCH(15);
  { EpiRes<true> E; E.xp = nullptr; E.st = (const float*)(ws + WS_ST) + 2 * TP; E.lg = p.in[25] + D; E.lb = p.in[26] + D; E.XB = (u16*)(ws + WS_X); E.gate = mod + 8192; E.gs = 0.5f; run_gemm(lds, ACT, (const u16*)(ws + WS_WD2), TP, D, FF, E);
    if (GU_SPLIT && blockIdx.x < 44) gu_finish(p.out + O_YP + O_Z, ACT, (int)blockIdx.x >> 2, tid);
    EpiResSlice EA; EA.B = (float*)(ws + WS_PB); EA.ldb = D; EA.gs = E.gs; EA.gate = E.gate; run_gemm_split(lds, ACT, (const u16*)(ws + WS_WD2), FF, EA); }
  xcd_barrier(xbar); tid = OTID();
  PH_SWITCH(16);
  row_phase<2, 11>(p, 2, 0, 0);
  PH_SWITCH(17);
}

extern "C" void kernel_launch(void* const* d_in, const int* in_sizes, int n_in, void* d_out, int out_size, void* d_ws, size_t ws_size, hipStream_t stream) {
  static int grid = 0;
  if (grid == 0) {
    if (n_in != 27 || ws_size < WS_PB + 12 * MiB) { fprintf(stderr, "kernel_launch: unexpected n_in %d / ws_size %zu (need %zu)\n", n_in, ws_size, (size_t)WS_END); grid = -1; return; }
    int dev = 0, cus = 0, per_cu = 0;
    hipGetDevice(&dev); hipDeviceGetAttribute(&cus, hipDeviceAttributeMultiprocessorCount, dev);
    if (hipFuncSetAttribute((const void*)fwd_kernel, hipFuncAttributeMaxDynamicSharedMemorySize, LDS_BYTES) != hipSuccess) { fprintf(stderr, "kernel_launch: hipFuncSetAttribute failed\n"); grid = -1; return; }
    if (hipOccupancyMaxActiveBlocksPerMultiprocessor(&per_cu, (const void*)fwd_kernel, NTHR, LDS_BYTES) != hipSuccess || per_cu < 1) { fprintf(stderr, "kernel_launch: occupancy query says %d\n", per_cu); per_cu = 1; }
    (void)hipGetLastError();
    grid = cus * 1;
  }
  if (grid < 0) return;
  Params p{};
  for (int i = 0; i < 27; ++i) p.in[i] = (const float*)d_in[i];
  p.out = (float*)d_out; p.ws = (unsigned char*)d_ws;
  void* args[] = {&p};
  hipError_t e = hipLaunchCooperativeKernel((const void*)fwd_kernel, dim3(grid), dim3(NTHR), args, LDS_BYTES, stream);
  if (e != hipSuccess) fprintf(stderr, "cooperative launch failed: %s (grid %d)\n", hipGetErrorString(e), grid);
}
```

```cpp
#include <hip/hip_runtime.h>
#include <hip/hip_cooperative_groups.h>
#include <cstdio>
#include <cstdint>
#include <type_traits>
namespace cg = cooperative_groups;
namespace pg8 {
#define PG8_LAS __attribute__((address_space(3)))
typedef unsigned short bf16_t;
typedef short bf16x8 __attribute__((ext_vector_type(8)));
typedef float f32x4 __attribute__((ext_vector_type(4)));
typedef unsigned u32x4 __attribute__((ext_vector_type(4)));
constexpr int BM = 256, BK = 64, HALF = 128, HTB = HALF * BK * 2  , STAGE_BYTES = 8 * HTB, NXCD = 8, WGM = 4;

__host__ __device__ __forceinline__ int lds_byte(int r, int c) { const int st = (r >> 4) * 2 + (c >> 5), rr = r & 15, cc = c & 31, ob = rr * 64 + cc * 2; return st * 1024 + (ob ^ (((ob >> 9) & 1) << 5)); }
__host__ __device__ __forceinline__ void stage_rc(int b, int& R, int& C) { const int st = b / 1024, sb = b % 1024, swz = sb ^ (((sb >> 9) & 1) << 5); R = (st >> 1) * 16 + swz / 64; C = (st & 1) * 32 + (swz % 64) / 2; }
__host__ __device__ __forceinline__ int perm32(int rho) { const int n = rho >> 4, i = rho & 15; return 8 * (i >> 2) + 4 * n + (i & 3); }

struct Unit { int pm, pn; };
struct Gemm { const bf16_t* A; const bf16_t* Bt; int M, N, K, ld; };

struct StaticOrder {
    int nM, nN, nwg, G, c;
    __host__ __device__ void init(int M, int N, int G_, int c_) { nM = M / BM; nN = N / BM; nwg = nM * nN; G = G_; c = c_; }
    __host__ __device__ bool next(int i, Unit& u) const {
        const long L = (long)i * G + c; if (L >= nwg) return false;
        int wgid = (int)L; { const int q = nwg / NXCD, r = nwg % NXCD, xcd = wgid % NXCD, off = wgid / NXCD; wgid = (xcd < r ? xcd * (q + 1) : r * (q + 1) + (xcd - r) * q) + off; }
        const int nig = WGM * nN, gid = wgid / nig, fm = gid * WGM, gsz = (nM - fm) < WGM ? (nM - fm) : WGM;
        u.pm = fm + ((wgid % nig) % gsz); u.pn = (wgid % nig) / gsz; return true;
    }
    __device__ __forceinline__ void a_ready(const Unit&) const {}
    __device__ __forceinline__ void done(const Unit&) const {}
};

__device__ __forceinline__ unsigned cvt_pk_bf16(float lo, float hi) { unsigned r; asm volatile("v_cvt_pk_bf16_f32 %0, %1, %2" : "=v"(r) : "v"(lo), "v"(hi)); return r; }
template <class Epi, class Sched, bool ALIGN_EPI = false, bool SP2 = false>
__device__ __forceinline__ void gemm_phase(PG8_LAS unsigned char* lds, const Gemm g, const Sched& S, const Epi& E) {
    int tid_ = threadIdx.x; asm volatile("" : "+v"(tid_));
    const int tid = tid_, wid = __builtin_amdgcn_readfirstlane(tid >> 6), lane = tid & 63, wr = wid >> 2, wc = wid & 3, fr = lane & 15, fq = lane >> 4;
    const int K = g.K, nt = K / BK;
    unsigned voffA[2], voffB[2];
#pragma unroll
    for (int i = 0; i < 2; ++i) { int R, C; stage_rc(tid * 16 + i * 8192, R, C); const int Rb = Epi::PERM ? ((R & ~31) + perm32(R & 31)) : R;
        voffA[i] = (unsigned)(R * g.ld + C) * 2u; voffB[i] = (unsigned)(Rb * g.ld + C) * 2u; }
    const size_t kstep = (size_t)(BK * 2);
    const size_t hstep = (size_t)HALF * g.ld * 2;
    const size_t tstep = 2 * hstep;
    const unsigned ldsw = (unsigned)wid * 1024u;
    const int aoff = lds_byte(wr * 64 + fr, fq * 8), boff = lds_byte(wc * 32 + fr, fq * 8);
#define PG8_SA(b, h) (((b) * 2 + (h)) * HTB)
#define PG8_SB(b, h) ((4 + (b) * 2 + (h)) * HTB)
#define PG8_STAGE(bufoff, gbase, voff) do { _Pragma("unroll") for (int _i = 0; _i < 2; ++_i) \
        __builtin_amdgcn_global_load_lds((const unsigned*)((const char*)(gbase) + (voff)[_i]), (PG8_LAS unsigned*)(lds + (bufoff) + ldsw + _i * 8192), 16, 0, 0); } while (0)
#define PG8_LDA(dst, b, h) do { _Pragma("unroll") for (int m = 0; m < 4; ++m) _Pragma("unroll") for (int k = 0; k < 2; ++k) dst[m][k] = *(const PG8_LAS bf16x8*)(lds + PG8_SA(b, h) + aoff + m * 2048 + k * 1024); } while (0)
#define PG8_LDB(dst, b, h) do { _Pragma("unroll") for (int n = 0; n < 2; ++n) _Pragma("unroll") for (int k = 0; k < 2; ++k) dst[n][k] = *(const PG8_LAS bf16x8*)(lds + PG8_SB(b, h) + boff + n * 2048 + k * 1024); } while (0)
#define PG8_MMA(ai, bj, At, Bt) do { __builtin_amdgcn_s_setprio(1); _Pragma("unroll") for (int m = 0; m < 4; ++m) _Pragma("unroll") for (int n = 0; n < 2; ++n) _Pragma("unroll") for (int k = 0; k < 2; ++k) \
        acc[ai][bj][m][n] = __builtin_amdgcn_mfma_f32_16x16x32_bf16(Bt[n][k], At[m][k], acc[ai][bj][m][n], 0, 0, 0); __builtin_amdgcn_s_setprio(0); } while (0)
#define PG8_WAIT_V(n) asm volatile("s_waitcnt vmcnt(" #n ")" ::: "memory")
#define PG8_WAIT_L(n) asm volatile("s_waitcnt lgkmcnt(" #n ")" ::: "memory")
#define PG8_BAR __builtin_amdgcn_s_barrier()
#define PG8_SCHED __builtin_amdgcn_sched_barrier(0)
    Unit cur, nxt; int ui = 0;
    if (!S.next(0, cur)) return;
    f32x4 acc[2][2][4][2];
#pragma unroll
    for (int a = 0; a < 2; ++a)
#pragma unroll
        for (int b = 0; b < 2; ++b)
#pragma unroll
            for (int m = 0; m < 4; ++m)
#pragma unroll
                for (int n = 0; n < 2; ++n) acc[a][b][m][n] = (f32x4){0.f, 0.f, 0.f, 0.f};
    bf16x8 At[4][2], B0[2][2], B1[2][2];
    const char* cA = (const char*)g.A + (size_t)cur.pm * tstep; const char* cB = (const char*)g.Bt + (size_t)cur.pn * tstep;
    S.a_ready(cur);
    if constexpr (SP2) {
        PG8_STAGE(PG8_SB(0, 0), cB, voffB); PG8_STAGE(PG8_SB(0, 1), cB + hstep, voffB); PG8_STAGE(PG8_SA(0, 0), cA, voffA); PG8_STAGE(PG8_SA(0, 1), cA + hstep, voffA);
        if (wr == 1) PG8_BAR;
        PG8_WAIT_V(2); PG8_BAR;
        PG8_STAGE(PG8_SB(1, 0), cB + kstep, voffB); PG8_STAGE(PG8_SA(1, 0), cA + kstep, voffA); PG8_STAGE(PG8_SB(1, 1), cB + hstep + kstep, voffB);
        PG8_WAIT_V(6); PG8_BAR;
    } else {
        PG8_STAGE(PG8_SB(0, 0), cB, voffB); PG8_STAGE(PG8_SA(0, 0), cA, voffA); PG8_STAGE(PG8_SB(0, 1), cB + hstep, voffB); PG8_STAGE(PG8_SA(0, 1), cA + hstep, voffA);
        if (wr == 1) PG8_BAR;
        PG8_WAIT_V(4); PG8_BAR;
        PG8_STAGE(PG8_SB(1, 0), cB + kstep, voffB); PG8_STAGE(PG8_SA(1, 0), cA + kstep, voffA); PG8_STAGE(PG8_SB(1, 1), cB + hstep + kstep, voffB);
        PG8_WAIT_V(6); PG8_BAR;
    }
    for (;;) {
        const bool has_next = S.next(ui + 1, nxt);
        const char* nA = has_next ? (const char*)g.A + (size_t)nxt.pm * tstep : cA; const char* nB = has_next ? (const char*)g.Bt + (size_t)nxt.pn * tstep : cB;
        for (int t = 0; t < nt; t += 2) {
            const bool last = (t == nt - 2);
            const char* a1 = cA + (size_t)(t + 1) * kstep;
            const char* a2 = last ? nA : cA + (size_t)(t + 2) * kstep; const char* b2 = last ? nB : cB + (size_t)(t + 2) * kstep;
            const char* a3 = a2 + kstep; const char* b3 = b2 + kstep;
            if (last && has_next) S.a_ready(nxt);
            if constexpr (SP2) {
            PG8_LDB(B0, 0, 0); PG8_LDB(B1, 0, 1); PG8_SCHED; PG8_LDA(At, 0, 0); PG8_STAGE(PG8_SA(1, 1), a1 + hstep, voffA);
            PG8_WAIT_V(8); PG8_WAIT_L(0); PG8_BAR; PG8_MMA(0, 0, At, B0); PG8_MMA(0, 1, At, B1); PG8_BAR; PG8_SCHED;
            PG8_LDA(At, 0, 1); PG8_STAGE(PG8_SB(0, 0), b2, voffB); PG8_STAGE(PG8_SB(0, 1), b2 + hstep, voffB); PG8_STAGE(PG8_SA(0, 0), a2, voffA);
            PG8_WAIT_V(8); PG8_WAIT_L(0); PG8_BAR; PG8_MMA(1, 0, At, B0); PG8_MMA(1, 1, At, B1); PG8_BAR; PG8_SCHED;
            PG8_LDB(B0, 1, 0); PG8_LDB(B1, 1, 1); PG8_SCHED; PG8_LDA(At, 1, 0); PG8_STAGE(PG8_SA(0, 1), a2 + hstep, voffA);
            PG8_WAIT_V(8); PG8_WAIT_L(0); PG8_BAR; PG8_MMA(0, 0, At, B0); PG8_MMA(0, 1, At, B1); PG8_BAR; PG8_SCHED;
            PG8_LDA(At, 1, 1); PG8_STAGE(PG8_SB(1, 0), b3, voffB); PG8_STAGE(PG8_SB(1, 1), b3 + hstep, voffB); PG8_STAGE(PG8_SA(1, 0), a3, voffA);
            PG8_WAIT_V(8); PG8_WAIT_L(0); PG8_BAR; PG8_MMA(1, 0, At, B0); PG8_MMA(1, 1, At, B1); PG8_BAR; PG8_SCHED;
            } else {
            PG8_LDB(B0, 0, 0); PG8_SCHED; PG8_LDA(At, 0, 0); PG8_STAGE(PG8_SA(1, 1), a1 + hstep, voffA);
            PG8_WAIT_L(8); PG8_BAR; PG8_WAIT_L(0); PG8_MMA(0, 0, At, B0); PG8_BAR; PG8_SCHED;
            PG8_LDB(B1, 0, 1); PG8_STAGE(PG8_SB(0, 0), b2, voffB);
            PG8_BAR; PG8_WAIT_L(0); PG8_MMA(0, 1, At, B1); PG8_BAR;
            PG8_LDA(At, 0, 1); PG8_STAGE(PG8_SA(0, 0), a2, voffA);
            PG8_BAR; PG8_WAIT_L(0); PG8_MMA(1, 0, At, B0); PG8_BAR; PG8_SCHED;
            PG8_STAGE(PG8_SB(0, 1), b2 + hstep, voffB);
            PG8_WAIT_V(6); PG8_BAR; PG8_MMA(1, 1, At, B1); PG8_BAR;
            PG8_LDB(B0, 1, 0); PG8_SCHED; PG8_LDA(At, 1, 0); PG8_STAGE(PG8_SA(0, 1), a2 + hstep, voffA);
            PG8_WAIT_L(8); PG8_BAR; PG8_WAIT_L(0); PG8_MMA(0, 0, At, B0); PG8_BAR; PG8_SCHED;
            PG8_LDB(B1, 1, 1); PG8_STAGE(PG8_SB(1, 0), b3, voffB);
            PG8_BAR; PG8_WAIT_L(0); PG8_MMA(0, 1, At, B1); PG8_BAR;
            PG8_LDA(At, 1, 1); PG8_STAGE(PG8_SA(1, 0), a3, voffA);
            PG8_BAR; PG8_WAIT_L(0); PG8_MMA(1, 0, At, B0); PG8_BAR; PG8_SCHED;
            PG8_STAGE(PG8_SB(1, 1), b3 + hstep, voffB);
            PG8_WAIT_V(6); PG8_BAR; PG8_MMA(1, 1, At, B1); PG8_BAR;
            }
        }
        if constexpr (ALIGN_EPI) { if (wr == 0) PG8_BAR; }
        if constexpr (!Epi::AFTER_DRAIN) { E(acc, cur, wr, wc, fr, fq); S.done(cur); }
        if (!has_next) break;
#pragma unroll
        for (int a = 0; a < 2; ++a)
#pragma unroll
            for (int b = 0; b < 2; ++b)
#pragma unroll
                for (int m = 0; m < 4; ++m)
#pragma unroll
                    for (int n = 0; n < 2; ++n) acc[a][b][m][n] = (f32x4){0.f, 0.f, 0.f, 0.f};
        cur = nxt; cA = nA; cB = nB; ++ui;
        if constexpr (ALIGN_EPI) { if (wr == 1) PG8_BAR; }
    }
    PG8_WAIT_V(0);
    if constexpr (!ALIGN_EPI) { if (wr == 0) PG8_BAR; }
    PG8_BAR;
    if constexpr (Epi::AFTER_DRAIN) { E.fused(acc, cur, wr, wc, fr, fq, lds, wid, lane); S.done(cur); }
#undef PG8_SA
#undef PG8_SB
#undef PG8_STAGE
#undef PG8_LDA
#undef PG8_LDB
#undef PG8_MMA
#undef PG8_WAIT_V
#undef PG8_WAIT_L
#undef PG8_BAR
#undef PG8_SCHED
}
}
typedef unsigned short u16;
using pg8::f32x4; using pg8::u32x4; using pg8::bf16x8;
typedef float f32x16 __attribute__((ext_vector_type(16)));

constexpr int TP = 32768, TS = 256, T = TP + TS, D = 1024, FF = 2816, SEQ = 16384, PAST = 2048;
constexpr float ALPHA = 1.189207115002721f, LN_EPS = 1e-5f, LOG2E = 1.4426950408889634f, C2 = 0.125f * LOG2E;
constexpr int NTHR = 512, LDS_BYTES = 148480, MISC_OFF = 147712;
#ifndef PROBE
#define PROBE 0
#endif
#ifndef GEMM_SP2
#define GEMM_SP2 true
#endif
#ifndef GEMM_ALIGN
#define GEMM_ALIGN true
#endif
#ifndef PROBE_MASK
#define PROBE_MASK 0
#endif
#ifndef GU_SPLIT
#define GU_SPLIT 0
#endif
#ifndef PRUNE
#define PRUNE 1
#endif
constexpr float PRUNE_TH = 32.f;

constexpr size_t O_YP = 0, O_YS = 33554432, O_KP = 33816576, O_VP = 50593792, O_LFP = 67371008, O_CP = 67633152, O_NP = 67764224, O_MP = 67765248,
                 O_CONVP = 67765256, O_KS = 67771400, O_VS = 67902472, O_LFS = 68033544, O_CS = 68035592, O_NS = 69084168, O_MS = 69092360, O_CONVS = 69092424;
constexpr size_t MiB = 1u << 20;
constexpr size_t WS_CTL = 0, WS_ST = 65536  , WS_MOD = 1 * MiB, WS_BIN = 2 * MiB;
constexpr size_t WS_F2 = 3 * MiB;
constexpr size_t WS_MI = 4 * MiB;
constexpr size_t WS_MLF = 5 * MiB;
constexpr size_t WS_MB = 6 * MiB;
constexpr size_t WS_MM = 7 * MiB;
constexpr size_t WS_UN = 8 * MiB;
constexpr size_t WS_MST = 9 * MiB;
constexpr size_t WS_WGU1 = 10 * MiB, WS_WD1 = 21 * MiB, WS_WIN = 27 * MiB, WS_WBA = 39 * MiB, WS_WBB = 40 * MiB, WS_WOUT = 41 * MiB, WS_WGU2 = 43 * MiB, WS_WD2 = 54 * MiB;
constexpr size_t WS_X = 60 * MiB  , WS_XS = 124 * MiB  , WS_H = 189 * MiB, WS_ACT = 254 * MiB;
constexpr size_t QSZ = (size_t)T * 512 * 2;
constexpr size_t WS_AQ = WS_ACT, WS_AK = WS_AQ + QSZ, WS_AV = WS_AK + QSZ, WS_PRE = WS_AV + QSZ;
constexpr size_t WS_GA = WS_PRE, WS_GB = WS_AK;
constexpr size_t O_Z = 16777216;
constexpr size_t WS_MV = 432 * MiB, WS_SIGO = WS_MV + QSZ, WS_END = WS_SIGO + QSZ;
constexpr size_t WS_PB = WS_END;
static_assert(WS_PRE + 2 * QSZ <= WS_ACT + (size_t)T * FF * 2 + 16 * MiB && WS_ACT + (size_t)T * FF * 2 <= WS_MV && WS_END <= 512 * MiB, "ws map");

struct Params { const float* in[27]; float* out; unsigned char* ws; };

__device__ __forceinline__ float bf2f(u16 b) { return __uint_as_float(((unsigned)b) << 16); }
typedef float f32x2_t __attribute__((ext_vector_type(2))); typedef __bf16 bf16x2_t __attribute__((ext_vector_type(2)));
__device__ __forceinline__ unsigned pk2(float lo, float hi) { f32x2_t v = {lo, hi}; bf16x2_t b = __builtin_convertvector(v, bf16x2_t); return __builtin_bit_cast(unsigned, b); }
__device__ __forceinline__ u16 f2bf(float f) { return (u16)(pk2(f, 0.f) & 0xffffu); }
__device__ __forceinline__ float sigm(float x) { return __builtin_amdgcn_rcpf(1.f + __expf(-x)); }
__device__ __forceinline__ float siluf(float x) { return x * __builtin_amdgcn_rcpf(1.f + __expf(-x)); }
__device__ __forceinline__ float logsig(float x) { return fminf(x, 0.f) - log1pf(__expf(-fabsf(x))); }
__device__ __forceinline__ int modrow(int t) { return t < TP ? (t >> 14) : 2 + ((t - TP) >> 4); }
__device__ __forceinline__ float wsum(float v) { for (int m = 32; m >= 1; m >>= 1) v += __shfl_xor(v, m); return v; }
__device__ __forceinline__ float wmax(float v) { for (int m = 32; m >= 1; m >>= 1) v = fmaxf(v, __shfl_xor(v, m)); return v; }
__device__ __forceinline__ int crow(int r, int hi) { return (r & 3) + 8 * (r >> 2) + 4 * hi; }

#define LAS __attribute__((address_space(3)))
#define XB_TMO      128
#define XB_XCNT(j)  (256  + 64 * (j))
#define XB_XSUB(j)  (1280 + 64 * (j))
#define XB_XGEN(j)  (2304 + 64 * (j))
#define XB_TOP      3328
#define XB_TOPGEN   3392
#define XCD_BAR_WORDS 3456
#define XB_SPIN_CAP (1u << 18)
__device__ __forceinline__ unsigned xb_ld(unsigned* p)              { return __hip_atomic_load(p, __ATOMIC_RELAXED, __HIP_MEMORY_SCOPE_AGENT); }
__device__ __forceinline__ unsigned xb_add(unsigned* p, unsigned v) { return __hip_atomic_fetch_add(p, v, __ATOMIC_RELAXED, __HIP_MEMORY_SCOPE_AGENT); }
__device__ __forceinline__ unsigned xb_xcc_id() { return (unsigned)__builtin_amdgcn_s_getreg((3 << 11) | 20) & 0xFu; }
#define XB_SPIN(cond, bar) do { unsigned _sp = 0; while (cond) { __builtin_amdgcn_s_sleep(1); \
    if ((++_sp & 255u) == 0u) { if (xb_ld(&(bar)[XB_TMO])) break; if (_sp > XB_SPIN_CAP) { atomicAdd(&(bar)[XB_TMO], 1u); break; } } } } while (0)
struct XcdBarrier { unsigned* bar; unsigned x; volatile LAS unsigned* st; };
__device__ __forceinline__ XcdBarrier xcd_barrier_post(unsigned* bar, volatile LAS unsigned* st) {
    XcdBarrier b; b.bar = bar; b.x = xb_xcc_id(); b.st = st;
    if (threadIdx.x == 0) (void)xb_add(&bar[XB_XCNT(b.x)], 1u);
    return b;
}
__device__ __forceinline__ void xcd_barrier_complete(unsigned* bar, unsigned x, unsigned& nloc, unsigned& nx) {
    const unsigned G = gridDim.x * gridDim.y * gridDim.z;
    unsigned sum, cnt, mine, sp = 0u;
    for (;;) {
        sum = 0u; cnt = 0u; mine = 0u;
#pragma unroll
        for (unsigned j = 0; j < 16; ++j) { const unsigned c = xb_ld(&bar[XB_XCNT(j)]); sum += c; cnt += (c > 0u) ? 1u : 0u; mine = (j == x) ? c : mine; }
        if (sum == G) break;
        __builtin_amdgcn_s_sleep(1);
        if ((++sp & 255u) == 0u) { if (xb_ld(&bar[XB_TMO])) break; if (sp > XB_SPIN_CAP) { atomicAdd(&bar[XB_TMO], 1u); break; } }
    }
    nloc = mine > 0u ? mine : 1u; nx = cnt > 0u ? cnt : 1u;
}
__device__ __forceinline__ void xcd_barrier(const XcdBarrier& b) {
    asm volatile("s_waitcnt vmcnt(0)" ::: "memory");
    __syncthreads();
    if (threadIdx.x == 0) {
        unsigned* bar = b.bar;
        __builtin_amdgcn_s_waitcnt(0);
        unsigned nloc = b.st[0], nx = b.st[1];
        if (nloc == 0u) { xcd_barrier_complete(bar, b.x, nloc, nx); b.st[0] = nloc; b.st[1] = nx; }
        const unsigned old = xb_add(&bar[XB_XSUB(b.x)], 1u);
        const unsigned gen = old / nloc;
        if (old + 1u == (gen + 1u) * nloc) {
            __builtin_amdgcn_fence(__ATOMIC_RELEASE, "agent");
            asm volatile("s_waitcnt vmcnt(0)" ::: "memory");
            const unsigned og = xb_add(&bar[XB_TOP], 1u);
            const unsigned tg = og / nx;
            if (og + 1u == (tg + 1u) * nx) xb_add(&bar[XB_TOPGEN], 1u);
            else XB_SPIN(xb_ld(&bar[XB_TOPGEN]) == tg, bar);
            __builtin_amdgcn_fence(__ATOMIC_ACQUIRE, "agent");
            xb_add(&bar[XB_XGEN(b.x)], 1u);
            asm volatile("s_waitcnt vmcnt(0)" ::: "memory");
        } else {
            XB_SPIN(xb_ld(&bar[XB_XGEN(b.x)]) == gen, bar);
            __builtin_amdgcn_fence(__ATOMIC_ACQUIRE, "agent");
            asm volatile("s_waitcnt vmcnt(0)" ::: "memory");
        }
    }
    __syncthreads();
}

struct EpiGU { static constexpr bool PERM = true, AFTER_DRAIN = false; u16* ACT;
  __device__ __forceinline__ void operator()(const f32x4 (&acc)[2][2][4][2], const pg8::Unit& u, int wr, int wc, int fr, int fq) const {
    const int row0 = u.pm * 256 + wr * 64 + fr, col0 = u.pn * 128 + wc * 32 + 8 * fq;
#pragma unroll
    for (int ai = 0; ai < 2; ++ai)
#pragma unroll
      for (int m = 0; m < 4; ++m) { const size_t row = row0 + ai * 128 + m * 16;
        const f32x4 g0 = acc[ai][0][m][0], g1 = acc[ai][0][m][1], u0 = acc[ai][1][m][0], u1 = acc[ai][1][m][1];
        u32x4 o; o[0] = pk2(siluf(g0[0]) * u0[0], siluf(g0[1]) * u0[1]); o[1] = pk2(siluf(g0[2]) * u0[2], siluf(g0[3]) * u0[3]);
        o[2] = pk2(siluf(g1[0]) * u1[0], siluf(g1[1]) * u1[1]); o[3] = pk2(siluf(g1[2]) * u1[2], siluf(g1[3]) * u1[3]);
        *(u32x4*)(ACT + row * FF + col0) = o; }
  } };

template <bool LNX> struct EpiRes { static constexpr bool PERM = false, AFTER_DRAIN = false; const float* xp; u16* XB; const float* gate; const float* st; const float* lg; const float* lb; float gs; float pad_;
  __device__ __forceinline__ void operator()(const f32x4 (&acc)[2][2][4][2], const pg8::Unit& u, int wr, int wc, int fr, int fq) const {
    int fr2 = fr, fq2 = fq; asm volatile("" : "+v"(fr2), "+v"(fq2));
    const int row0 = u.pm * 256 + wr * 64 + fr2, col0 = u.pn * 256 + wc * 32 + 4 * fq2;
    const float* gr = gate + (u.pm >> 6) * 9216;
    f32x4 gv[2][2], g4[2][2], b4[2][2];
#pragma unroll
    for (int bj = 0; bj < 2; ++bj)
#pragma unroll
      for (int n = 0; n < 2; ++n) { const int c = col0 + bj * 128 + n * 16; gv[bj][n] = *(const f32x4*)(gr + c) * gs; if (LNX) { g4[bj][n] = *(const f32x4*)(lg + c); b4[bj][n] = *(const f32x4*)(lb + c); } }
#pragma unroll
    for (int ai = 0; ai < 2; ++ai)
#pragma unroll
      for (int m = 0; m < 4; ++m) { const int row = row0 + ai * 128 + m * 16; u16* o = XB + (size_t)row * D;
        float mu = 0.f, rs = 1.f; if (LNX) { mu = st[2 * (size_t)row]; rs = st[2 * (size_t)row + 1]; }
#pragma unroll
        for (int bj = 0; bj < 2; ++bj)
#pragma unroll
          for (int n = 0; n < 2; ++n) { const int c = col0 + bj * 128 + n * 16; f32x4 xv;
            if (LNX) { const uint2 r = *(const uint2*)(o + c); xv = (f32x4){__uint_as_float(r.x << 16), __uint_as_float(r.x & 0xffff0000u), __uint_as_float(r.y << 16), __uint_as_float(r.y & 0xffff0000u)};
              xv = (xv - mu) * rs * g4[bj][n] + b4[bj][n]; }
            else xv = *(const f32x4*)(xp + (size_t)row * D + c);
            const f32x4 ov = xv * ALPHA + gv[bj][n] * acc[ai][bj][m][n]; uint2 w; w.x = pk2(ov[0], ov[1]); w.y = pk2(ov[2], ov[3]); *(uint2*)(o + c) = w; } }
  } };

struct EpiIn { static constexpr bool PERM = true, AFTER_DRAIN = false; u16 *AQ, *AK, *AV, *PRE, *MV, *SIGO; float *MI, *MLF; const float* bias; float* out;
  __device__ __forceinline__ void operator()(const f32x4 (&acc)[2][2][4][2], const pg8::Unit& u, int wr, int wc, int fr, int fq) const {
    const int row0 = u.pm * 256 + wr * 64 + fr, pn = u.pn;
    f32x4 bz[2][2];
#pragma unroll
    for (int bj = 0; bj < 2; ++bj) { const int pc0 = 256 * pn + 128 * bj + 32 * wc + 8 * fq; bz[bj][0] = *(const f32x4*)(bias + pc0); bz[bj][1] = *(const f32x4*)(bias + pc0 + 4); }
#pragma unroll
    for (int ai = 0; ai < 2; ++ai)
#pragma unroll
      for (int m = 0; m < 4; ++m) { const int row = row0 + ai * 128 + m * 16;
#pragma unroll
        for (int bj = 0; bj < 2; ++bj) { const int cl = 128 * bj + 32 * wc + 8 * fq, pc = 256 * pn + cl;
          f32x4 v0 = acc[ai][bj][m][0] + bz[bj][0], v1 = acc[ai][bj][m][1] + bz[bj][1];
          if (pn < 2) { u32x4 o = {pk2(v0[0] * C2, v0[1] * C2), pk2(v0[2] * C2, v0[3] * C2), pk2(v1[0] * C2, v1[1] * C2), pk2(v1[2] * C2, v1[3] * C2)};
            *(u32x4*)(AQ + (size_t)row * 512 + pc) = o; }
          else if (pn < 6) { const int col = (pn < 4) ? pc - 512 : pc - 1024; u16* B = (pn < 4) ? AK : AV;
            u32x4 o = {pk2(v0[0], v0[1]), pk2(v0[2], v0[3]), pk2(v1[0], v1[1]), pk2(v1[2], v1[3])}; *(u32x4*)(B + (size_t)row * 512 + col) = o;
            float* op = (row < TP) ? out + ((pn < 4) ? O_KP : O_VP) + (size_t)row * 512 + col : out + ((pn < 4) ? O_KS : O_VS) + (size_t)(row - TP) * 512 + col;
            *(f32x4*)op = v0; *(f32x4*)(op + 4) = v1; }
          else if (pn < 10) { const int col = pc - 1536;
            u32x4 o = {pk2(v0[0], v0[1]), pk2(v0[2], v0[3]), pk2(v1[0], v1[1]), pk2(v1[2], v1[3])}; *(u32x4*)(PRE + (size_t)row * 1024 + col) = o;
            if (row < TP) { const int s = row & (SEQ - 1); if (s >= SEQ - 3) { float* op = out + O_CONVP + ((size_t)(row >> 14) * 3 + (s - (SEQ - 3))) * 1024 + col; *(f32x4*)op = v0; *(f32x4*)(op + 4) = v1; } }
            else { const int l = (row - TP) & 15; if (l >= 13) { float* op = out + O_CONVS + ((size_t)((row - TP) >> 4) * 3 + (l - 13)) * 1024 + col; *(f32x4*)op = v0; *(f32x4*)(op + 4) = v1; } } }
          else if (pn < 12) { u32x4 o = {pk2(v0[0], v0[1]), pk2(v0[2], v0[3]), pk2(v1[0], v1[1]), pk2(v1[2], v1[3])}; *(u32x4*)(MV + (size_t)row * 512 + (pc - 2560)) = o; }
          else if (pn < 14) { u32x4 o = {pk2(sigm(v0[0]), sigm(v0[1])), pk2(sigm(v0[2]), sigm(v0[3])), pk2(sigm(v1[0]), sigm(v1[1])), pk2(sigm(v1[2]), sigm(v1[3]))};
            *(u32x4*)(SIGO + (size_t)row * 512 + (pc - 3072)) = o; }
          else { if (bj == 0 && wc == 0) {
              if (fq == 0) { float* op = (row < TP) ? out + O_LFP + (size_t)row * 8 : out + O_LFS + (size_t)(row - TP) * 8;
                f32x4 a = {logsig(v0[0]), logsig(v0[1]), logsig(v0[2]), logsig(v0[3])}, b = {logsig(v1[0]), logsig(v1[1]), logsig(v1[2]), logsig(v1[3])};
                *(f32x4*)op = a; *(f32x4*)(op + 4) = b; }
              else if (fq == 1) { *(f32x4*)(MI + (size_t)row * 4) = v0; f32x4 b = {logsig(v1[0]), logsig(v1[1]), logsig(v1[2]), logsig(v1[3])}; *(f32x4*)(MLF + (size_t)row * 4) = b; } } }
        } }
  } };

template <int MODE> struct EpiMerge { static constexpr bool PERM = true, AFTER_DRAIN = false; u16* O; const u16* Aa; const float* bias;
  __device__ __forceinline__ void operator()(const f32x4 (&acc)[2][2][4][2], const pg8::Unit& u, int wr, int wc, int fr, int fq) const {
    const int row0 = u.pm * 256 + wr * 64 + fr, col0 = u.pn * 256 + wc * 32 + 8 * fq;
    f32x4 bz[2][2];
    if (MODE == 0) {
#pragma unroll
      for (int bj = 0; bj < 2; ++bj) { bz[bj][0] = *(const f32x4*)(bias + col0 + bj * 128); bz[bj][1] = *(const f32x4*)(bias + col0 + bj * 128 + 4); } }
#pragma unroll
    for (int ai = 0; ai < 2; ++ai)
#pragma unroll
      for (int m = 0; m < 4; ++m) { const size_t row = row0 + ai * 128 + m * 16;
#pragma unroll
        for (int bj = 0; bj < 2; ++bj) { const int c = col0 + bj * 128; u16* op = O + row * D + c; float r[8];
          const f32x4 a0 = acc[ai][bj][m][0], a1 = acc[ai][bj][m][1];
          if (MODE == 0) { const f32x4 b0 = bz[bj][0], b1 = bz[bj][1];
#pragma unroll
            for (int j = 0; j < 4; ++j) { r[j] = sigm(a0[j] + b0[j]); r[4 + j] = sigm(a1[j] + b1[j]); } }
          else { const u32x4 ov = *(const u32x4*)op; float o[8];
#pragma unroll
            for (int j = 0; j < 4; ++j) { o[2 * j] = __uint_as_float(ov[j] << 16); o[2 * j + 1] = __uint_as_float(ov[j] & 0xffff0000u); }
            if (MODE == 1) {
#pragma unroll
              for (int j = 0; j < 4; ++j) { r[j] = o[j] * a0[j]; r[4 + j] = o[4 + j] * a1[j]; } }
            else { const u32x4 av = *(const u32x4*)(Aa + row * D + c); const float accv[8] = {a0[0], a0[1], a0[2], a0[3], a1[0], a1[1], a1[2], a1[3]};
#pragma unroll
              for (int j = 0; j < 4; ++j) { const float x0 = __uint_as_float(av[j] << 16), x1 = __uint_as_float(av[j] & 0xffff0000u);
                r[2 * j] = x0 + o[2 * j] * accv[2 * j]; r[2 * j + 1] = x1 + o[2 * j + 1] * accv[2 * j + 1]; } } }
          u32x4 w = {pk2(r[0], r[1]), pk2(r[2], r[3]), pk2(r[4], r[5]), pk2(r[6], r[7])}; *(u32x4*)op = w; } }
  } };

struct EpiResSlice { static constexpr bool PERM = false, AFTER_DRAIN = false; float* B; int ldb; const float* gate; float gs;
  __device__ __forceinline__ void operator()(const f32x4 (&acc)[2][2][4][2], const pg8::Unit& u, int wr, int wc, int fr, int fq) const {
    int fr2 = fr, fq2 = fq; asm volatile("" : "+v"(fr2), "+v"(fq2));
    const int row0 = wr * 64 + fr2, col0 = u.pn * 256 + wc * 32 + 4 * fq2;
#pragma unroll
    for (int ai = 0; ai < 2; ++ai)
#pragma unroll
      for (int m = 0; m < 4; ++m) { const int lr = row0 + ai * 128 + m * 16; const float* gr = gate + (2 + (lr >> 4)) * 9216; float* o = B + (size_t)lr * ldb;
#pragma unroll
        for (int bj = 0; bj < 2; ++bj)
#pragma unroll
          for (int n = 0; n < 2; ++n) { const int c = col0 + bj * 128 + n * 16; const f32x4 gv = *(const f32x4*)(gr + c); *(f32x4*)(o + c) = gv * acc[ai][bj][m][n] * gs; } }
  } };
struct EpiSlice { static constexpr bool PERM = false, AFTER_DRAIN = false; float* B; int ldb;
  __device__ __forceinline__ void operator()(const f32x4 (&acc)[2][2][4][2], const pg8::Unit& u, int wr, int wc, int fr, int fq) const {
    int fr2 = fr, fq2 = fq; asm volatile("" : "+v"(fr2), "+v"(fq2));
    const int row0 = wr * 64 + fr2, col0 = u.pn * 256 + wc * 32 + 4 * fq2;
#pragma unroll
    for (int ai = 0; ai < 2; ++ai)
#pragma unroll
      for (int m = 0; m < 4; ++m) { float* o = B + (size_t)(row0 + ai * 128 + m * 16) * ldb;
#pragma unroll
        for (int bj = 0; bj < 2; ++bj)
#pragma unroll
          for (int n = 0; n < 2; ++n) *(f32x4*)(o + col0 + bj * 128 + n * 16) = acc[ai][bj][m][n]; }
  } };
struct SplitOrder { int c, n, npn;
  __device__ __forceinline__ bool next(int i, pg8::Unit& u) const { if (i != 0 || c >= n) return false; u.pm = 0; u.pn = c % npn; return true; }
  __device__ __forceinline__ void a_ready(const pg8::Unit&) const {}
  __device__ __forceinline__ void done(const pg8::Unit&) const {} };

template <class Epi> __device__ __forceinline__ void run_gemm(unsigned char* lds, const u16* A, const u16* Bt, int M, int N, int K, const Epi& E) {
  pg8::Gemm g; g.A = A; g.Bt = Bt; g.M = M; g.N = N; g.K = K; g.ld = K;
  pg8::StaticOrder S; S.init(M, N, (int)gridDim.x, (int)blockIdx.x);
  pg8::gemm_phase<Epi, pg8::StaticOrder, GEMM_ALIGN, GEMM_SP2>((PG8_LAS unsigned char*)lds, g, S, E);
  __syncthreads();
}
template <class Epi> __device__ __forceinline__ void run_gemm_split(unsigned char* lds, const u16* A, const u16* Bt, int K, const Epi& E, int blk0 = 0, int N = 1024) {
  const int npn = N / 256; const int cc = (int)blockIdx.x - blk0; const int c = cc < 0 ? 1 << 20 : cc, ks = c / npn;
  pg8::Gemm g; g.A = A + (size_t)TP * K + ks * 256; g.Bt = Bt + ks * 256; g.M = 256; g.N = N; g.K = 256; g.ld = K;
  SplitOrder S; S.c = c; S.n = npn * (K / 256); S.npn = npn;
  Epi E2 = E; E2.B = E.B + (size_t)(c < S.n ? ks : 0) * 256 * E.ldb;
  pg8::gemm_phase<Epi, SplitOrder, GEMM_ALIGN, GEMM_SP2>((PG8_LAS unsigned char*)lds, g, S, E2);
  __syncthreads();
}
__device__ __forceinline__ void gu_finish(const float* Z, u16* ACT, int ks, int tid) {
  const int r = tid >> 1, half = tid & 1; const float* zr = Z + (size_t)r * (2 * FF) + 512 * ks + 256 * half; u16* ar = ACT + (size_t)(TP + r) * FF + 256 * ks + 128 * half;
  constexpr size_t SL = (size_t)256 * 2 * FF;
#pragma unroll 2
  for (int i = 0; i < 16; ++i) { f32x4 g0 = *(const f32x4*)(zr + 8 * i), g1 = *(const f32x4*)(zr + 8 * i + 4), u0 = *(const f32x4*)(zr + 128 + 8 * i), u1 = *(const f32x4*)(zr + 128 + 8 * i + 4);
#pragma unroll
    for (int sl = 1; sl < 4; ++sl) { g0 += *(const f32x4*)(zr + sl * SL + 8 * i); g1 += *(const f32x4*)(zr + sl * SL + 8 * i + 4); u0 += *(const f32x4*)(zr + sl * SL + 128 + 8 * i); u1 += *(const f32x4*)(zr + sl * SL + 128 + 8 * i + 4); }
    u32x4 o = {pk2(siluf(g0[0]) * u0[0], siluf(g0[1]) * u0[1]), pk2(siluf(g0[2]) * u0[2], siluf(g0[3]) * u0[3]), pk2(siluf(g1[0]) * u1[0], siluf(g1[1]) * u1[1]), pk2(siluf(g1[2]) * u1[2], siluf(g1[3]) * u1[3])};
    *(u32x4*)(ar + 8 * i) = o; }
  __builtin_amdgcn_fence(__ATOMIC_RELEASE, "agent"); asm volatile("s_waitcnt vmcnt(0)" ::: "memory");
  __syncthreads();
  __builtin_amdgcn_fence(__ATOMIC_ACQUIRE, "agent"); asm volatile("s_waitcnt vmcnt(0)" ::: "memory");
  __syncthreads();
}

__device__ __forceinline__ int gu_map(int p) { const int t = p >> 8, r = p & 255; return r < 128 ? t * 128 + r : FF + t * 128 + (r - 128); }
__device__ __forceinline__ int in_map(int p) {
  if (p < 1536) return p; if (p < 2560) return 1544 + (p - 1536); if (p < 3072) return 2568 + (p - 2560); if (p < 3584) return 3088 + (p - 3072);
  if (p < 3592) return 1536 + (p - 3584); if (p < 3596) return 3080 + (p - 3592); if (p < 3600) return 3084 + (p - 3596); if (p < 3840) return -1;
  if (p < 4864) return 3600 + (p - 3840); return 4624 + (p - 4864); }

__device__ __forceinline__ void adaln_unit(const Params& p, float* mod, int unit, unsigned char* lds, int tid) {
  float* sc = (float*)lds; float* red = (float*)(lds + 73728);
  for (int i = tid; i < 18 * 1024; i += NTHR) { const int r = i >> 10, k = i & 1023; const float c = r < 2 ? p.in[9][r * 1024 + k] : p.in[10][(r - 2) * 1024 + k]; sc[i] = siluf(c); }
  __syncthreads();
  const int col = tid & 63, kg = tid >> 6; const float* W = p.in[11] + unit * 64 + col;
  float acc[18];
#pragma unroll
  for (int r = 0; r < 18; ++r) acc[r] = 0.f;
  for (int k0 = kg * 128; k0 < kg * 128 + 128; k0 += 16) { float w[16];
#pragma unroll
    for (int i = 0; i < 16; ++i) w[i] = W[(size_t)(k0 + i) * 9216];
#pragma unroll
    for (int i = 0; i < 16; ++i)
#pragma unroll
      for (int r = 0; r < 18; ++r) acc[r] += sc[r * 1024 + k0 + i] * w[i]; }
#pragma unroll
  for (int r = 0; r < 18; ++r) red[(kg * 18 + r) * 64 + col] = acc[r];
  __syncthreads();
  for (int i = tid; i < 18 * 64; i += NTHR) { const int r = i >> 6, c = i & 63; float s = 0.f; for (int g = 0; g < 8; ++g) s += red[(g * 18 + r) * 64 + c]; mod[r * 9216 + unit * 64 + c] = s + p.in[12][unit * 64 + c]; }
  __syncthreads();
}
template <int MAP> __device__ __forceinline__ void transpose_tile(const float* src, int ld, int K, u16* dst, int p0, int k0, unsigned char* lds, int tid) {
  u16* tl = (u16*)lds;
  { const int pp = tid & 63, kk = tid >> 6; const int sc = MAP == 0 ? p0 + pp : (MAP == 1 ? gu_map(p0 + pp) : in_map(p0 + pp));
#pragma unroll
    for (int i = 0; i < 8; ++i) { const int k = kk + 8 * i; const float v = sc >= 0 ? src[(size_t)(k0 + k) * ld + sc] : 0.f; tl[pp * 66 + k] = f2bf(v); } }
  __syncthreads();
  { const int row = tid >> 3, ch = tid & 7; const unsigned* s = (const unsigned*)(tl + row * 66 + ch * 8); u32x4 v = {s[0], s[1], s[2], s[3]};
    *(u32x4*)(dst + (size_t)(p0 + row) * K + k0 + ch * 8) = v; }
  __syncthreads();
}
__device__ __forceinline__ void prep_phase(const Params& p, unsigned char* lds, int tid_in) { int tid = tid_in;
  unsigned char* ws = p.ws;
  if (blockIdx.x == 0) { int* ctl = (int*)(ws + WS_CTL); if (tid < 64) ctl[tid] = 0; for (int i = tid; i < XCD_BAR_WORDS; i += NTHR) ctl[4096 + i] = 0;
    float* bp = (float*)(ws + WS_BIN); for (int i = tid; i < 5888; i += NTHR) { const int s = in_map(i); bp[i] = s >= 0 ? p.in[16][s] : 0.f; } }
  constexpr int N0 = 88 * 16, N1 = 16 * 44, N2 = 92 * 16, N3 = 16 * 8, N4 = 16 * 8, N5 = 16 * 16, N6 = 88 * 16, N7 = 16 * 44;
  constexpr int total = 144 + N0 + N1 + N2 + N3 + N4 + N5 + N6 + N7;
  for (int w = blockIdx.x; w < total; w += gridDim.x) { asm volatile("" : "+v"(tid));
    if (w < 144) { adaln_unit(p, (float*)(ws + WS_MOD), w, lds, tid); continue; }
    int q = w - 144, j = 0;
    if (q >= N0) { q -= N0; j = 1; if (q >= N1) { q -= N1; j = 2; if (q >= N2) { q -= N2; j = 3; if (q >= N3) { q -= N3; j = 4; if (q >= N4) { q -= N4; j = 5; if (q >= N5) { q -= N5; j = 6; if (q >= N6) { q -= N6; j = 7; } } } } } } }
    switch (j) {
      case 0: transpose_tile<1>(p.in[13], 2 * FF, 1024, (u16*)(ws + WS_WGU1), (q >> 4) * 64, (q & 15) * 64, lds, tid); break;
      case 1: transpose_tile<0>(p.in[14], D, FF, (u16*)(ws + WS_WD1), (q / 44) * 64, (q % 44) * 64, lds, tid); break;
      case 2: transpose_tile<2>(p.in[15], 5648, 1024, (u16*)(ws + WS_WIN), (q >> 4) * 64, (q & 15) * 64, lds, tid); break;
      case 3: transpose_tile<0>(p.in[20], D, 512, (u16*)(ws + WS_WBA), (q >> 3) * 64, (q & 7) * 64, lds, tid); break;
      case 4: transpose_tile<0>(p.in[21], D, 512, (u16*)(ws + WS_WBB), (q >> 3) * 64, (q & 7) * 64, lds, tid); break;
      case 5: transpose_tile<0>(p.in[22], D, 1024, (u16*)(ws + WS_WOUT), (q >> 4) * 64, (q & 15) * 64, lds, tid); break;
      case 6: transpose_tile<1>(p.in[23], 2 * FF, 1024, (u16*)(ws + WS_WGU2), (q >> 4) * 64, (q & 15) * 64, lds, tid); break;
      default: transpose_tile<0>(p.in[24], D, FF, (u16*)(ws + WS_WD2), (q / 44) * 64, (q % 44) * 64, lds, tid); break;
    }
  }
}

template <int MODE, int NSLAB> __device__ __forceinline__ void row_one(const Params& p, int row, int lane, int lnidx, const f32x4 (&g)[4], const f32x4 (&b)[4], const f32x4 (&sh)[4], const f32x4 (&sc)[4]) {
  const u16* XB = (const u16*)(p.ws + WS_X); float* XS = (float*)(p.ws + WS_XS); u16* H = (u16*)(p.ws + WS_H);
  f32x4 v[4];
  if (MODE != 0 && row < TP) {
#pragma unroll
    for (int i = 0; i < 4; ++i) { const uint2 r = *(const uint2*)(XB + (size_t)row * D + lane * 4 + 256 * i);
      v[i] = (f32x4){__uint_as_float(r.x << 16), __uint_as_float(r.x & 0xffff0000u), __uint_as_float(r.y << 16), __uint_as_float(r.y & 0xffff0000u)}; } }
  else { const float* src = MODE == 0 ? (row < TP ? p.in[0] + (size_t)row * D : p.in[1] + (size_t)(row - TP) * D) : XS + (size_t)(row - TP) * D;
#pragma unroll
    for (int i = 0; i < 4; ++i) v[i] = *(const f32x4*)(src + lane * 4 + 256 * i); }
  if (MODE != 0 && row >= TP) { const float* pb = (const float*)(p.ws + WS_PB) + (size_t)(row - TP) * D + lane * 4;
    for (int sl = 0; sl < NSLAB; ++sl) {
#pragma unroll
      for (int i = 0; i < 4; ++i) v[i] += *(const f32x4*)(pb + (size_t)sl * 262144 + 256 * i); } }
  if (MODE != 0) {
    float s = 0.f;
#pragma unroll
    for (int i = 0; i < 4; ++i) s += v[i][0] + v[i][1] + v[i][2] + v[i][3];
    const float mu = wsum(s) * (1.f / D); float q = 0.f;
#pragma unroll
    for (int i = 0; i < 4; ++i) { v[i] = v[i] - mu; q += v[i][0] * v[i][0] + v[i][1] * v[i][1] + v[i][2] * v[i][2] + v[i][3] * v[i][3]; }
    const float rstd = rsqrtf(wsum(q) * (1.f / D) + LN_EPS);
    if (MODE == 1 && row < TP && lane == 0) { float2 sv; sv.x = mu; sv.y = rstd; *(float2*)((float*)(p.ws + WS_ST) + 2 * ((size_t)lnidx * TP + row)) = sv; }
#pragma unroll
    for (int i = 0; i < 4; ++i) v[i] = v[i] * rstd * g[i] + b[i];
  }
  if (MODE == 2) { float* dst = row < TP ? p.out + O_YP + (size_t)row * D : p.out + O_YS + (size_t)(row - TP) * D;
#pragma unroll
    for (int i = 0; i < 4; ++i) *(f32x4*)(dst + lane * 4 + 256 * i) = v[i]; }
  else {
#pragma unroll
    for (int i = 0; i < 4; ++i) { const int c = lane * 4 + 256 * i; if (row >= TP) *(f32x4*)(XS + (size_t)(row - TP) * D + c) = v[i] * ALPHA;
      const f32x4 h = v[i] * (sc[i] + 1.f) + sh[i];
      uint2 w; w.x = pk2(h[0], h[1]); w.y = pk2(h[2], h[3]); *(uint2*)(H + (size_t)row * D + c) = w; } }
}
template <int MODE, int NSLAB = 0> __device__ __forceinline__ void row_phase(const Params& p, int lnidx, int sh_off, int sc_off) {
  int t_ = threadIdx.x; asm volatile("" : "+v"(t_)); const int lane = t_ & 63, wave = t_ >> 6;
  const float* mod = (const float*)(p.ws + WS_MOD);
  f32x4 g[4], b[4], sh[4], sc[4];
#pragma unroll
  for (int i = 0; i < 4; ++i) { const int c = lane * 4 + 256 * i; g[i] = b[i] = sh[i] = sc[i] = (f32x4){0.f, 0.f, 0.f, 0.f};
    if (MODE != 0) { g[i] = *(const f32x4*)(p.in[25] + lnidx * D + c); b[i] = *(const f32x4*)(p.in[26] + lnidx * D + c); } }
  for (int wg = blockIdx.x * 8 + wave; wg < TP / 16; wg += gridDim.x * 8) {
    if (MODE != 2) { const float* mr = mod + (wg >> 10) * 9216;
#pragma unroll
      for (int i = 0; i < 4; ++i) { const int c = lane * 4 + 256 * i; sh[i] = *(const f32x4*)(mr + sh_off + c); sc[i] = *(const f32x4*)(mr + sc_off + c); } }
#pragma unroll 2
    for (int k = 0; k < 16; ++k) row_one<MODE, NSLAB>(p, wg * 16 + k, lane, lnidx, g, b, sh, sc);
  }
  for (int sr = blockIdx.x * 8 + wave; sr < TS; sr += gridDim.x * 8) { const int row = TP + sr;
    if (MODE != 2) { const float* mr = mod + modrow(row) * 9216;
#pragma unroll
      for (int i = 0; i < 4; ++i) { const int c = lane * 4 + 256 * i; sh[i] = *(const f32x4*)(mr + sh_off + c); sc[i] = *(const f32x4*)(mr + sc_off + c); } }
    row_one<MODE, NSLAB>(p, row, lane, lnidx, g, b, sh, sc); }
}

__device__ __forceinline__ void scan_phase(const Params& p, unsigned char* lds, int tid_in) {
  unsigned char* ws = p.ws; float* sm = (float*)lds;
  const float* MI = (const float*)(ws + WS_MI); const float* MLF = (const float*)(ws + WS_MLF);
  for (int u = blockIdx.x; u < 24 + 512; u += gridDim.x) { int tid = tid_in; asm volatile("" : "+v"(tid));
    if (u < 16) {
      const int b = u >> 3, h = u & 7; const float* lf = p.out + O_LFP + ((size_t)b * SEQ) * 8 + h; float* F2 = (float*)(ws + WS_F2) + ((size_t)b * SEQ) * 8 + h;
      float loc[32]; float tot = 0.f;
#pragma unroll
      for (int i = 0; i < 32; ++i) { tot += lf[(size_t)(tid * 32 + i) * 8]; loc[i] = tot; }
      sm[tid] = tot; __syncthreads();
      for (int off = 1; off < NTHR; off <<= 1) { const float v = tid >= off ? sm[tid - off] : 0.f; __syncthreads(); sm[tid] += v; __syncthreads(); }
      const float pre = sm[tid] - tot;
#pragma unroll
      for (int i = 0; i < 32; ++i) F2[(size_t)(tid * 32 + i) * 8] = (pre + loc[i]) * LOG2E;
      __syncthreads();
    } else if (u < 24) {
      const int sq = u - 16, b = sq >> 2, h = sq & 3; const size_t r0 = (size_t)b * SEQ;
      float* MB = (float*)(ws + WS_MB); float* MM = (float*)(ws + WS_MM); float* MST = (float*)(ws + WS_MST);
      float* lfs = sm; float* igs = sm + 16640; float* sA = sm + 33280, *sC = sA + 256, *sE = sA + 512;
#pragma unroll 8
      for (int i = 0; i < 32; ++i) { const int tok = tid + NTHR * i; lfs[tok + (tok >> 6)] = MLF[(r0 + tok) * 4 + h]; igs[tok + (tok >> 6)] = MI[(r0 + tok) * 4 + h]; }
      __syncthreads();
      if (tid < 256) { float bsum = 0.f, ml = -INFINITY; for (int i = 0; i < 64; ++i) { const float lf = lfs[tid * 65 + i], ig = igs[tid * 65 + i]; bsum += lf; ml = fmaxf(lf + ml, ig); } sA[tid] = bsum; sC[tid] = ml; }
      __syncthreads();
      for (int off = 1; off < 256; off <<= 1) { float ap = 0.f, cp = -INFINITY; const bool act = tid < 256 && tid >= off; if (act) { ap = sA[tid - off]; cp = sC[tid - off]; } __syncthreads();
        if (act) { sC[tid] = fmaxf(sA[tid] + cp, sC[tid]); sA[tid] += ap; } __syncthreads(); }
      if (tid < 256) sE[tid] = fmaxf(sA[tid], sC[tid]);
      __syncthreads();
      if (tid < 256) { const float ms = tid > 0 ? sE[tid - 1] : 0.f; float bsum = 0.f, m = ms; for (int i = 0; i < 64; ++i) { const float lf = lfs[tid * 65 + i], ig = igs[tid * 65 + i]; bsum += lf; m = fmaxf(lf + m, ig); lfs[tid * 65 + i] = bsum; igs[tid * 65 + i] = m; }
        MST[sq * 256 + tid] = ms; MST[2048 + sq * 256 + tid] = __expf(bsum + ms - m); if (tid == 255) p.out[O_MP + sq] = m; }
      __syncthreads();
#pragma unroll 8
      for (int i = 0; i < 32; ++i) { const int tok = tid + NTHR * i; MB[(r0 + tok) * 4 + h] = lfs[tok + (tok >> 6)]; MM[(r0 + tok) * 4 + h] = igs[tok + (tok >> 6)]; }
      __syncthreads();
    } else {
      const int v = u - 24, b = v >> 8, tile = v & 255; unsigned* mx = (unsigned*)lds;
      if (tid < 16) mx[tid] = 0u; __syncthreads();
      const int row = tid >> 3, h = tid & 7; const size_t r = (size_t)b * SEQ + tile * 64 + row;
      const u16* kp = (const u16*)(ws + WS_AK) + r * 512 + h * 64; const u16* qp = (const u16*)(ws + WS_AQ) + r * 512 + h * 64;
      float nk = 0.f, nq = 0.f;
#pragma unroll
      for (int i = 0; i < 8; ++i) { const u32x4 a = *(const u32x4*)(kp + i * 8), c = *(const u32x4*)(qp + i * 8);
#pragma unroll
        for (int j = 0; j < 4; ++j) { float x = __uint_as_float(a[j] << 16), y = __uint_as_float(a[j] & 0xffff0000u); nk += x * x + y * y; x = __uint_as_float(c[j] << 16); y = __uint_as_float(c[j] & 0xffff0000u); nq += x * x + y * y; } }
      atomicMax(&mx[h], __float_as_uint(nk)); atomicMax(&mx[8 + h], __float_as_uint(nq)); __syncthreads();
      if (tid < 16) { float* MST = (float*)(ws + WS_MST); const int hh = tid & 7; MST[(tid < 8 ? 4096 : 8192) + (b * 8 + hh) * 256 + tile] = sqrtf(__uint_as_float(mx[tid])) * 1.0001f; }
      __syncthreads();
    }
  }
}

__device__ __forceinline__ void attn_prompt_unit(const Params& p, int b, int h, int qb, unsigned char* lds, int tid, int dry = 0) {
  unsigned char* ws = p.ws;
  const u16* AQ = (const u16*)(ws + WS_AQ); const u16* AK = (const u16*)(ws + WS_AK); const u16* AV = (const u16*)(ws + WS_AV); u16* OA = (u16*)(ws + WS_AQ);
  const float* F2 = (const float*)(ws + WS_F2); const float* MST = (const float*)(ws + WS_MST);
  u16* Ks = (u16*)lds;
  u16* Vt = (u16*)(lds + 18432);
  float* Fk = (float*)(lds + 36864);
  int* si = (int*)(lds + 37376);
  const int lane = tid & 63, wave = tid >> 6, r32 = lane & 31, hi = lane >> 5;
  const size_t rb = (size_t)b * SEQ; const int q0 = qb * 256; const int qrow = q0 + wave * 32 + r32;
  const int tend = 4 * qb + 3;
  int tstart = 0;
#if PRUNE
  { if (tid == 0) si[0] = 4 * qb; __syncthreads();
    const float* KM = MST + 4096 + (b * 8 + h) * 256; const float* QM = MST + 8192 + (b * 8 + h) * 256;
    const float q2 = fmaxf(fmaxf(QM[4 * qb], QM[4 * qb + 1]), fmaxf(QM[4 * qb + 2], QM[4 * qb + 3]));
    const float kd = fmaxf(fmaxf(KM[4 * qb], KM[4 * qb + 1]), fmaxf(KM[4 * qb + 2], KM[4 * qb + 3]));
    const float lower = -q2 * kd; const float fq0 = F2[(rb + q0) * 8 + h];
    if (tid < 4 * qb) { const float upper = q2 * KM[tid] + fq0 - F2[(rb + tid * 64 + 63) * 8 + h]; if (!(upper - lower < -PRUNE_TH)) atomicMin(&si[0], tid); }
    __syncthreads(); tstart = si[0]; __syncthreads(); }
#endif
  bf16x8 qr[4];
#pragma unroll
  for (int d0 = 0; d0 < 4; ++d0) qr[d0] = *(const bf16x8*)(AQ + (rb + qrow) * 512 + h * 64 + d0 * 16 + hi * 8);
  const float fq = F2[(rb + qrow) * 8 + h];
  f32x16 o0, o1;
#pragma unroll
  for (int r = 0; r < 16; ++r) { o0[r] = 0.f; o1[r] = 0.f; }
  float mrun = -INFINITY, lrun = 0.f;
  const int srow = tid >> 3, sch = tid & 7;
  const int vcol = srow ^ (sch << 3);
  const int sw0 = (r32 >> 3) << 3, sw1 = ((r32 >> 3) + 4) << 3;
  u32x4 kA, vA, kB, vB; float fA = 0.f, fB = 0.f;
#define ATT_LOAD(KR, VR, FR, t_) do { const size_t r_ = rb + (size_t)(t_) * 64 + srow; KR = *(const u32x4*)(AK + r_ * 512 + h * 64 + sch * 8); VR = *(const u32x4*)(AV + r_ * 512 + h * 64 + sch * 8); \
    if (tid < 64) FR = F2[(rb + (size_t)(t_) * 64 + tid) * 8 + h]; } while (0)
#define ATT_TILE(KR, VR, FR, t) do { \
    u16* Kb = Ks + buf * 4608; u16* Vb = Vt + buf * 4608; float* Fb = Fk + buf * 64; \
    *(u32x4*)(Kb + srow * 72 + sch * 8) = KR; \
    _Pragma("unroll") for (int j = 0; j < 4; ++j) { Vb[(sch * 8 + 2 * j) * 72 + vcol] = (u16)(VR[j] & 0xffffu); Vb[(sch * 8 + 2 * j + 1) * 72 + vcol] = (u16)(VR[j] >> 16); } \
    if (tid < 64) Fb[tid] = FR; \
    __syncthreads(); \
    if ((t) + 2 <= tend) ATT_LOAD(KR, VR, FR, (t) + 2); \
    f32x2_t pq[2][8]; const f32x2_t fq2 = {fq, fq}; \
    _Pragma("unroll") for (int blk = 0; blk < 2; ++blk) { f32x16 c; \
      _Pragma("unroll") for (int g = 0; g < 4; ++g) { const f32x4 fk = *(const f32x4*)(Fb + 32 * blk + 8 * g + 4 * hi); const f32x2_t a_ = fq2 - (f32x2_t){fk[0], fk[1]}, b_ = fq2 - (f32x2_t){fk[2], fk[3]}; \
        c[4 * g] = a_[0]; c[4 * g + 1] = a_[1]; c[4 * g + 2] = b_[0]; c[4 * g + 3] = b_[1]; } \
      _Pragma("unroll") for (int d0 = 0; d0 < 4; ++d0) { const bf16x8 a = *(const bf16x8*)(Kb + (32 * blk + r32) * 72 + d0 * 16 + hi * 8); c = __builtin_amdgcn_mfma_f32_32x32x16_bf16(a, qr[d0], c, 0, 0, 0); } \
      if ((t) >= 4 * qb) { const int kb0 = (t) * 64; \
        _Pragma("unroll") for (int r = 0; r < 16; ++r) { const int kv = kb0 + 32 * blk + crow(r, hi); if (kv > qrow) c[r] = -INFINITY; } } \
      _Pragma("unroll") for (int i = 0; i < 8; ++i) pq[blk][i] = (f32x2_t){c[2 * i], c[2 * i + 1]}; } \
    f32x2_t m2 = __builtin_elementwise_max(pq[0][0], pq[1][0]); \
    _Pragma("unroll") for (int i = 1; i < 8; ++i) m2 = __builtin_elementwise_max(m2, __builtin_elementwise_max(pq[0][i], pq[1][i])); \
    float rm = fmaxf(m2[0], m2[1]); \
    rm = fmaxf(rm, __shfl_xor(rm, 32)); \
    const float mnew = fmaxf(mrun, rm); const float al = __builtin_amdgcn_exp2f(mrun - mnew); const f32x2_t mn2 = {mnew, mnew}; f32x2_t rs2 = {0.f, 0.f}; \
    _Pragma("unroll") for (int blk = 0; blk < 2; ++blk) _Pragma("unroll") for (int i = 0; i < 8; ++i) { const f32x2_t d_ = pq[blk][i] - mn2; f32x2_t e_; e_[0] = __builtin_amdgcn_exp2f(d_[0]); e_[1] = __builtin_amdgcn_exp2f(d_[1]); pq[blk][i] = e_; rs2 += e_; } \
    lrun = lrun * al + (rs2[0] + rs2[1]); mrun = mnew; \
    o0 *= al; o1 *= al; \
    _Pragma("unroll") for (int blk = 0; blk < 2; ++blk) _Pragma("unroll") for (int s = 0; s < 2; ++s) { \
        u32x4 pw = {__builtin_bit_cast(unsigned, __builtin_convertvector(pq[blk][4 * s], bf16x2_t)), __builtin_bit_cast(unsigned, __builtin_convertvector(pq[blk][4 * s + 1], bf16x2_t)), \
                    __builtin_bit_cast(unsigned, __builtin_convertvector(pq[blk][4 * s + 2], bf16x2_t)), __builtin_bit_cast(unsigned, __builtin_convertvector(pq[blk][4 * s + 3], bf16x2_t))}; \
        const bf16x8 pf = __builtin_bit_cast(bf16x8, pw); const int kvo = 32 * blk + 16 * s + 4 * hi; \
        { const uint2 x = *(const uint2*)(Vb + r32 * 72 + (kvo ^ sw0)), y = *(const uint2*)(Vb + r32 * 72 + ((kvo + 8) ^ sw0)); u32x4 a = {x.x, x.y, y.x, y.y}; \
          o0 = __builtin_amdgcn_mfma_f32_32x32x16_bf16(__builtin_bit_cast(bf16x8, a), pf, o0, 0, 0, 0); } \
        { const uint2 x = *(const uint2*)(Vb + (32 + r32) * 72 + (kvo ^ sw1)), y = *(const uint2*)(Vb + (32 + r32) * 72 + ((kvo + 8) ^ sw1)); u32x4 a = {x.x, x.y, y.x, y.y}; \
          o1 = __builtin_amdgcn_mfma_f32_32x32x16_bf16(__builtin_bit_cast(bf16x8, a), pf, o1, 0, 0, 0); } } \
    buf ^= 1; } while (0)
  ATT_LOAD(kA, vA, fA, tstart);
  if (tstart + 1 <= tend) ATT_LOAD(kB, vB, fB, tstart + 1);
  int buf = 0;
  { int t = tstart;
    for (; t + 1 <= tend; t += 2) { ATT_TILE(kA, vA, fA, t); ATT_TILE(kB, vB, fB, t + 1); }
    if (t <= tend) ATT_TILE(kA, vA, fA, t); }
#undef ATT_LOAD
#undef ATT_TILE
  lrun += __shfl_xor(lrun, 32);
  const float inv = 1.f / lrun;
  u16* orow = dry ? (u16*)(ws + WS_END) + (((rb + qrow) * 512 + h * 64) & 0x3fffff) : OA + (rb + qrow) * 512 + h * 64;
#pragma unroll
  for (int g = 0; g < 4; ++g) { uint2 w; w.x = pk2(o0[4 * g] * inv, o0[4 * g + 1] * inv); w.y = pk2(o0[4 * g + 2] * inv, o0[4 * g + 3] * inv); *(uint2*)(orow + 8 * g + 4 * hi) = w;
    w.x = pk2(o1[4 * g] * inv, o1[4 * g + 1] * inv); w.y = pk2(o1[4 * g + 2] * inv, o1[4 * g + 3] * inv); *(uint2*)(orow + 32 + 8 * g + 4 * hi) = w; }
  __syncthreads();
}

__device__ __forceinline__ void attn_sample_unit(const Params& p, int b, int h, unsigned char* lds, int tid, int dry = 0) {
  constexpr int NK = PAST + 16, NTILE = (NK + 31) / 32;
  float* Ft = (float*)lds;
  float* red = (float*)(lds + 8320);
  const int lane = tid & 63, wave = tid >> 6, r32 = lane & 31, hi = lane >> 5, q = r32 & 15;
  unsigned char* wreg = lds + 10752 + wave * 12288;
  u16* Kw = (u16*)wreg; u16* Vw = (u16*)(wreg + 4608); float* Ow = (float*)wreg; float* MLw = (float*)(wreg + 8192);
  const u16* AQ = (const u16*)(p.ws + WS_AQ); u16* OA = (u16*)(p.ws + WS_AQ);
  const float* ck = p.in[2]; const float* cv = p.in[3]; const float* clf = p.in[4];
  { float loc[5]; float tot = 0.f;
#pragma unroll
    for (int i = 0; i < 5; ++i) { const int j = tid * 5 + i; float v = 0.f; if (j < PAST) v = clf[((size_t)b * PAST + j) * 8 + h]; else if (j < NK) v = p.out[O_LFS + (size_t)(b * 16 + j - PAST) * 8 + h]; tot += v; loc[i] = tot; }
    red[tid] = tot; __syncthreads();
    for (int off = 1; off < NTHR; off <<= 1) { const float v = tid >= off ? red[tid - off] : 0.f; __syncthreads(); red[tid] += v; __syncthreads(); }
    const float pre = red[tid] - tot;
#pragma unroll
    for (int i = 0; i < 5; ++i) { const int j = tid * 5 + i; if (j < 2080) Ft[j] = (pre + loc[i]) * LOG2E; }
    __syncthreads(); }
  bf16x8 qr[4];
#pragma unroll
  for (int d0 = 0; d0 < 4; ++d0) qr[d0] = *(const bf16x8*)(AQ + (size_t)(TP + b * 16 + q) * 512 + h * 64 + d0 * 16 + hi * 8);
  const float fq = Ft[PAST + q];
  f32x16 o0, o1;
#pragma unroll
  for (int r = 0; r < 16; ++r) { o0[r] = 0.f; o1[r] = 0.f; }
  float mrun = -INFINITY, lrun = 0.f;
  const int kk = lane >> 1, hh = lane & 1;
  f32x4 kreg[8], vreg[8];
#define SAMPLE_LOAD(t_) do { const int j_ = 32 * (t_) + kk; \
    if (j_ < NK) { const float* kp_ = j_ < PAST ? ck + (((size_t)b * PAST + j_) * 8 + h) * 64 : p.out + O_KS + (size_t)(b * 16 + j_ - PAST) * 512 + h * 64; \
      const float* vp_ = j_ < PAST ? cv + (((size_t)b * PAST + j_) * 8 + h) * 64 : p.out + O_VS + (size_t)(b * 16 + j_ - PAST) * 512 + h * 64; \
      _Pragma("unroll") for (int i_ = 0; i_ < 8; ++i_) { kreg[i_] = *(const f32x4*)(kp_ + hh * 32 + i_ * 4); vreg[i_] = *(const f32x4*)(vp_ + hh * 32 + i_ * 4); } } \
    else { _Pragma("unroll") for (int i_ = 0; i_ < 8; ++i_) { kreg[i_] = (f32x4){0.f, 0.f, 0.f, 0.f}; vreg[i_] = (f32x4){0.f, 0.f, 0.f, 0.f}; } } } while (0)
  SAMPLE_LOAD(wave);
  for (int t = wave; t < NTILE; t += 8) {
#pragma unroll
    for (int i = 0; i < 2; ++i) { u32x4 w0 = {pk2(kreg[4 * i][0], kreg[4 * i][1]), pk2(kreg[4 * i][2], kreg[4 * i][3]), pk2(kreg[4 * i + 1][0], kreg[4 * i + 1][1]), pk2(kreg[4 * i + 1][2], kreg[4 * i + 1][3])};
      u32x4 w1 = {pk2(kreg[4 * i + 2][0], kreg[4 * i + 2][1]), pk2(kreg[4 * i + 2][2], kreg[4 * i + 2][3]), pk2(kreg[4 * i + 3][0], kreg[4 * i + 3][1]), pk2(kreg[4 * i + 3][2], kreg[4 * i + 3][3])};
      *(u32x4*)(Kw + kk * 72 + hh * 32 + i * 16) = w0; *(u32x4*)(Kw + kk * 72 + hh * 32 + i * 16 + 8) = w1; }
#pragma unroll
    for (int i = 0; i < 8; ++i)
#pragma unroll
      for (int e = 0; e < 4; ++e) Vw[(hh * 32 + i * 4 + e) * 40 + kk] = f2bf(vreg[i][e]);
    if (t + 8 < NTILE) SAMPLE_LOAD(t + 8);
    f32x16 c;
#pragma unroll
    for (int g = 0; g < 4; ++g) { const f32x4 fk = *(const f32x4*)(Ft + 32 * t + 8 * g + 4 * hi); c[4 * g] = fq - fk[0]; c[4 * g + 1] = fq - fk[1]; c[4 * g + 2] = fq - fk[2]; c[4 * g + 3] = fq - fk[3]; }
#pragma unroll
    for (int d0 = 0; d0 < 4; ++d0) { const bf16x8 a = *(const bf16x8*)(Kw + r32 * 72 + d0 * 16 + hi * 8); c = __builtin_amdgcn_mfma_f32_32x32x16_bf16(a, qr[d0], c, 0, 0, 0); }
    if (32 * t + 31 > PAST) {
#pragma unroll
      for (int r = 0; r < 16; ++r) { const int kv = 32 * t + crow(r, hi); if (kv > PAST + q) c[r] = -INFINITY; } }
    float rm = -INFINITY;
#pragma unroll
    for (int r = 0; r < 16; ++r) rm = fmaxf(rm, c[r]);
    rm = fmaxf(rm, __shfl_xor(rm, 32));
    const float mnew = fmaxf(mrun, rm); const float al = __builtin_amdgcn_exp2f(mrun - mnew); float rs = 0.f;
#pragma unroll
    for (int r = 0; r < 16; ++r) { const float e = __builtin_amdgcn_exp2f(c[r] - mnew); c[r] = e; rs += e; }
    lrun = lrun * al + rs; mrun = mnew;
#pragma unroll
    for (int r = 0; r < 16; ++r) { o0[r] *= al; o1[r] *= al; }
#pragma unroll
    for (int s2 = 0; s2 < 2; ++s2) {
      u32x4 pw = {pk2(c[8 * s2], c[8 * s2 + 1]), pk2(c[8 * s2 + 2], c[8 * s2 + 3]), pk2(c[8 * s2 + 4], c[8 * s2 + 5]), pk2(c[8 * s2 + 6], c[8 * s2 + 7])};
      const bf16x8 pf = __builtin_bit_cast(bf16x8, pw); const int kvo = 16 * s2 + 4 * hi;
      { const uint2 x = *(const uint2*)(Vw + r32 * 40 + kvo), y = *(const uint2*)(Vw + r32 * 40 + kvo + 8); u32x4 a = {x.x, x.y, y.x, y.y};
        o0 = __builtin_amdgcn_mfma_f32_32x32x16_bf16(__builtin_bit_cast(bf16x8, a), pf, o0, 0, 0, 0); }
      { const uint2 x = *(const uint2*)(Vw + (32 + r32) * 40 + kvo), y = *(const uint2*)(Vw + (32 + r32) * 40 + kvo + 8); u32x4 a = {x.x, x.y, y.x, y.y};
        o1 = __builtin_amdgcn_mfma_f32_32x32x16_bf16(__builtin_bit_cast(bf16x8, a), pf, o1, 0, 0, 0); } }
  }
#undef SAMPLE_LOAD
  lrun += __shfl_xor(lrun, 32);
#pragma unroll
  for (int r = 0; r < 16; ++r) { Ow[crow(r, hi) * 32 + r32] = o0[r]; Ow[(32 + crow(r, hi)) * 32 + r32] = o1[r]; }
  if (hi == 0) { MLw[r32] = mrun; MLw[32 + r32] = lrun; }
  __syncthreads();
  { const int qq = tid & 15, dp = tid >> 4; float M = -INFINITY;
#pragma unroll
    for (int w = 0; w < 8; ++w) M = fmaxf(M, ((const float*)(lds + 10752 + w * 12288 + 8192))[qq]);
    float L = 0.f, a0 = 0.f, a1 = 0.f;
#pragma unroll
    for (int w = 0; w < 8; ++w) { const float* ml = (const float*)(lds + 10752 + w * 12288 + 8192); const float* ow = (const float*)(lds + 10752 + w * 12288); const float sc = __builtin_amdgcn_exp2f(ml[qq] - M);
      L += ml[32 + qq] * sc; a0 += ow[(2 * dp) * 32 + qq] * sc; a1 += ow[(2 * dp + 1) * 32 + qq] * sc; }
    const float inv = 1.f / L;
    u16* dst = (dry ? (u16*)(p.ws + WS_END) : OA + (size_t)TP * 512) + (size_t)(b * 16 + qq) * 512 + h * 64 + 2 * dp;
    *(unsigned*)dst = pk2(a0 * inv, a1 * inv); }
  __syncthreads();
}

template <class CT> __device__ __forceinline__ float ldc(const CT* p);
template <> __device__ __forceinline__ float ldc<u16>(const u16* p) { return bf2f(*p); }
template <> __device__ __forceinline__ float ldc<float>(const float* p) { return *p; }

template <int L, int MODE> __device__ __forceinline__ void mlstm_unit(const Params& p, int b, int h, int c, unsigned char* lds, int tid, int dry = 0) {
  typedef typename std::conditional<MODE == 2, float, u16>::type CT;
  constexpr int CP = (MODE == 2) ? 129 : 130;
  constexpr int OFF_Q = 0, OFF_K = L * 260, OFF_V = 2 * L * 260, OFF_C = 3 * L * 260, OFF_A = OFF_C + 128 * CP * (int)sizeof(CT), OFF_H = OFF_A + L * (L + 1) * 4, OFF_S = OFF_H + L * 128 * 4;
  static_assert(OFF_S + 1024 * 4 <= MISC_OFF && (OFF_C % 4) == 0 && (OFF_A % 4) == 0, "mlstm lds");
  unsigned char* ws = p.ws;
  u16* qs = (u16*)(lds + OFF_Q); u16* ks = (u16*)(lds + OFF_K); u16* vs = (u16*)(lds + OFF_V); CT* Cs = (CT*)(lds + OFF_C); float* A = (float*)(lds + OFF_A); float* Hs = (float*)(lds + OFF_H);
  float* sc = (float*)(lds + OFF_S); float *bt = sc, *ig = sc + 64, *mt = sc + 128, *wint = sc + 192, *den = sc + 256, *nq = sc + 320, *wsv = sc + 384, *ns = sc + 448, *misc = sc + 576;
  const u16* PRE = (const u16*)(ws + WS_PRE); u16* MV = (u16*)(ws + WS_MV); const u16* SIGO = (const u16*)(ws + WS_SIGO);
  const float* MI = (const float*)(ws + WS_MI); const float* MLF = (const float*)(ws + WS_MLF);
  const int sq = b * 4 + h; const int item = sq * 256 + c;
  const size_t r0 = (MODE == 2) ? (size_t)TP + b * 16 : (size_t)b * SEQ + (size_t)c * 64;
  const float* cw = p.in[17]; const float* cb = p.in[18];
  { constexpr int NI = (MODE == 0) ? L * 16 : L * 32;
    for (int idx = tid; idx < NI; idx += NTHR) { const int l = (MODE == 0) ? idx >> 4 : idx >> 5, chk = (MODE == 0) ? 16 + (idx & 15) : idx & 31;
      const int col0 = chk < 16 ? h * 128 + chk * 8 : 512 + h * 128 + (chk - 16) * 8;
      float val[8]; { const f32x4 b0 = *(const f32x4*)(cb + col0), b1 = *(const f32x4*)(cb + col0 + 4);
#pragma unroll
        for (int e = 0; e < 4; ++e) { val[e] = b0[e]; val[4 + e] = b1[e]; } }
#pragma unroll
      for (int j = 0; j < 4; ++j) { const int rr = l - 3 + j; float x[8];
        if (rr >= 0 || (MODE != 2 && c > 0)) { const u32x4 pv = *(const u32x4*)(PRE + (r0 + rr) * 1024 + col0);
#pragma unroll
          for (int e = 0; e < 4; ++e) { x[2 * e] = __uint_as_float(pv[e] << 16); x[2 * e + 1] = __uint_as_float(pv[e] & 0xffff0000u); } }
        else if (MODE == 2) { const float* hp = p.in[8] + ((size_t)b * 3 + (3 + rr)) * 1024 + col0; const f32x4 h0 = *(const f32x4*)hp, h1 = *(const f32x4*)(hp + 4);
#pragma unroll
          for (int e = 0; e < 4; ++e) { x[e] = h0[e]; x[4 + e] = h1[e]; } }
        else {
#pragma unroll
          for (int e = 0; e < 8; ++e) x[e] = 0.f; }
        const f32x4 w0 = *(const f32x4*)(cw + j * 1024 + col0), w1 = *(const f32x4*)(cw + j * 1024 + col0 + 4);
#pragma unroll
        for (int e = 0; e < 4; ++e) { val[e] += x[e] * w0[e]; val[4 + e] += x[4 + e] * w1[e]; } }
      const float scl = chk < 16 ? 1.f : 0.08838834764831845f;
#pragma unroll
      for (int e = 0; e < 8; ++e) val[e] = siluf(val[e]) * scl;
      unsigned* dst = (unsigned*)((chk < 16 ? qs + l * 130 + chk * 8 : ks + l * 130 + (chk - 16) * 8));
      dst[0] = pk2(val[0], val[1]); dst[1] = pk2(val[2], val[3]); dst[2] = pk2(val[4], val[5]); dst[3] = pk2(val[6], val[7]); }
    for (int idx = tid; idx < L * 16; idx += NTHR) { const int l = idx >> 4, ch = idx & 15; const u32x4 v = *(const u32x4*)(MV + (r0 + l) * 512 + h * 128 + ch * 8);
      unsigned* dst = (unsigned*)(vs + l * 130 + ch * 8); dst[0] = v[0]; dst[1] = v[1]; dst[2] = v[2]; dst[3] = v[3]; } }
  float m0;
  if (MODE == 2) { m0 = p.in[7][sq];
    if (tid == 0) { float bs = 0.f, m = m0; for (int l = 0; l < L; ++l) { const float lf = MLF[(r0 + l) * 4 + h], g = MI[(r0 + l) * 4 + h]; bs += lf; m = fmaxf(lf + m, g); bt[l] = bs; ig[l] = g; mt[l] = m; } }
    for (int i = tid; i < 128; i += NTHR) ns[i] = p.in[6][sq * 128 + i];
  } else { m0 = ((const float*)(ws + WS_MST))[item];
    if (tid < L) { bt[tid] = ((const float*)(ws + WS_MB))[(r0 + tid) * 4 + h]; ig[tid] = MI[(r0 + tid) * 4 + h]; mt[tid] = ((const float*)(ws + WS_MM))[(r0 + tid) * 4 + h]; }
    if (MODE == 1) for (int i = tid; i < 128; i += NTHR) ns[i] = ((const float*)(ws + WS_UN))[(size_t)item * 128 + i]; }
  if (MODE == 1) { const u16* Cg = (const u16*)(p.out + O_YP) + (size_t)item * 16384;
#pragma unroll
    for (int i = 0; i < 4; ++i) { const int idx = tid + NTHR * i, v = idx >> 4, ch = idx & 15; const u32x4 x = *(const u32x4*)(Cg + v * 128 + ch * 8); unsigned* dst = (unsigned*)((u16*)Cs + v * CP + ch * 8); dst[0] = x[0]; dst[1] = x[1]; dst[2] = x[2]; dst[3] = x[3]; } }
  if (MODE == 2) { const float* Cg = p.in[5] + (size_t)sq * 16384;
#pragma unroll
    for (int i = 0; i < 8; ++i) { const int idx = tid + NTHR * i, v = idx >> 5, c4 = idx & 31; const f32x4 x = *(const f32x4*)(Cg + v * 128 + c4 * 4); float* dst = (float*)Cs + v * CP + c4 * 4; dst[0] = x[0]; dst[1] = x[1]; dst[2] = x[2]; dst[3] = x[3]; } }
  __syncthreads();
  if (tid < L) { wint[tid] = __expf(bt[tid] + m0 - mt[tid]); wsv[tid] = __expf(bt[L - 1] - bt[tid] + ig[tid] - mt[L - 1]); }
  const float mnew = mt[L - 1]; const float wstate = __expf(bt[L - 1] + m0 - mnew);
  if (MODE != 0) {
#pragma unroll 1
    for (int idx = tid; idx < L * L; idx += NTHR) { const int t = idx / L, s = idx % L; float a = 0.f;
      if (s <= t) { float dot = 0.f;
#pragma unroll 8
        for (int d = 0; d < 128; ++d) dot += bf2f(qs[t * 130 + d]) * bf2f(ks[s * 130 + d]);
        a = __expf(bt[t] - bt[s] + ig[s] - mt[t]) * dot; }
      A[t * (L + 1) + s] = a; }
    __syncthreads();
    if (tid < L) { float s = 0.f; for (int j = 0; j <= tid; ++j) s += A[tid * (L + 1) + j]; den[tid] = s; }
    else if (tid >= 64 && tid < 64 + L) { const int t = tid - 64; float s = 0.f; for (int d = 0; d < 128; ++d) s += ns[d] * bf2f(qs[t * 130 + d]); nq[t] = s; }
    __syncthreads();
#pragma unroll 1
    for (int idx = tid; idx < L * 128; idx += NTHR) { const int t = idx >> 7, v = idx & 127; float n1 = 0.f, n2 = 0.f;
#pragma unroll 1
      for (int s = 0; s <= t; ++s) n1 += A[t * (L + 1) + s] * bf2f(vs[s * 130 + v]);
#pragma unroll 8
      for (int d = 0; d < 128; ++d) n2 += ldc<CT>(Cs + v * CP + d) * bf2f(qs[t * 130 + d]);
      const float wi = wint[t]; const float dn = den[t] + wi * nq[t];
      Hs[t * 128 + v] = (n1 + wi * n2) / fmaxf(fabsf(dn), __expf(-mt[t])); }
    __syncthreads();
    { const int lane = tid & 63, wave = tid >> 6;
      for (int t = wave; t < L; t += 8) { const float x0 = Hs[t * 128 + lane], x1 = Hs[t * 128 + 64 + lane]; const float mu = wsum(x0 + x1) * (1.f / 128.f);
        const float y0 = x0 - mu, y1 = x1 - mu; const float rstd = rsqrtf(wsum(y0 * y0 + y1 * y1) * (1.f / 128.f) + LN_EPS);
        const size_t ro = (r0 + t) * 512 + h * 128; const float* ng = p.in[19] + h * 128;
        u16* MO = dry ? (u16*)(ws + WS_END) + (ro & 0x3fffff) : MV + ro; MO[lane] = f2bf(y0 * rstd * ng[lane] * bf2f(SIGO[ro + lane])); MO[64 + lane] = f2bf(y1 * rstd * ng[64 + lane] * bf2f(SIGO[ro + 64 + lane])); } }
  }
  if (MODE != 1) {
    __syncthreads();
    const int v = tid >> 2, dg = tid & 3; float acc[32];
#pragma unroll
    for (int i = 0; i < 32; ++i) acc[i] = 0.f;
#pragma unroll 1
    for (int s = 0; s < L; ++s) { const float wv = wsv[s] * bf2f(vs[s * 130 + v]);
#pragma unroll
      for (int i = 0; i < 32; ++i) acc[i] += wv * bf2f(ks[s * 130 + dg * 32 + i]); }
    if (MODE == 0) { u16* Ug = (u16*)(p.out + O_YP) + (size_t)item * 16384 + v * 128 + dg * 32;
#pragma unroll
      for (int i = 0; i < 4; ++i) { u32x4 w = {pk2(acc[8 * i], acc[8 * i + 1]), pk2(acc[8 * i + 2], acc[8 * i + 3]), pk2(acc[8 * i + 4], acc[8 * i + 5]), pk2(acc[8 * i + 6], acc[8 * i + 7])}; *(u32x4*)(Ug + 8 * i) = w; }
      if (tid < 128) { float s = 0.f; for (int j = 0; j < L; ++j) s += wsv[j] * bf2f(ks[j * 130 + tid]); ((float*)(ws + WS_UN))[(size_t)item * 128 + tid] = s; } }
    else { float* Cg = p.out + O_CS + (size_t)sq * 16384 + v * 128 + dg * 32;
#pragma unroll
      for (int i = 0; i < 32; ++i) Cg[i] = wstate * ldc<CT>(Cs + v * CP + dg * 32 + i) + acc[i];
      if (tid < 128) { float s = 0.f; for (int j = 0; j < L; ++j) s += wsv[j] * bf2f(ks[j * 130 + tid]); p.out[O_NS + sq * 128 + tid] = wstate * ns[tid] + s; }
      if (tid == 0) p.out[O_MS + sq] = mnew; }
  }
  __syncthreads();
}

__device__ __forceinline__ void conv8(const u16* PRE, const float* cw, const float* cb, size_t r0, int l, int col0, bool hasprev, float scl, float (&val)[8]) {
  { const f32x4 b0 = *(const f32x4*)(cb + col0), b1 = *(const f32x4*)(cb + col0 + 4);
#pragma unroll
    for (int e = 0; e < 4; ++e) { val[e] = b0[e]; val[4 + e] = b1[e]; } }
#pragma unroll
  for (int j = 0; j < 4; ++j) { const int rr = l - 3 + j;
    if (rr >= 0 || hasprev) { const u32x4 pv = *(const u32x4*)(PRE + (r0 + rr) * 1024 + col0);
      const f32x4 w0 = *(const f32x4*)(cw + j * 1024 + col0), w1 = *(const f32x4*)(cw + j * 1024 + col0 + 4);
#pragma unroll
      for (int e = 0; e < 4; ++e) { const float x0 = __uint_as_float(pv[e] << 16), x1 = __uint_as_float(pv[e] & 0xffff0000u);
        const float wa = (2 * e < 4) ? w0[(2 * e) & 3] : w1[(2 * e) & 3], wb = (2 * e + 1 < 4) ? w0[(2 * e + 1) & 3] : w1[(2 * e + 1) & 3];
        val[2 * e] += x0 * wa; val[2 * e + 1] += x1 * wb; } } }
#pragma unroll
  for (int e = 0; e < 8; ++e) val[e] = siluf(val[e]) * scl;
}

template <int NR> __device__ __forceinline__ void convN(const u16* PRE, const float* cw, const float* cb, size_t r0, int l0, int col0, bool hasprev, float scl, float (&out)[NR][8]) {
  float w[4][8], bb[8];
  { const f32x4 b0 = *(const f32x4*)(cb + col0), b1 = *(const f32x4*)(cb + col0 + 4);
#pragma unroll
    for (int e = 0; e < 4; ++e) { bb[e] = b0[e]; bb[4 + e] = b1[e]; } }
#pragma unroll
  for (int j = 0; j < 4; ++j) { const f32x4 w0 = *(const f32x4*)(cw + j * 1024 + col0), w1 = *(const f32x4*)(cw + j * 1024 + col0 + 4);
#pragma unroll
    for (int e = 0; e < 4; ++e) { w[j][e] = w0[e]; w[j][4 + e] = w1[e]; } }
  u32x4 xr[NR + 3];
#pragma unroll
  for (int i = 0; i < NR + 3; ++i) { const int rr = l0 - 3 + i; xr[i] = (rr >= 0 || hasprev) ? *(const u32x4*)(PRE + (r0 + rr) * 1024 + col0) : (u32x4){0u, 0u, 0u, 0u}; }
#pragma unroll
  for (int r = 0; r < NR; ++r) {
#pragma unroll
    for (int e = 0; e < 8; ++e) out[r][e] = bb[e];
#pragma unroll
    for (int j = 0; j < 4; ++j) { const u32x4 pv = xr[r + j];
#pragma unroll
      for (int e = 0; e < 4; ++e) { out[r][2 * e] += __uint_as_float(pv[e] << 16) * w[j][2 * e]; out[r][2 * e + 1] += __uint_as_float(pv[e] & 0xffff0000u) * w[j][2 * e + 1]; } }
#pragma unroll
    for (int e = 0; e < 8; ++e) out[r][e] = siluf(out[r][e]) * scl; }
}

__device__ __forceinline__ void mlstm_h1_unit(const Params& p, int b, int h, int c, unsigned char* lds, int tid) {
  unsigned char* ws = p.ws;
  u16* vT = (u16*)lds; u16* kT = (u16*)(lds + 18432); float* wsv = (float*)(lds + 36864);
  const u16* PRE = (const u16*)(ws + WS_PRE); const u16* MV = (const u16*)(ws + WS_MV);
  const float* MI = (const float*)(ws + WS_MI); const float* MB = (const float*)(ws + WS_MB); const float* MM = (const float*)(ws + WS_MM);
  const int sq = b * 4 + h, item = sq * 256 + c; const size_t r0 = (size_t)b * SEQ + (size_t)c * 64;
  const int lane = tid & 63, wave = tid >> 6, r32 = lane & 31, hi = lane >> 5;
  if (tid < 64) wsv[tid] = __expf(MB[(r0 + 63) * 4 + h] - MB[(r0 + tid) * 4 + h] + MI[(r0 + tid) * 4 + h] - MM[(r0 + 63) * 4 + h]);
  __syncthreads();
  { const int chk = tid & 15, l0 = (tid >> 4) * 2; float val[2][8];
    convN<2>(PRE, p.in[17], p.in[18], r0, l0, 512 + h * 128 + chk * 8, c > 0, 0.08838834764831845f, val);
#pragma unroll
    for (int r = 0; r < 2; ++r)
#pragma unroll
      for (int e = 0; e < 8; ++e) kT[(chk * 8 + e) * 72 + l0 + r] = f2bf(val[r][e]); }
#pragma unroll
  for (int it = 0; it < 2; ++it) { const int idx = tid + NTHR * it, l = idx >> 4, ch = idx & 15; const u32x4 v = *(const u32x4*)(MV + (r0 + l) * 512 + h * 128 + ch * 8); const float w = wsv[l];
#pragma unroll
    for (int e = 0; e < 4; ++e) { vT[(ch * 8 + 2 * e) * 72 + l] = f2bf(__uint_as_float(v[e] << 16) * w); vT[(ch * 8 + 2 * e + 1) * 72 + l] = f2bf(__uint_as_float(v[e] & 0xffff0000u) * w); } }
  __syncthreads();
  u16* Ug = (u16*)(p.out + O_YP) + (size_t)item * 16384;
#pragma unroll
  for (int ti = 0; ti < 2; ++ti) { const int i = wave * 2 + ti, vb = i >> 2, db = i & 3; f32x16 acc;
#pragma unroll
    for (int r = 0; r < 16; ++r) acc[r] = 0.f;
#pragma unroll
    for (int k0 = 0; k0 < 64; k0 += 16) { const bf16x8 a = *(const bf16x8*)(vT + (vb * 32 + r32) * 72 + k0 + 8 * hi), bb = *(const bf16x8*)(kT + (db * 32 + r32) * 72 + k0 + 8 * hi);
      acc = __builtin_amdgcn_mfma_f32_32x32x16_bf16(a, bb, acc, 0, 0, 0); }
#pragma unroll
    for (int r = 0; r < 16; ++r) Ug[(vb * 32 + crow(r, hi)) * 128 + db * 32 + r32] = f2bf(acc[r]); }
  if (tid < 128) { float s2 = 0.f;
#pragma unroll 8
    for (int j = 0; j < 64; ++j) s2 += bf2f(kT[tid * 72 + j]) * wsv[j];
    ((float*)(ws + WS_UN))[(size_t)item * 128 + tid] = s2; }
  __syncthreads();
}

__device__ __forceinline__ void mlstm_h3_unit(const Params& p, int b, int h, int c, unsigned char* lds, int tid, int dry = 0) {
  unsigned char* ws = p.ws;
  u16* qs = (u16*)lds; u16* ks = (u16*)(lds + 17408); u16* vT = (u16*)(lds + 34816); u16* Cs = (u16*)(lds + 53248); u16* At = (u16*)(lds + 88064); float* Hs = (float*)(lds + 97280);
  float* sc = (float*)(lds + 130048); float *bt = sc, *ig = sc + 64, *mt = sc + 128, *wint = sc + 192, *den = sc + 256, *nq = sc + 320, *ns = sc + 384;
  const u16* PRE = (const u16*)(ws + WS_PRE); u16* MV = (u16*)(ws + WS_MV); const u16* SIGO = (const u16*)(ws + WS_SIGO);
  const float* MI = (const float*)(ws + WS_MI); const float* MB = (const float*)(ws + WS_MB); const float* MM = (const float*)(ws + WS_MM);
  const int sq = b * 4 + h, item = sq * 256 + c; const size_t r0 = (size_t)b * SEQ + (size_t)c * 64;
  const int lane = tid & 63, wave = tid >> 6, r32 = lane & 31, hi = lane >> 5;
  if (tid < 64) { const float m0 = ((const float*)(ws + WS_MST))[item]; const float bb = MB[(r0 + tid) * 4 + h], mm = MM[(r0 + tid) * 4 + h]; bt[tid] = bb; ig[tid] = MI[(r0 + tid) * 4 + h]; mt[tid] = mm; wint[tid] = __expf(bb + m0 - mm); }
  else if (tid >= 128 && tid < 256) ns[tid - 128] = ((const float*)(ws + WS_UN))[(size_t)item * 128 + tid - 128];
  { const int chk = tid & 31, l0 = (tid >> 5) * 4; float val[4][8];
    const int col0 = chk < 16 ? h * 128 + chk * 8 : 512 + h * 128 + (chk - 16) * 8;
    convN<4>(PRE, p.in[17], p.in[18], r0, l0, col0, c > 0, chk < 16 ? 1.f : 0.08838834764831845f, val);
#pragma unroll
    for (int r = 0; r < 4; ++r) { u32x4 w = {pk2(val[r][0], val[r][1]), pk2(val[r][2], val[r][3]), pk2(val[r][4], val[r][5]), pk2(val[r][6], val[r][7])};
      *(u32x4*)((chk < 16 ? qs : ks) + (l0 + r) * 136 + (chk & 15) * 8) = w; } }
#pragma unroll
  for (int it = 0; it < 2; ++it) { const int idx = tid + NTHR * it, l = idx >> 4, ch = idx & 15; const u32x4 v = *(const u32x4*)(MV + (r0 + l) * 512 + h * 128 + ch * 8);
#pragma unroll
    for (int e = 0; e < 4; ++e) { vT[(ch * 8 + 2 * e) * 72 + l] = (u16)(v[e] & 0xffffu); vT[(ch * 8 + 2 * e + 1) * 72 + l] = (u16)(v[e] >> 16); } }
  { const u16* Cg = (const u16*)(p.out + O_YP) + (size_t)item * 16384;
#pragma unroll
    for (int it = 0; it < 4; ++it) { const int idx = tid + NTHR * it, v = idx >> 4, ch = idx & 15; *(u32x4*)(Cs + v * 136 + ch * 8) = *(const u32x4*)(Cg + v * 128 + ch * 8); } }
  float sg0[8], sg1[8]; float ng0, ng1;
  { const float* ng = p.in[19] + h * 128; ng0 = ng[lane]; ng1 = ng[64 + lane];
#pragma unroll
    for (int i = 0; i < 8; ++i) { const size_t ro = (r0 + wave + 8 * i) * 512 + h * 128; sg0[i] = bf2f(SIGO[ro + lane]); sg1[i] = bf2f(SIGO[ro + 64 + lane]); } }
  __syncthreads();
  { const int l15 = lane & 15, l4 = lane >> 4;
#pragma unroll
    for (int ti = 0; ti < 2; ++ti) { const int i = wave * 2 + ti, tb = i >> 2, sb = i & 3; const int t = tb * 16 + l15, s0 = sb * 16 + 4 * l4; uint2 w; w.x = 0u; w.y = 0u;
      if (sb <= tb) { f32x4 acc = {0.f, 0.f, 0.f, 0.f};
#pragma unroll
        for (int k0 = 0; k0 < 128; k0 += 32) { const bf16x8 a = *(const bf16x8*)(ks + (sb * 16 + l15) * 136 + k0 + 8 * l4), bq = *(const bf16x8*)(qs + (tb * 16 + l15) * 136 + k0 + 8 * l4);
          acc = __builtin_amdgcn_mfma_f32_16x16x32_bf16(a, bq, acc, 0, 0, 0); }
        float av[4]; const float bmt = bt[t] - mt[t];
#pragma unroll
        for (int r = 0; r < 4; ++r) { const int s2 = s0 + r; av[r] = (s2 <= t) ? __expf(bmt - bt[s2] + ig[s2]) * acc[r] : 0.f; }
        w.x = pk2(av[0], av[1]); w.y = pk2(av[2], av[3]); }
      *(uint2*)(At + t * 72 + s0) = w; } }
  __syncthreads();
  { const int t = tid >> 3, part = tid & 7; float s2 = 0.f, s3 = 0.f;
#pragma unroll
    for (int j = 0; j < 8; ++j) s2 += bf2f(At[t * 72 + part * 8 + j]);
#pragma unroll
    for (int j = 0; j < 16; ++j) s3 += ns[part * 16 + j] * bf2f(qs[t * 136 + part * 16 + j]);
    s2 += __shfl_xor(s2, 1); s3 += __shfl_xor(s3, 1); s2 += __shfl_xor(s2, 2); s3 += __shfl_xor(s3, 2); s2 += __shfl_xor(s2, 4); s3 += __shfl_xor(s3, 4);
    if (part == 0) { den[t] = s2; nq[t] = s3; } }
  f32x16 a1, a2;
  { const int tb = wave >> 2, vb = wave & 3;
#pragma unroll
    for (int r = 0; r < 16; ++r) { a1[r] = 0.f; a2[r] = 0.f; }
#pragma unroll
    for (int k0 = 0; k0 < 64; k0 += 16) { const bf16x8 a = *(const bf16x8*)(At + (tb * 32 + r32) * 72 + k0 + 8 * hi), bv = *(const bf16x8*)(vT + (vb * 32 + r32) * 72 + k0 + 8 * hi);
      a1 = __builtin_amdgcn_mfma_f32_32x32x16_bf16(a, bv, a1, 0, 0, 0); }
#pragma unroll
    for (int k0 = 0; k0 < 128; k0 += 16) { const bf16x8 a = *(const bf16x8*)(qs + (tb * 32 + r32) * 136 + k0 + 8 * hi), bc = *(const bf16x8*)(Cs + (vb * 32 + r32) * 136 + k0 + 8 * hi);
      a2 = __builtin_amdgcn_mfma_f32_32x32x16_bf16(a, bc, a2, 0, 0, 0); } }
  __syncthreads();
  { const int tb = wave >> 2, vb = wave & 3;
#pragma unroll
    for (int r = 0; r < 16; ++r) { const int t = tb * 32 + crow(r, hi); const float wi = wint[t]; const float dn = den[t] + wi * nq[t];
      Hs[t * 128 + vb * 32 + r32] = (a1[r] + wi * a2[r]) * __builtin_amdgcn_rcpf(fmaxf(fabsf(dn), __expf(-mt[t]))); } }
  __syncthreads();
#pragma unroll
  for (int i = 0; i < 8; ++i) { const int t = wave + 8 * i; const float x0 = Hs[t * 128 + lane], x1 = Hs[t * 128 + 64 + lane];
    float s1 = x0 + x1, s2 = x0 * x0 + x1 * x1;
#pragma unroll
    for (int m = 32; m >= 1; m >>= 1) { s1 += __shfl_xor(s1, m); s2 += __shfl_xor(s2, m); }
    const float mu = s1 * (1.f / 128.f); const float rstd = rsqrtf(fmaxf(s2 * (1.f / 128.f) - mu * mu, 0.f) + LN_EPS);
    const size_t ro = (r0 + t) * 512 + h * 128;
    u16* MO = dry ? (u16*)(ws + WS_END) + (ro & 0x3fffff) : MV + ro; MO[lane] = f2bf((x0 - mu) * rstd * ng0 * sg0[i]); MO[64 + lane] = f2bf((x1 - mu) * rstd * ng1 * sg1[i]); }
  __syncthreads();
}

__device__ __forceinline__ void state_scan_phase(const Params& p, int tid) {
  unsigned char* ws = p.ws; const float* WST = (const float*)(ws + WS_MST) + 2048;
  for (int u = blockIdx.x; u < 130; u += gridDim.x) {
    const int gi = u * NTHR + tid;
    if (gi < 65536) { const int sq = gi >> 13, e2 = gi & 8191; unsigned* U = (unsigned*)((u16*)(p.out + O_YP) + (size_t)sq * 256 * 16384) + e2; const float* w = WST + sq * 256; float C0 = 0.f, C1 = 0.f;
      for (int c0 = 0; c0 < 256; c0 += 16) { unsigned tmp[16];
#pragma unroll
        for (int i = 0; i < 16; ++i) tmp[i] = U[(size_t)(c0 + i) * 8192];
#pragma unroll
        for (int i = 0; i < 16; ++i) { U[(size_t)(c0 + i) * 8192] = pk2(C0, C1); const float wc = w[c0 + i]; C0 = wc * C0 + __uint_as_float(tmp[i] << 16); C1 = wc * C1 + __uint_as_float(tmp[i] & 0xffff0000u); } }
      p.out[O_CP + 2 * gi] = C0; p.out[O_CP + 2 * gi + 1] = C1; }
    else if (gi < 65536 + 1024) { const int g2 = gi - 65536, sq = g2 >> 7, e = g2 & 127; float* U = (float*)(ws + WS_UN) + (size_t)sq * 256 * 128 + e; const float* w = WST + sq * 256; float C = 0.f;
      for (int c0 = 0; c0 < 256; c0 += 16) { float tmp[16];
#pragma unroll
        for (int i = 0; i < 16; ++i) tmp[i] = U[(size_t)(c0 + i) * 128];
#pragma unroll
        for (int i = 0; i < 16; ++i) { U[(size_t)(c0 + i) * 128] = C; C = w[c0 + i] * C + tmp[i]; } }
      p.out[O_NP + g2] = C; }
  }
}

#define PH_SWITCH(k) do { if ((k) > 0 && ((PROBE_MASK >> ((k) > 0 ? (k) - 1 : 0)) & 1)) { const unsigned long long t1_ = __builtin_amdgcn_s_memrealtime(); const unsigned long long dt_ = t1_ - tph; \
      while (__builtin_amdgcn_s_memrealtime() - t1_ < dt_) __builtin_amdgcn_s_sleep(8); } \
    if ((PROBE_MASK >> (k)) & 1) tph = __builtin_amdgcn_s_memrealtime(); } while (0)
__global__ void __launch_bounds__(NTHR, 2) fwd_kernel(Params p) {
  extern __shared__ __attribute__((aligned(16))) unsigned char lds[];
  cg::grid_group grid = cg::this_grid();
#define OTID() ({ int t_ = threadIdx.x; asm volatile("" : "+v"(t_)); t_; })
  int tid = OTID(); unsigned char* ws = p.ws;
  int* ctl = (int*)(ws + WS_CTL); int* s_u = (int*)(lds + MISC_OFF);
  float* X = (float*)(ws + WS_X); u16* H = (u16*)(ws + WS_H); u16* ACT = (u16*)(ws + WS_ACT); const float* mod = (const float*)(ws + WS_MOD);
  unsigned long long tph = 0; (void)tph;
  volatile LAS unsigned* st = (volatile LAS unsigned*)(lds + MISC_OFF + 16);
  if (tid == 0) { st[0] = 0u; st[1] = 0u; }
  __syncthreads();
  PH_SWITCH(0);
  prep_phase(p, lds, tid);
  grid.sync(); tid = OTID();
  XcdBarrier xbar = xcd_barrier_post((unsigned*)(ws + WS_CTL) + 4096, st);
#if PROBE == 3
  prep_phase(p, lds, tid); xcd_barrier(xbar); tid = OTID();
  for (int i = 0; i < 16; ++i) xcd_barrier(xbar);
  row_phase<0>(p, 0, 0, 1024); xcd_barrier(xbar); tid = OTID();
#endif
  PH_SWITCH(1);
  row_phase<0>(p, 0, 0, 1024);
  xcd_barrier(xbar); tid = OTID();
  PH_SWITCH(2);
  { EpiGU E; E.ACT = ACT; run_gemm(lds, H, (const u16*)(ws + WS_WGU1), GU_SPLIT ? TP : T, 2 * FF, D, E);
    if (GU_SPLIT) { EpiSlice EZ; EZ.B = p.out + O_YP + O_Z; EZ.ldb = 2 * FF; run_gemm_split(lds, H, (const u16*)(ws + WS_WGU1), D, EZ, 0, 2 * FF); } }
  xcd_barrier(xbar); tid = OTID();
#if PROBE == 4
  { EpiGU E; E.ACT = ACT; run_gemm(lds, H, (const u16*)(ws + WS_WGU1), T, 2 * FF, D, E); }
  xcd_barrier(xbar); tid = OTID();
#endif
  PH_SWITCH(3);
  { EpiRes<false> E; E.xp = p.in[0]; E.st = nullptr; E.lg = nullptr; E.lb = nullptr; E.XB = (u16*)(ws + WS_X); E.gate = mod + 2048; E.gs = 0.5f; run_gemm(lds, ACT, (const u16*)(ws + WS_WD1), TP, D, FF, E);
    if (GU_SPLIT && blockIdx.x < 44) gu_finish(p.out + O_YP + O_Z, ACT, (int)blockIdx.x >> 2, tid);
    EpiResSlice EA; EA.B = (float*)(ws + WS_PB); EA.ldb = D; EA.gs = E.gs; EA.gate = E.gate; run_gemm_split(lds, ACT, (const u16*)(ws + WS_WD1), FF, EA); }
  xcd_barrier(xbar); tid = OTID();
  PH_SWITCH(4);
  row_phase<1, 11>(p, 0, 3072, 4096);
  xcd_barrier(xbar); tid = OTID();
  PH_SWITCH(5);
  { EpiIn E; E.AQ = (u16*)(ws + WS_AQ); E.AK = (u16*)(ws + WS_AK); E.AV = (u16*)(ws + WS_AV); E.PRE = (u16*)(ws + WS_PRE); E.MV = (u16*)(ws + WS_MV); E.SIGO = (u16*)(ws + WS_SIGO);
    E.MI = (float*)(ws + WS_MI); E.MLF = (float*)(ws + WS_MLF); E.bias = (const float*)(ws + WS_BIN); E.out = p.out; run_gemm(lds, H, (const u16*)(ws + WS_WIN), T, 3840, D, E); }
  xcd_barrier(xbar); tid = OTID();
#if PROBE == 5
  { EpiIn E; E.AQ = (u16*)(ws + WS_AQ); E.AK = (u16*)(ws + WS_AK); E.AV = (u16*)(ws + WS_AV); E.PRE = (u16*)(ws + WS_PRE); E.MV = (u16*)(ws + WS_MV); E.SIGO = (u16*)(ws + WS_SIGO);
    E.MI = (float*)(ws + WS_MI); E.MLF = (float*)(ws + WS_MLF); E.bias = (const float*)(ws + WS_BIN); E.out = p.out; run_gemm(lds, H, (const u16*)(ws + WS_WIN), T, 3840, D, E); }
  xcd_barrier(xbar); tid = OTID();
#endif
  PH_SWITCH(6);
  scan_phase(p, lds, tid);
  xcd_barrier(xbar); tid = OTID();
#if PROBE == 1
  for (;;) { __syncthreads(); if (tid == 0) *s_u = atomicAdd(&ctl[3], 1); __syncthreads(); const int u = *s_u; if (u >= 128 + 1024) break; asm volatile("" : "+v"(tid));
    if (u < 128) attn_sample_unit(p, u >> 3, u & 7, lds, tid, 1);
    else { const int v = u - 128; attn_prompt_unit(p, (v & 15) >> 3, v & 7, 63 - (v >> 4), lds, tid, 1); } }
  xcd_barrier(xbar); tid = OTID();
#endif
#if PROBE == 3
  scan_phase(p, lds, tid); xcd_barrier(xbar); tid = OTID();
#endif
  PH_SWITCH(7);
  for (;;) { __syncthreads(); if (tid == 0) *s_u = atomicAdd(&ctl[0], 1); __syncthreads(); const int u = *s_u; if (u >= 64 + 128 + 1024 + 2048) break; asm volatile("" : "+v"(tid));
    if (u < 64) mlstm_unit<16, 2>(p, u >> 2, u & 3, 0, lds, tid);
    else if (u < 192) { const int v = u - 64; attn_sample_unit(p, v >> 3, v & 7, lds, tid); }
    else if (u < 1216) { const int v = u - 192; attn_prompt_unit(p, (v & 15) >> 3, v & 7, 63 - (v >> 4), lds, tid); }
    else { const int v = u - 1216; mlstm_h1_unit(p, v >> 10, (v >> 8) & 3, v & 255, lds, tid); } }
  xcd_barrier(xbar); tid = OTID();
  PH_SWITCH(8);
  PH_SWITCH(9);
  state_scan_phase(p, tid);
  xcd_barrier(xbar); tid = OTID();
#if PROBE == 2
  for (;;) { __syncthreads(); if (tid == 0) *s_u = atomicAdd(&ctl[4], 1); __syncthreads(); const int u = *s_u; if (u >= 2048) break; asm volatile("" : "+v"(tid));
    mlstm_h3_unit(p, u >> 10, (u >> 8) & 3, u & 255, lds, tid, 1); }
  xcd_barrier(xbar); tid = OTID();
#endif
  PH_SWITCH(10);
  for (int u = blockIdx.x; u < 2048; u += gridDim.x) { asm volatile("" : "+v"(tid));
    mlstm_h3_unit(p, u >> 10, (u >> 8) & 3, u & 255, lds, tid); }
  xcd_barrier(xbar); tid = OTID();
  PH_SWITCH(11);
  { const float* bias = (const float*)(ws + WS_BIN); u16* GA = (u16*)(ws + WS_GA); u16* GB = (u16*)(ws + WS_GB); const u16* WIN = (const u16*)(ws + WS_WIN); float* MB4 = (float*)(ws + WS_END);
    { EpiMerge<0> E; E.O = GA; E.Aa = nullptr; E.bias = bias + 3840; run_gemm(lds, H, WIN + (size_t)3840 * D, TP, D, D, E); }
    { EpiMerge<1> E; E.O = GA; E.Aa = nullptr; E.bias = nullptr; run_gemm(lds, (const u16*)(ws + WS_AQ), (const u16*)(ws + WS_WBA), TP, D, 512, E); }
    { EpiMerge<0> E; E.O = GB; E.Aa = nullptr; E.bias = bias + 4864; run_gemm(lds, H, WIN + (size_t)4864 * D, TP, D, D, E); }
    { EpiMerge<2> E; E.O = GB; E.Aa = GA; E.bias = nullptr; run_gemm(lds, (const u16*)(ws + WS_MV), (const u16*)(ws + WS_WBB), TP, D, 512, E); }
    { EpiSlice E; E.ldb = D; E.B = MB4; run_gemm_split(lds, H, WIN + (size_t)3840 * D, D, E, 0); }
    { EpiSlice E; E.ldb = D; E.B = MB4 + 4 * 262144; run_gemm_split(lds, (const u16*)(ws + WS_AQ), (const u16*)(ws + WS_WBA), 512, E, 16); }
    { EpiSlice E; E.ldb = D; E.B = MB4 + 6 * 262144; run_gemm_split(lds, H, WIN + (size_t)4864 * D, D, E, 24); }
    { EpiSlice E; E.ldb = D; E.B = MB4 + 10 * 262144; run_gemm_split(lds, (const u16*)(ws + WS_MV), (const u16*)(ws + WS_WBB), 512, E, 40); } }
  xcd_barrier(xbar); tid = OTID();
  { const float* bias = (const float*)(ws + WS_BIN); const float* MB4 = (const float*)(ws + WS_END); u16* GB = (u16*)(ws + WS_GB);
    const int idx = ((int)blockIdx.x * NTHR + tid) * 2, c = idx & 1023;
    float r[2];
#pragma unroll
    for (int j = 0; j < 2; ++j) { const float* q = MB4 + idx + j; const float a1 = q[0] + q[262144] + q[2 * 262144] + q[3 * 262144], a2 = q[4 * 262144] + q[5 * 262144],
        a3 = q[6 * 262144] + q[7 * 262144] + q[8 * 262144] + q[9 * 262144], a4 = q[10 * 262144] + q[11 * 262144];
      r[j] = sigm(a1 + bias[3840 + c + j]) * a2 + sigm(a3 + bias[4864 + c + j]) * a4; }
    if (idx < 262144) *(unsigned*)(GB + (size_t)TP * D + idx) = pk2(r[0], r[1]); }
  xcd_barrier(xbar); tid = OTID();
#if PROBE == 5
  { const float* bias = (const float*)(ws + WS_BIN); u16* GA = (u16*)(ws + WS_GA); u16* GB = (u16*)(ws + WS_GB); const u16* WIN = (const u16*)(ws + WS_WIN);
    { EpiMerge<0> E; E.O = GA; E.Aa = nullptr; E.bias = bias + 3840; run_gemm(lds, H, WIN + (size_t)3840 * D, T, D, D, E); }
    { EpiMerge<1> E; E.O = GA; E.Aa = nullptr; E.bias = nullptr; run_gemm(lds, (const u16*)(ws + WS_AQ), (const u16*)(ws + WS_WBA), T, D, 512, E); }
    { EpiMerge<0> E; E.O = GB; E.Aa = nullptr; E.bias = bias + 4864; run_gemm(lds, H, WIN + (size_t)4864 * D, T, D, D, E); }
    { EpiMerge<2> E; E.O = GB; E.Aa = GA; E.bias = nullptr; run_gemm(lds, (const u16*)(ws + WS_MV), (const u16*)(ws + WS_WBB), T, D, 512, E); } }
  xcd_barrier(xbar); tid = OTID();
#endif
  PH_SWITCH(12);
  { EpiRes<true> E; E.xp = nullptr; E.st = (const float*)(ws + WS_ST); E.lg = p.in[25]; E.lb = p.in[26]; E.XB = (u16*)(ws + WS_X); E.gate = mod + 5120; E.gs = 1.0f; run_gemm(lds, (const u16*)(ws + WS_GB), (const u16*)(ws + WS_WOUT), TP, D, D, E);
    EpiResSlice EA; EA.B = (float*)(ws + WS_PB); EA.ldb = D; EA.gs = E.gs; EA.gate = E.gate; run_gemm_split(lds, (const u16*)(ws + WS_GB), (const u16*)(ws + WS_WOUT), D, EA); }
  xcd_barrier(xbar); tid = OTID();
  PH_SWITCH(13);
  row_phase<1, 4>(p, 1, 6144, 7168);
  xcd_barrier(xbar); tid = OTID();
  PH_SWITCH(14);
  { EpiGU E; E.ACT = ACT; run_gemm(lds, H, (const u16*)(ws + WS_WGU2), GU_SPLIT ? TP : T, 2 * FF, D, E);
    if (GU_SPLIT) { EpiSlice EZ; EZ.B = p.out + O_YP + O_Z; EZ.ldb = 2 * FF; run_gemm_split(lds, H, (const u16*)(ws + WS_WGU2), D, EZ, 0, 2 * FF); } }
  xcd_barrier(xbar); tid = OTID();
  PH_SWITCH(15);
  { EpiRes<true> E; E.xp = nullptr; E.st = (const float*)(ws + WS_ST) + 2 * TP; E.lg = p.in[25] + D; E.lb = p.in[26] + D; E.XB = (u16*)(ws + WS_X); E.gate = mod + 8192; E.gs = 0.5f; run_gemm(lds, ACT, (const u16*)(ws + WS_WD2), TP, D, FF, E);
    if (GU_SPLIT && blockIdx.x < 44) gu_finish(p.out + O_YP + O_Z, ACT, (int)blockIdx.x >> 2, tid);
    EpiResSlice EA; EA.B = (float*)(ws + WS_PB); EA.ldb = D; EA.gs = E.gs; EA.gate = E.gate; run_gemm_split(lds, ACT, (const u16*)(ws + WS_WD2), FF, EA); }
  xcd_barrier(xbar); tid = OTID();
  PH_SWITCH(16);
  row_phase<2, 11>(p, 2, 0, 0);
  PH_SWITCH(17);
}

extern "C" void kernel_launch(void* const* d_in, const int* in_sizes, int n_in, void* d_out, int out_size, void* d_ws, size_t ws_size, hipStream_t stream) {
  static int grid = 0;
  if (grid == 0) {
    if (n_in != 27 || ws_size < WS_PB + 12 * MiB) { fprintf(stderr, "kernel_launch: unexpected n_in %d / ws_size %zu (need %zu)\n", n_in, ws_size, (size_t)WS_END); grid = -1; return; }
    int dev = 0, cus = 0, per_cu = 0;
    hipGetDevice(&dev); hipDeviceGetAttribute(&cus, hipDeviceAttributeMultiprocessorCount, dev);
    if (hipFuncSetAttribute((const void*)fwd_kernel, hipFuncAttributeMaxDynamicSharedMemorySize, LDS_BYTES) != hipSuccess) { fprintf(stderr, "kernel_launch: hipFuncSetAttribute failed\n"); grid = -1; return; }
    if (hipOccupancyMaxActiveBlocksPerMultiprocessor(&per_cu, (const void*)fwd_kernel, NTHR, LDS_BYTES) != hipSuccess || per_cu < 1) { fprintf(stderr, "kernel_launch: occupancy query says %d\n", per_cu); per_cu = 1; }
    (void)hipGetLastError();
    grid = cus * 1;
  }
  if (grid < 0) return;
  Params p{};
  for (int i = 0; i < 27; ++i) p.in[i] = (const float*)d_in[i];
  p.out = (float*)d_out; p.ws = (unsigned char*)d_ws;
  void* args[] = {&p};
  hipError_t e = hipLaunchCooperativeKernel((const void*)fwd_kernel, dim3(grid), dim3(NTHR), args, LDS_BYTES, stream);
  if (e != hipSuccess) fprintf(stderr, "cooperative launch failed: %s (grid %d)\n", hipGetErrorString(e), grid);
}
```
